# Optimizing an MI355X kernel written in HIP

```python
import math
import jax, jax.numpy as jnp
from jax import lax
import numpy as np

D_MODEL = 1024
BATCH = 4
SEQ = 4096
DEPTH = 4

N_MIXERS = 3
N_A = (DEPTH + 2) // 3
N_B = (DEPTH + 1) // 3
N_C = DEPTH // 3

ALPHA = (2.0 * DEPTH) ** 0.25
BETA = (8.0 * DEPTH) ** -0.25
LN_EPS = 1e-5

GLA_HEADS = 4
GLA_DK = D_MODEL // 2
GLA_DV = D_MODEL
GLA_HK = GLA_DK // GLA_HEADS
GLA_HV = GLA_DV // GLA_HEADS
GLA_RANK = 16
GLA_TAU = 16.0
GLA_CHUNK = 32
GLA_IN = 2 * GLA_DK + 2 * GLA_DV + GLA_RANK

RG_BW = 128
RG_WIDTH = ((4 * D_MODEL // 3) // RG_BW) * RG_BW
RG_BLOCKS = RG_WIDTH // RG_BW
RG_CONV = 4
RG_C = 8.0

FOX_HD = 64
FOX_HEADS = D_MODEL // FOX_HD
FOX_BLOCK = 128
FOX_IN = 4 * D_MODEL + FOX_HEADS

N_EXPERTS = 32
TOP_K = 4
D_FF = D_MODEL
SWIGLU_LIMIT = 7.0
SWIGLU_ALPHA = 1.702
MOE_BLOCK = 128

kernel_name = "hybrid_gla_rglru_fox_moe_deepnorm_adaln"


def layer_norm(x, g, b):
    xf = x.astype(jnp.float32)
    mu = jnp.mean(xf, axis=-1, keepdims=True)
    var = jnp.mean(jnp.square(xf - mu), axis=-1, keepdims=True)
    return ((xf - mu) * lax.rsqrt(var + LN_EPS) * g + b).astype(x.dtype)


def rms_norm(x, g):
    xf = x.astype(jnp.float32)
    return (xf * lax.rsqrt(jnp.mean(jnp.square(xf), axis=-1, keepdims=True) + LN_EPS) * g).astype(x.dtype)


def gla_mixer(h, w_in, w_gate_up, b_gate, norm_g, w_out):
    B, S, _ = h.shape
    H, C = GLA_HEADS, GLA_CHUNK
    NC = S // C
    proj = h @ w_in
    q, k, v, r, g_lr = jnp.split(proj, [GLA_DK, 2 * GLA_DK, 2 * GLA_DK + GLA_DV, 2 * GLA_DK + 2 * GLA_DV], axis=-1)
    log_a = jax.nn.log_sigmoid((g_lr @ w_gate_up + b_gate).astype(jnp.float32)) / GLA_TAU

    def chunked(t, dh):
        return t.reshape(B, NC, C, H, dh).transpose(0, 3, 1, 2, 4)

    qc = chunked(q, GLA_HK).astype(jnp.float32) * (GLA_HK ** -0.5)
    kc = chunked(k, GLA_HK).astype(jnp.float32)
    vc = chunked(v, GLA_HV).astype(jnp.float32)
    bcum = jnp.cumsum(chunked(log_a, GLA_HK), axis=3)
    blast = bcum[:, :, :, -1:, :]
    q_dec = qc * jnp.exp(bcum)
    k_inv = kc * jnp.exp(-bcum)
    k_end = kc * jnp.exp(blast - bcum)
    causal = jnp.tril(jnp.ones((C, C), dtype=bool))
    scores = jnp.where(causal, jnp.einsum('bhnid,bhnjd->bhnij', q_dec, k_inv), 0.0)
    o_intra = jnp.einsum('bhnij,bhnje->bhnie', scores, vc)

    def step(state, inp):
        q_n, k_n, v_n, dec_n = inp
        o_n = jnp.einsum('bhid,bhde->bhie', q_n, state)
        state = dec_n[..., None] * state + jnp.einsum('bhjd,bhje->bhde', k_n, v_n)
        return state, o_n

    xs = (jnp.moveaxis(q_dec, 2, 0), jnp.moveaxis(k_end, 2, 0), jnp.moveaxis(vc, 2, 0),
          jnp.moveaxis(jnp.exp(blast[:, :, :, 0, :]), 2, 0))
    state0 = jnp.zeros((B, H, GLA_HK, GLA_HV), jnp.float32)
    _, o_inter = lax.scan(step, state0, xs)
    o = o_intra + jnp.moveaxis(o_inter, 0, 2)
    o = o.transpose(0, 2, 3, 1, 4).reshape(B, S, H, GLA_HV)
    o = (o * lax.rsqrt(jnp.mean(jnp.square(o), axis=-1, keepdims=True) + LN_EPS)).reshape(B, S, GLA_DV) * norm_g
    o = o.astype(h.dtype) * jax.nn.silu(r)
    return o @ w_out


def rglru_mixer(h, w_in, conv_w, conv_b, w_rg, b_rg, w_ig, b_ig, lam, w_out):
    B, S, _ = h.shape
    proj = h @ w_in
    y_br, x_br = jnp.split(proj, 2, axis=-1)
    y_br = jax.nn.gelu(y_br, approximate=True)
    xp = jnp.pad(x_br, ((0, 0), (RG_CONV - 1, 0), (0, 0)))
    xc = sum(xp[:, j:j + S] * conv_w[j] for j in range(RG_CONV)) + conv_b
    xblk = xc.reshape(B, S, RG_BLOCKS, RG_BW)
    r = jax.nn.sigmoid(jnp.einsum('bsnj,njk->bsnk', xblk, w_rg).reshape(B, S, RG_WIDTH) + b_rg)
    i = jax.nn.sigmoid(jnp.einsum('bsnj,njk->bsnk', xblk, w_ig).reshape(B, S, RG_WIDTH) + b_ig)
    log_a = -RG_C * r.astype(jnp.float32) * jax.nn.softplus(-lam.astype(jnp.float32))
    a = jnp.exp(log_a)
    u = jnp.sqrt(-jnp.expm1(2.0 * log_a)) * (i * xc).astype(jnp.float32)

    def combine(e1, e2):
        a1, b1 = e1
        a2, b2 = e2
        return a1 * a2, a2 * b1 + b2

    _, hs = lax.associative_scan(combine, (a, u), axis=1)
    return (hs.astype(h.dtype) * y_br) @ w_out


def fox_mixer(h, w_in, b_f, q_norm_g, k_norm_g, w_out):
    B, S, D = h.shape
    H, hd = FOX_HEADS, FOX_HD
    proj = h @ w_in
    q, k, v, f_logit, og = jnp.split(proj, [D, 2 * D, 3 * D, 3 * D + H], axis=-1)
    q = rms_norm(q.reshape(B, S, H, hd), q_norm_g).transpose(0, 2, 1, 3)
    k = rms_norm(k.reshape(B, S, H, hd), k_norm_g).transpose(0, 2, 1, 3)
    v = v.reshape(B, S, H, hd).transpose(0, 2, 1, 3)
    log_f = jax.nn.log_sigmoid((f_logit + b_f).astype(jnp.float32))
    dcum = jnp.cumsum(log_f, axis=1).transpose(0, 2, 1)
    scale = hd ** -0.5
    outs = []
    for blk in range(S // FOX_BLOCK):
        q0, q1 = blk * FOX_BLOCK, (blk + 1) * FOX_BLOCK
        logits = (jnp.einsum('bhqd,bhkd->bhqk', q[:, :, q0:q1], k[:, :, :q1]).astype(jnp.float32) * scale
                  + dcum[:, :, q0:q1, None] - dcum[:, :, None, :q1])
        mask = jnp.arange(q1)[None, :] <= jnp.arange(q0, q1)[:, None]
        p = jax.nn.softmax(jnp.where(mask, logits, -jnp.inf), axis=-1)
        outs.append(jnp.einsum('bhqk,bhkd->bhqd', p.astype(v.dtype), v[:, :, :q1]))
    o = jnp.concatenate(outs, axis=2).transpose(0, 2, 1, 3).reshape(B, S, D)
    return (o * jax.nn.sigmoid(og)) @ w_out


def moe_ffn(h, w_router, b_router, w_gu, b_gu, w_down, b_down):
    B, S, D = h.shape
    T = B * S
    xt = h.reshape(T, D)
    logits = (xt @ w_router + b_router).astype(jnp.float32)
    top_logit, top_idx = lax.top_k(logits, TOP_K)
    top_w = jax.nn.softmax(top_logit, axis=-1)
    n_assign = T * TOP_K
    n_pad = -(-(n_assign + N_EXPERTS * (MOE_BLOCK - 1)) // MOE_BLOCK) * MOE_BLOCK
    n_blocks = n_pad // MOE_BLOCK
    flat_e = top_idx.reshape(-1)
    flat_tok = jnp.arange(n_assign, dtype=jnp.int32) // TOP_K
    order = jnp.argsort(flat_e)
    sorted_e = flat_e[order]
    counts = jnp.bincount(flat_e, length=N_EXPERTS)
    starts = jnp.cumsum(counts) - counts
    padded = (counts + MOE_BLOCK - 1) // MOE_BLOCK * MOE_BLOCK
    pad_ends = jnp.cumsum(padded)
    pad_starts = pad_ends - padded
    dest = pad_starts[sorted_e] + jnp.arange(n_assign) - starts[sorted_e]
    tok_buf = jnp.full((n_pad,), T, jnp.int32).at[dest].set(flat_tok[order])
    w_buf = jnp.zeros((n_pad,), jnp.float32).at[dest].set(top_w.reshape(-1)[order])
    block_e = jnp.minimum(jnp.searchsorted(pad_ends, jnp.arange(n_blocks) * MOE_BLOCK, side='right'), N_EXPERTS - 1)
    x_pad = jnp.concatenate([xt, jnp.zeros((1, D), xt.dtype)], axis=0)
    xb = x_pad[tok_buf].reshape(n_blocks, MOE_BLOCK, D)

    def expert_block(args):
        xblk, e = args
        gu = xblk @ w_gu[e] + b_gu[e]
        gate = jnp.minimum(gu[:, 0::2], SWIGLU_LIMIT)
        up = jnp.clip(gu[:, 1::2], -SWIGLU_LIMIT, SWIGLU_LIMIT)
        glu = gate * jax.nn.sigmoid(SWIGLU_ALPHA * gate)
        return ((up + 1.0) * glu) @ w_down[e] + b_down[e]

    yb = lax.map(expert_block, (xb, block_e)).reshape(n_pad, D)
    out = jnp.zeros((T + 1, D), jnp.float32).at[tok_buf].add(yb.astype(jnp.float32) * w_buf[:, None])[:T]
    return out.astype(h.dtype).reshape(B, S, D)


def setup_inputs(seed: int = 0) -> dict:
    key = jax.random.key(seed)
    ks = iter(jax.random.split(key, 40))

    def nrm(shape, scale):
        return jax.random.normal(next(ks), shape, jnp.float32) * scale

    D = D_MODEL
    inp = {}
    inp['x'] = nrm((BATCH, SEQ, D), 1.0)
    inp['c'] = nrm((BATCH, D), 1.0)
    inp['ada_w'] = nrm((DEPTH, D, 6 * D), 0.1 * D ** -0.5)
    inp['ada_b'] = nrm((DEPTH, 6 * D), 0.02)
    inp['ln_g'] = 1.0 + nrm((DEPTH, 2, D), 0.02)
    inp['ln_b'] = nrm((DEPTH, 2, D), 0.02)
    inp['gla_w_in'] = nrm((N_A, D, GLA_IN), D ** -0.5)
    inp['gla_w_gate_up'] = nrm((N_A, GLA_RANK, GLA_DK), GLA_RANK ** -0.5)
    inp['gla_b_gate'] = nrm((N_A, GLA_DK), 0.5)
    inp['gla_norm_g'] = 1.0 + nrm((N_A, GLA_DV), 0.02)
    inp['gla_w_out'] = nrm((N_A, GLA_DV, D), BETA * GLA_DV ** -0.5)
    inp['rg_w_in'] = nrm((N_B, D, 2 * RG_WIDTH), D ** -0.5)
    inp['rg_conv_w'] = nrm((N_B, RG_CONV, RG_WIDTH), RG_CONV ** -0.5)
    inp['rg_conv_b'] = nrm((N_B, RG_WIDTH), 0.02)
    inp['rg_w_rg'] = nrm((N_B, RG_BLOCKS, RG_BW, RG_BW), RG_BW ** -0.5)
    inp['rg_b_rg'] = nrm((N_B, RG_WIDTH), 0.02)
    inp['rg_w_ig'] = nrm((N_B, RG_BLOCKS, RG_BW, RG_BW), RG_BW ** -0.5)
    inp['rg_b_ig'] = nrm((N_B, RG_WIDTH), 0.02)
    a_c = jax.random.uniform(next(ks), (N_B, RG_WIDTH), jnp.float32, 0.9, 0.999)
    s = a_c ** (1.0 / RG_C)
    inp['rg_lambda'] = jnp.log(s) - jnp.log1p(-s)
    inp['rg_w_out'] = nrm((N_B, RG_WIDTH, D), BETA * RG_WIDTH ** -0.5)
    inp['fox_w_in'] = nrm((N_C, D, FOX_IN), D ** -0.5)
    inp['fox_b_f'] = 2.0 + nrm((N_C, FOX_HEADS), 0.5)
    inp['fox_q_norm_g'] = 1.0 + nrm((N_C, FOX_HD), 0.02)
    inp['fox_k_norm_g'] = 1.0 + nrm((N_C, FOX_HD), 0.02)
    inp['fox_w_out'] = nrm((N_C, D, D), BETA * D ** -0.5)
    inp['moe_w_router'] = nrm((DEPTH, D, N_EXPERTS), D ** -0.5)
    inp['moe_b_router'] = nrm((DEPTH, N_EXPERTS), 0.01)
    inp['moe_w_gu'] = nrm((DEPTH, N_EXPERTS, D, 2 * D_FF), D ** -0.5)
    inp['moe_b_gu'] = nrm((DEPTH, N_EXPERTS, 2 * D_FF), 0.02)
    inp['moe_w_down'] = nrm((DEPTH, N_EXPERTS, D_FF, D), BETA * D_FF ** -0.5)
    inp['moe_b_down'] = nrm((DEPTH, N_EXPERTS, D), 0.02)
    return inp


def reference(x, c, ada_w, ada_b, ln_g, ln_b,
              gla_w_in, gla_w_gate_up, gla_b_gate, gla_norm_g, gla_w_out,
              rg_w_in, rg_conv_w, rg_conv_b, rg_w_rg, rg_b_rg, rg_w_ig, rg_b_ig, rg_lambda, rg_w_out,
              fox_w_in, fox_b_f, fox_q_norm_g, fox_k_norm_g, fox_w_out,
              moe_w_router, moe_b_router, moe_w_gu, moe_b_gu, moe_w_down, moe_b_down):
    c_act = jax.nn.silu(c)
    for l in range(DEPTH):
        mod = c_act @ ada_w[l] + ada_b[l]
        sh1, sc1, g1, sh2, sc2, g2 = [m[:, None, :] for m in jnp.split(mod, 6, axis=-1)]
        h = x * (1.0 + sc1) + sh1
        kind, j = l % N_MIXERS, l // N_MIXERS
        if kind == 0:
            y = gla_mixer(h, gla_w_in[j], gla_w_gate_up[j], gla_b_gate[j], gla_norm_g[j], gla_w_out[j])
        elif kind == 1:
            y = rglru_mixer(h, rg_w_in[j], rg_conv_w[j], rg_conv_b[j], rg_w_rg[j], rg_b_rg[j],
                            rg_w_ig[j], rg_b_ig[j], rg_lambda[j], rg_w_out[j])
        else:
            y = fox_mixer(h, fox_w_in[j], fox_b_f[j], fox_q_norm_g[j], fox_k_norm_g[j], fox_w_out[j])
        x = layer_norm(ALPHA * x + (1.0 + g1) * y, ln_g[l, 0], ln_b[l, 0])
        h = x * (1.0 + sc2) + sh2
        y = moe_ffn(h, moe_w_router[l], moe_b_router[l], moe_w_gu[l], moe_b_gu[l], moe_w_down[l], moe_b_down[l])
        x = layer_norm(ALPHA * x + (1.0 + g2) * y, ln_g[l, 1], ln_b[l, 1])
    return x
```

```cpp
#include <hip/hip_runtime.h>
#include <cstdio>
#include <cstdint>
__device__ __forceinline__ int my_tid() { int t = (int)threadIdx.x; asm volatile("" : "+v"(t)); return t; }
namespace pg8 {
#define PG8_LAS __attribute__((address_space(3)))
typedef unsigned short bf16_t;
typedef short bf16x8 __attribute__((ext_vector_type(8)));
typedef float f32x4 __attribute__((ext_vector_type(4)));
typedef unsigned u32x4 __attribute__((ext_vector_type(4)));
constexpr int BM = 256, BK = 64, HALF = 128, HTB = HALF * BK * 2  , STAGE_BYTES = 8 * HTB, NXCD = 8, WGM = 8;
__host__ __device__ __forceinline__ int lds_byte(int r, int c) { const int st = (r >> 4) * 2 + (c >> 5), rr = r & 15, cc = c & 31, ob = rr * 64 + cc * 2; return st * 1024 + (ob ^ (((ob >> 9) & 1) << 5)); }
__host__ __device__ __forceinline__ void stage_rc(int b, int& R, int& C) { const int st = b / 1024, sb = b % 1024, swz = sb ^ (((sb >> 9) & 1) << 5); R = (st >> 1) * 16 + swz / 64; C = (st & 1) * 32 + (swz % 64) / 2; }
__host__ __device__ __forceinline__ int perm32(int rho) { const int n = rho >> 4, i = rho & 15; return 8 * (i >> 2) + 4 * n + (i & 3); }

struct Unit { int pm, pn, ui; };
struct Gemm { const bf16_t* A; const bf16_t* Bt; int M, N, K; int lda; size_t a_pn_stride; int wscale; };

struct StaticOrder {
    int nM, nN, nwg, G, c;
    __host__ __device__ void init(int M, int N, int G_, int c_) { nM = M / BM; nN = N / BM; nwg = nM * nN; G = G_; c = c_; }
    __host__ __device__ bool next(int i, Unit& u) const {
        const long L = (long)i * G + c; if (L >= nwg) return false;
        int wgid = (int)L; { const int q = nwg / NXCD, r = nwg % NXCD, xcd = wgid % NXCD, off = wgid / NXCD; wgid = (xcd < r ? xcd * (q + 1) : r * (q + 1) + (xcd - r) * q) + off; }
        const int nig = WGM * nN, gid = wgid / nig, fm = gid * WGM, gsz = (nM - fm) < WGM ? (nM - fm) : WGM;
        u.pm = fm + ((wgid % nig) % gsz); u.pn = (wgid % nig) / gsz; return true;
    }
    __device__ __forceinline__ void a_ready(const Unit&) const {}
    __device__ __forceinline__ void done(const Unit&) const {}
};

__device__ __forceinline__ unsigned cvt_pk_bf16(float lo, float hi) { unsigned r; asm volatile("v_cvt_pk_bf16_f32 %0, %1, %2" : "=v"(r) : "v"(lo), "v"(hi)); return r; }
typedef float f32x2 __attribute__((ext_vector_type(2)));

__device__ __forceinline__ float fast_sigmoid(float x) { return __builtin_amdgcn_rcpf(1.0f + __builtin_amdgcn_exp2f(-1.4426950408889634f * x)); }
__device__ __forceinline__ float gelu_tanh(float x) { const float u = 0.7978845608028654f * (x + 0.044715f * x * x * x); return x * fast_sigmoid(2.0f * u); }
struct EpiBf16Plain {
    static constexpr bool PERM = true, AFTER_DRAIN = false, BIAS_INIT = false;
    bf16_t* O; int ldc; int gelu_pn_lt;
    __device__ __forceinline__ void operator()(const f32x4 (&acc)[2][2][4][2], const Unit& u, int wr, int wc, int fr, int fq) const {
        const int row0 = u.pm * BM + wr * 64 + fr, col0 = u.pn * BM + wc * 32 + 8 * fq; const bool g = u.pn < gelu_pn_lt;
#pragma unroll
        for (int ai = 0; ai < 2; ++ai)
#pragma unroll
            for (int m = 0; m < 4; ++m) { bf16_t* rowp = O + (size_t)(row0 + ai * HALF + m * 16) * ldc + col0;
#pragma unroll
                for (int bj = 0; bj < 2; ++bj) { f32x4 v0 = acc[ai][bj][m][0], v1 = acc[ai][bj][m][1];
                    if (g) {
#pragma unroll
                        for (int q = 0; q < 4; ++q) { v0[q] = gelu_tanh(v0[q]); v1[q] = gelu_tanh(v1[q]); } }
                    u32x4 w; w.x = cvt_pk_bf16(v0[0], v0[1]); w.y = cvt_pk_bf16(v0[2], v0[3]); w.z = cvt_pk_bf16(v1[0], v1[1]); w.w = cvt_pk_bf16(v1[2], v1[3]);
                    *(u32x4*)(rowp + bj * HALF) = w; } }
    }
};
struct EpiSwiglu {
    static constexpr bool PERM = true, AFTER_DRAIN = false, BIAS_INIT = true;
    bf16_t* act; const PG8_LAS float* bl;
    __device__ __forceinline__ void bias_init(f32x4 (&b)[2][2], const Unit& u, int wc, int fq) const { const PG8_LAS float* bp = bl + u.ui * 256 + wc * 32 + 8 * fq;
#pragma unroll
        for (int bj = 0; bj < 2; ++bj)
#pragma unroll
            for (int n = 0; n < 2; ++n) b[bj][n] = *(const PG8_LAS f32x4*)(bp + bj * HALF + 4 * n); }
    __device__ __forceinline__ void operator()(const f32x4 (&acc)[2][2][4][2], const Unit& u, int wr, int wc, int fr, int fq) const {
        const int nt = u.pn & 7; const int row0 = u.pm * BM + wr * 64 + fr, cl = wc * 32 + 8 * fq, colo = nt * 128 + cl;
#pragma unroll
        for (int ai = 0; ai < 2; ++ai)
#pragma unroll
            for (int m = 0; m < 4; ++m) { unsigned char* rowp = (unsigned char*)act + (size_t)(row0 + ai * HALF + m * 16) * 1024 + colo;
                float o[8];
#pragma unroll
                for (int n = 0; n < 2; ++n) { const f32x4 G = acc[ai][0][m][n], U = acc[ai][1][m][n]; f32x4 gc, uc, ex, r;
#pragma unroll
                    for (int q = 0; q < 4; ++q) { gc[q] = __builtin_amdgcn_fmed3f(G[q], -3.0e38f, 224.0f); uc[q] = __builtin_amdgcn_fmed3f(U[q], -192.0f, 256.0f); }
                    const f32x4 ea = gc * -0.07673331611f + 10.0f;
#pragma unroll
                    for (int q = 0; q < 4; ++q) ex[q] = __builtin_amdgcn_exp2f(ea[q]);
                    const f32x4 den = ex + 1024.0f;
#pragma unroll
                    for (int q = 0; q < 4; ++q) r[q] = __builtin_amdgcn_rcpf(den[q]);
                    const f32x4 o4 = uc * gc * r;
#pragma unroll
                    for (int q = 0; q < 4; ++q) o[n * 4 + q] = o4[q]; }
                int p0 = 0, p1 = 0; p0 = __builtin_amdgcn_cvt_pk_fp8_f32(o[0], o[1], p0, false); p0 = __builtin_amdgcn_cvt_pk_fp8_f32(o[2], o[3], p0, true); p1 = __builtin_amdgcn_cvt_pk_fp8_f32(o[4], o[5], p1, false); p1 = __builtin_amdgcn_cvt_pk_fp8_f32(o[6], o[7], p1, true);
                typedef unsigned u32x2_ __attribute__((ext_vector_type(2))); *(u32x2_*)rowp = (u32x2_){(unsigned)p0, (unsigned)p1}; }
    }
};
struct EpiDown {
    static constexpr bool PERM = true, AFTER_DRAIN = false, BIAS_INIT = true;
    bf16_t* yb; const PG8_LAS unsigned* rt; const PG8_LAS float* bl;
    __device__ __forceinline__ void bias_init(f32x4 (&b)[2][2], const Unit& u, int wc, int fq) const { const PG8_LAS float* bp = bl + u.ui * 256 + wc * 32 + 8 * fq;
#pragma unroll
        for (int bj = 0; bj < 2; ++bj)
#pragma unroll
            for (int n = 0; n < 2; ++n) b[bj][n] = *(const PG8_LAS f32x4*)(bp + bj * HALF + 4 * n); }
    __device__ __forceinline__ void operator()(const f32x4 (&acc)[2][2][4][2], const Unit& u, int wr, int wc, int fr, int fq) const {
        const int nt = u.pn & 3; const int cl = wc * 32 + 8 * fq, col0 = nt * 256 + cl;
        typedef unsigned u32x2_ __attribute__((ext_vector_type(2)));
        const PG8_LAS unsigned* rp = rt + (u.ui * 256 + wr * 64 + fr) * 2;
#pragma unroll
        for (int ai = 0; ai < 2; ++ai)
#pragma unroll
            for (int m = 0; m < 4; ++m) { const u32x2_ iw = *(const PG8_LAS u32x2_*)(rp + (ai * HALF + m * 16) * 2); const int info = (int)iw.x; const float w = __uint_as_float(iw.y);
                if (info >= 0) { unsigned char* rowp = (unsigned char*)yb + (size_t)info * 1024 + col0;
#pragma unroll
                    for (int bj = 0; bj < 2; ++bj) {
                        const f32x4 v0 = acc[ai][bj][m][0] * w, v1 = acc[ai][bj][m][1] * w;
                        f32x4 c0, c1;
#pragma unroll
                        for (int q_ = 0; q_ < 4; ++q_) { c0[q_] = __builtin_amdgcn_fmed3f(v0[q_], -440.f, 440.f); c1[q_] = __builtin_amdgcn_fmed3f(v1[q_], -440.f, 440.f); }
                        int q0 = 0, q1 = 0; q0 = __builtin_amdgcn_cvt_pk_fp8_f32(c0[0], c0[1], q0, false); q0 = __builtin_amdgcn_cvt_pk_fp8_f32(c0[2], c0[3], q0, true); q1 = __builtin_amdgcn_cvt_pk_fp8_f32(c1[0], c1[1], q1, false); q1 = __builtin_amdgcn_cvt_pk_fp8_f32(c1[2], c1[3], q1, true);
                        *(u32x2_*)(rowp + bj * HALF) = (u32x2_){(unsigned)q0, (unsigned)q1}; } } }
    }
};
struct EpiRgGate {
    static constexpr bool PERM = false, AFTER_DRAIN = false, BIAS_INIT = false;
    unsigned* AU; const bf16_t* xc; const float* brg; const float* big; const float* lam;
    __device__ __forceinline__ void operator()(const f32x4 (&acc)[2][2][4][2], const Unit& u, int wr, int wc, int fr, int fq) const {
        const int row0 = u.pm * BM + wr * 64 + fr, ch0 = u.pn * 128 + wc * 32 + 4 * fq;
        unsigned long long xw[2][2][4];
#pragma unroll
        for (int n = 0; n < 2; ++n)
#pragma unroll
            for (int ai = 0; ai < 2; ++ai)
#pragma unroll
                for (int m = 0; m < 4; ++m) xw[n][ai][m] = *(const unsigned long long*)(xc + (size_t)(row0 + ai * HALF + m * 16) * 1280 + ch0 + 16 * n);
#pragma unroll
        for (int n = 0; n < 2; ++n) { const int ch = ch0 + 16 * n;
            const f32x4 br = *(const f32x4*)(brg + ch), bi = *(const f32x4*)(big + ch), lm = *(const f32x4*)(lam + ch); f32x4 sp;
#pragma unroll
            for (int q = 0; q < 4; ++q) sp[q] = lm[q] < -20.f ? -lm[q] : log1pf(__expf(-lm[q]));
#pragma unroll
            for (int ai = 0; ai < 2; ++ai)
#pragma unroll
                for (int m = 0; m < 4; ++m) { const size_t row = (size_t)(row0 + ai * HALF + m * 16);
                    const unsigned long long xq = xw[n][ai][m];
                    const float xv[4] = {__uint_as_float((unsigned)xq << 16), __uint_as_float((unsigned)xq & 0xffff0000u), __uint_as_float((unsigned)(xq >> 32) << 16), __uint_as_float((unsigned)(xq >> 32) & 0xffff0000u)};
                    u32x4 au;
#pragma unroll
                    for (int q = 0; q < 4; ++q) { const float rr = fast_sigmoid(acc[ai][0][m][n][q] + br[q]), ii = fast_sigmoid(acc[ai][1][m][n][q] + bi[q]); const float la = -8.0f * rr * sp[q];
                        const float x2 = 2.0f * la; const float om = x2 > -0.01f ? -x2 * (1.0f + x2 * (0.5f + x2 * 0.16666667f)) : 1.0f - __expf(x2);
                        au[q] = cvt_pk_bf16(la, __builtin_amdgcn_sqrtf(om) * (ii * xv[q])); }
                    *(u32x4*)(AU + row * 1280 + ch) = au; } }
    }
};
struct ListOrder {
    const PG8_LAS unsigned* list; int n;
    __device__ __forceinline__ bool next(int i, Unit& u) const { if (i >= n) return false; const unsigned v = (unsigned)__builtin_amdgcn_readfirstlane((int)list[i]); u.pm = (int)(v & 0xffffu); u.pn = (int)(v >> 16); u.ui = i; return true; }
    __device__ __forceinline__ void a_ready(const Unit&) const {}
    __device__ __forceinline__ void done(const Unit&) const {}
};
template <class Epi, class Sched, bool ALIGN_EPI = false, bool SP2 = false, bool GATHER = false, bool FP8 = false>
__device__ __forceinline__ void gemm_phase(PG8_LAS unsigned char* lds, const Gemm g, const Sched& S, const Epi& E, const PG8_LAS unsigned* gtab = nullptr) {
    const int tid = my_tid(), wid = __builtin_amdgcn_readfirstlane(tid >> 6), lane = tid & 63, wr = wid >> 2, wc = wid & 3, fr = lane & 15, fq = lane >> 4;
    const int K = g.K, nt = K / BK;
    unsigned voffA[2], voffB[2];
#pragma unroll
    for (int i = 0; i < 2; ++i) { int R, C; stage_rc(tid * 16 + i * 8192, R, C); const int Rb = Epi::PERM ? ((R & ~31) + perm32(R & 31)) : R;
        voffA[i] = (unsigned)(R * g.lda + C) * 2u; voffB[i] = (unsigned)(Rb * K + C) * 2u; }
    const size_t kstep = (size_t)(BK * 2);
    const size_t hstepA = (size_t)HALF * g.lda * 2, hstepB = (size_t)HALF * K * 2;
    const size_t tstepA = 2 * hstepA, tstepB = 2 * hstepB;
    const unsigned ldsw = (unsigned)wid * 1024u;
    const int aoff = lds_byte(wr * 64 + fr, fq * 8), boff = lds_byte(wc * 32 + fr, fq * 8);
#define PG8_SA(b, h) (((b) * 2 + (h)) * HTB)
#define PG8_SB(b, h) ((4 + (b) * 2 + (h)) * HTB)
#define PG8_STAGE(bufoff, gbase, voff) do { _Pragma("unroll") for (int _i = 0; _i < 2; ++_i) { unsigned o_ = (voff)[_i]; asm volatile("" : "+v"(o_));     \
        __builtin_amdgcn_global_load_lds((const unsigned*)((const char*)(gbase) + o_), (PG8_LAS unsigned*)(lds + (bufoff) + ldsw + _i * 8192), 16, 0, 0); } } while (0)
#define PG8_LDA(dst, b, h) do { _Pragma("unroll") for (int m = 0; m < 4; ++m) { dst[m].lo = *(const PG8_LAS bf16x8*)(lds + PG8_SA(b, h) + aoff + m * 2048); dst[m].hi = *(const PG8_LAS bf16x8*)(lds + PG8_SA(b, h) + aoff + m * 2048 + 1024); } } while (0)
#define PG8_LDB(dst, b, h) do { _Pragma("unroll") for (int n = 0; n < 2; ++n) { dst[n].lo = *(const PG8_LAS bf16x8*)(lds + PG8_SB(b, h) + boff + n * 2048); dst[n].hi = *(const PG8_LAS bf16x8*)(lds + PG8_SB(b, h) + boff + n * 2048 + 1024); } } while (0)
#define PG8_MMA(ai, bj, At, Bt) do { __builtin_amdgcn_s_setprio(1); \
        if constexpr (FP8) { typedef int v8i_ __attribute__((ext_vector_type(8))); \
            _Pragma("unroll") for (int m = 0; m < 4; ++m) _Pragma("unroll") for (int n = 0; n < 2; ++n) \
                acc[ai][bj][m][n] = __builtin_amdgcn_mfma_scale_f32_16x16x128_f8f6f4(__builtin_bit_cast(v8i_, Bt[n]), __builtin_bit_cast(v8i_, At[m]), acc[ai][bj][m][n], 0, 0, 0, 0, 0, 0);     \
        } else { _Pragma("unroll") for (int m = 0; m < 4; ++m) _Pragma("unroll") for (int n = 0; n < 2; ++n) { \
            acc[ai][bj][m][n] = __builtin_amdgcn_mfma_f32_16x16x32_bf16(Bt[n].lo, At[m].lo, acc[ai][bj][m][n], 0, 0, 0); \
            acc[ai][bj][m][n] = __builtin_amdgcn_mfma_f32_16x16x32_bf16(Bt[n].hi, At[m].hi, acc[ai][bj][m][n], 0, 0, 0); } } __builtin_amdgcn_s_setprio(0); } while (0)
#define PG8_WAIT_V(n) asm volatile("s_waitcnt vmcnt(" #n ")" ::: "memory")
#define PG8_WAIT_L(n) asm volatile("s_waitcnt lgkmcnt(" #n ")" ::: "memory")
#define PG8_BAR __builtin_amdgcn_s_barrier()
#define PG8_SCHED __builtin_amdgcn_sched_barrier(0)
    Unit cur, nxt; int ui = 0;
    if (!S.next(0, cur)) return;
    f32x4 acc[2][2][4][2];
#define PG8_ACC_INIT(unit_) do { f32x4 i_[2][2]; if constexpr (Epi::BIAS_INIT) { int t3_ = (int)threadIdx.x; asm volatile("" : "+v"(t3_)); E.bias_init(i_, unit_, wc, (t3_ & 63) >> 4); } \
        else { _Pragma("unroll") for (int b = 0; b < 2; ++b) _Pragma("unroll") for (int n = 0; n < 2; ++n) i_[b][n] = (f32x4){0.f, 0.f, 0.f, 0.f}; } \
        _Pragma("unroll") for (int a = 0; a < 2; ++a) _Pragma("unroll") for (int b = 0; b < 2; ++b) _Pragma("unroll") for (int m = 0; m < 4; ++m) _Pragma("unroll") for (int n = 0; n < 2; ++n) acc[a][b][m][n] = i_[b][n]; } while (0)
    PG8_ACC_INIT(cur);
    typedef short bf16x16 __attribute__((ext_vector_type(16)));
    bf16x16 At[4], B0[2], B1[2];
    const char* cA = GATHER ? (const char*)g.A : (const char*)g.A + (size_t)cur.pm * tstepA + (size_t)cur.pn * g.a_pn_stride;
    unsigned gvc[2][2];
#define PG8_GLOAD(dst, ui_) do { int t_ = (int)threadIdx.x; asm volatile("" : "+v"(t_));     \
        _Pragma("unroll") for (int i_ = 0; i_ < 2; ++i_) { int R_, C_; stage_rc(t_ * 16 + i_ * 8192, R_, C_); \
            _Pragma("unroll") for (int h_ = 0; h_ < 2; ++h_) dst[h_][i_] = gtab[(ui_) * 256 + h_ * HALF + R_] + (unsigned)C_ * 2u; } } while (0)
#define PG8_AH(p, h) (GATHER ? (p) : (p) + (h) * hstepA)
    if constexpr (GATHER) { PG8_GLOAD(gvc, 0); }
    else { _Pragma("unroll") for (int h_ = 0; h_ < 2; ++h_) _Pragma("unroll") for (int i_ = 0; i_ < 2; ++i_) gvc[h_][i_] = voffA[i_]; }
    const char* cB = (const char*)g.Bt + (size_t)cur.pn * tstepB;
    S.a_ready(cur);
    if constexpr (SP2) {
        PG8_STAGE(PG8_SB(0, 0), cB, voffB); PG8_STAGE(PG8_SB(0, 1), cB + hstepB, voffB); PG8_STAGE(PG8_SA(0, 0), cA, gvc[0]); PG8_STAGE(PG8_SA(0, 1), PG8_AH(cA, 1), gvc[1]);
        if (wr == 1) PG8_BAR;
        PG8_WAIT_V(2); PG8_BAR;
        PG8_STAGE(PG8_SB(1, 0), cB + kstep, voffB); PG8_STAGE(PG8_SA(1, 0), cA + kstep, gvc[0]); PG8_STAGE(PG8_SB(1, 1), cB + hstepB + kstep, voffB);
        PG8_WAIT_V(6); PG8_BAR;
    } else {
        PG8_STAGE(PG8_SB(0, 0), cB, voffB); PG8_STAGE(PG8_SA(0, 0), cA, gvc[0]); PG8_STAGE(PG8_SB(0, 1), cB + hstepB, voffB); PG8_STAGE(PG8_SA(0, 1), PG8_AH(cA, 1), gvc[1]);
        if (wr == 1) PG8_BAR;
        PG8_WAIT_V(4); PG8_BAR;
        PG8_STAGE(PG8_SB(1, 0), cB + kstep, voffB); PG8_STAGE(PG8_SA(1, 0), cA + kstep, gvc[0]); PG8_STAGE(PG8_SB(1, 1), cB + hstepB + kstep, voffB);
        PG8_WAIT_V(6); PG8_BAR;
    }
    for (;;) {
        const bool has_next = S.next(ui + 1, nxt);
        const char* nA = GATHER ? cA : (has_next ? (const char*)g.A + (size_t)nxt.pm * tstepA + (size_t)nxt.pn * g.a_pn_stride : cA);
        const char* nB = has_next ? (const char*)g.Bt + (size_t)nxt.pn * tstepB : cB;
        for (int t = 0; t < nt; t += 2) {
            const bool last = (t == nt - 2);
            const char* a1 = cA + (size_t)(t + 1) * kstep;
            const char* a2 = last ? (GATHER ? (const char*)g.A : nA) : cA + (size_t)(t + 2) * kstep; const char* b2 = last ? nB : cB + (size_t)(t + 2) * kstep;
            const char* a3 = a2 + kstep; const char* b3 = b2 + kstep;
            if (last && has_next) S.a_ready(nxt);
            if constexpr (SP2) {
            PG8_LDB(B0, 0, 0); PG8_LDB(B1, 0, 1); PG8_SCHED; PG8_LDA(At, 0, 0); PG8_STAGE(PG8_SA(1, 1), PG8_AH(a1, 1), gvc[1]); if constexpr (GATHER) { if (last && has_next) PG8_GLOAD(gvc, ui + 1); }
            PG8_WAIT_V(8); PG8_WAIT_L(0); PG8_BAR; PG8_MMA(0, 0, At, B0); PG8_MMA(0, 1, At, B1); PG8_BAR; PG8_SCHED;
            PG8_LDA(At, 0, 1); PG8_STAGE(PG8_SB(0, 0), b2, voffB); PG8_STAGE(PG8_SB(0, 1), b2 + hstepB, voffB); PG8_STAGE(PG8_SA(0, 0), a2, gvc[0]);
            PG8_WAIT_V(8); PG8_WAIT_L(0); PG8_BAR; PG8_MMA(1, 0, At, B0); PG8_MMA(1, 1, At, B1); PG8_BAR; PG8_SCHED;
            PG8_LDB(B0, 1, 0); PG8_LDB(B1, 1, 1); PG8_SCHED; PG8_LDA(At, 1, 0); PG8_STAGE(PG8_SA(0, 1), PG8_AH(a2, 1), gvc[1]);
            PG8_WAIT_V(8); PG8_WAIT_L(0); PG8_BAR; PG8_MMA(0, 0, At, B0); PG8_MMA(0, 1, At, B1); PG8_BAR; PG8_SCHED;
            PG8_LDA(At, 1, 1); PG8_STAGE(PG8_SB(1, 0), b3, voffB); PG8_STAGE(PG8_SB(1, 1), b3 + hstepB, voffB); PG8_STAGE(PG8_SA(1, 0), a3, gvc[0]);
            PG8_WAIT_V(8); PG8_WAIT_L(0); PG8_BAR; PG8_MMA(1, 0, At, B0); PG8_MMA(1, 1, At, B1); PG8_BAR; PG8_SCHED;
            } else {
            PG8_LDB(B0, 0, 0); PG8_SCHED; PG8_LDA(At, 0, 0); PG8_STAGE(PG8_SA(1, 1), PG8_AH(a1, 1), gvc[1]); if constexpr (GATHER) { if (last && has_next) PG8_GLOAD(gvc, ui + 1); }
            PG8_WAIT_L(8); PG8_BAR; PG8_WAIT_L(0); PG8_MMA(0, 0, At, B0); PG8_BAR; PG8_SCHED;
            PG8_LDB(B1, 0, 1); PG8_STAGE(PG8_SB(0, 0), b2, voffB);
            PG8_BAR; PG8_WAIT_L(0); PG8_MMA(0, 1, At, B1); PG8_BAR;
            PG8_LDA(At, 0, 1); PG8_STAGE(PG8_SA(0, 0), a2, gvc[0]);
            PG8_BAR; PG8_WAIT_L(0); PG8_MMA(1, 0, At, B0); PG8_BAR; PG8_SCHED;
            PG8_STAGE(PG8_SB(0, 1), b2 + hstepB, voffB);
            PG8_WAIT_V(6); PG8_BAR; PG8_MMA(1, 1, At, B1); PG8_BAR;
            PG8_LDB(B0, 1, 0); PG8_SCHED; PG8_LDA(At, 1, 0); PG8_STAGE(PG8_SA(0, 1), PG8_AH(a2, 1), gvc[1]);
            PG8_WAIT_L(8); PG8_BAR; PG8_WAIT_L(0); PG8_MMA(0, 0, At, B0); PG8_BAR; PG8_SCHED;
            PG8_LDB(B1, 1, 1); PG8_STAGE(PG8_SB(1, 0), b3, voffB);
            PG8_BAR; PG8_WAIT_L(0); PG8_MMA(0, 1, At, B1); PG8_BAR;
            PG8_LDA(At, 1, 1); PG8_STAGE(PG8_SA(1, 0), a3, gvc[0]);
            PG8_BAR; PG8_WAIT_L(0); PG8_MMA(1, 0, At, B0); PG8_BAR; PG8_SCHED;
            PG8_STAGE(PG8_SB(1, 1), b3 + hstepB, voffB);
            PG8_WAIT_V(6); PG8_BAR; PG8_MMA(1, 1, At, B1); PG8_BAR;
            }
        }
        if constexpr (ALIGN_EPI) { if (wr == 0) PG8_BAR; }
        if constexpr (!Epi::AFTER_DRAIN) { int t2_ = (int)threadIdx.x; asm volatile("" : "+v"(t2_));
            const int l2_ = t2_ & 63; E(acc, cur, wr, wc, l2_ & 15, l2_ >> 4); S.done(cur); }
        if (!has_next) break;
        cur = nxt; cA = nA; cB = nB; ++ui;
        PG8_ACC_INIT(cur);

        if constexpr (ALIGN_EPI) { if (wr == 1) PG8_BAR; }
    }
    PG8_WAIT_V(0);
    if constexpr (!ALIGN_EPI) { if (wr == 0) PG8_BAR; }
    PG8_BAR;
    if constexpr (Epi::AFTER_DRAIN) { E.fused(acc, cur, wr, wc, fr, fq, lds, wid, lane); S.done(cur); }
#undef PG8_GLOAD
#undef PG8_ACC_INIT
#undef PG8_AH
#undef PG8_SA
#undef PG8_SB
#undef PG8_STAGE
#undef PG8_LDA
#undef PG8_LDB
#undef PG8_MMA
#undef PG8_WAIT_V
#undef PG8_WAIT_L
#undef PG8_BAR
#undef PG8_SCHED
}
}

constexpr int NB = 4, SEQ = 4096, D = 1024, T = NB * SEQ;
constexpr float ALPHA = 1.681792830507429f;
constexpr float LN_EPS = 1e-5f;
constexpr int NE = 32;
constexpr int NPAD_MAX = T * 4 + NE * 256;
constexpr float LOG2E = 1.4426950408889634f;
constexpr float FOX_C2 = 0.125f * LOG2E;

constexpr size_t KiB = 1024, MiB = 1u << 20;
constexpr size_t WS_CTL = 0, CTL_ZERO_BYTES = 320 * KiB;
constexpr size_t WS_MOD = 1 * MiB;
constexpr size_t WS_SMALL = 2 * MiB;
constexpr size_t WS_TKE = 3 * MiB, WS_TKP = 3 * MiB + 256 * KiB, WS_TKW = 3 * MiB + 512 * KiB;
constexpr size_t WS_ROWINFO = 4 * MiB, WS_ROWW = 4 * MiB + 512 * KiB;
constexpr size_t WS_BGUP = 5 * MiB;
constexpr size_t WS_DCUM = 6 * MiB;
constexpr size_t WS_SCAN = 7 * MiB;
constexpr size_t WS_ELIST = 10 * MiB, WS_EWT = 12 * MiB;
constexpr size_t WS_X = 16 * MiB;
constexpr size_t WS_H = 80 * MiB;
constexpr size_t WS_Y = 112 * MiB;
constexpr size_t WS_PROJ = 176 * MiB;
constexpr size_t WS_CORE = 304 * MiB;
constexpr size_t WS_MIX = 352 * MiB;
constexpr size_t WS_XG = 512 * MiB;
constexpr size_t WS_ACT = 656 * MiB;
constexpr size_t WS_YB = 800 * MiB;
constexpr size_t WS_WT = 1024 * MiB;
constexpr size_t WT_GLA_IN = WS_WT, WT_GLA_OUT = WT_GLA_IN + 12 * MiB, WT_RG_IN = WT_GLA_OUT + 4 * MiB, WT_RG_OUT = WT_RG_IN + 5 * MiB,
                 WT_FOX_IN = WT_RG_OUT + 3 * MiB, WT_FOX_OUT = WT_FOX_IN + 8 * MiB, WT_RG_G = WT_FOX_OUT + 2 * MiB, WT_GU = WT_RG_G + 2 * MiB, WT_DN = WT_GU + 512 * MiB, WS_END = WT_DN + 256 * MiB;
constexpr int CW_TMO = 0, CW_BAR = 4096, CW_CNT = 16384, CW_GLA = 20480;

constexpr int RING_BYTES = 131072, CTRL_OFF = 135168, LDS_BYTES = 163840;
constexpr int L_MISC = CTRL_OFF, L_TS = CTRL_OFF + 64, L_CNT = CTRL_OFF + 256, L_ULIST = CTRL_OFF + 512, L_NU = CTRL_OFF + 1024, L_VEC = CTRL_OFF + 2048, L_RLIST = CTRL_OFF + 2048 + 20480;

#define GAS __attribute__((address_space(1)))
#define LAS __attribute__((address_space(3)))
typedef unsigned short bf16;
typedef unsigned v4u __attribute__((ext_vector_type(4)));
typedef unsigned v2u __attribute__((ext_vector_type(2)));
typedef float f32x4 __attribute__((ext_vector_type(4)));
typedef float f32x2 __attribute__((ext_vector_type(2)));
typedef __bf16 bf16x2_t __attribute__((ext_vector_type(2)));
#define LDS_WAIT() asm volatile("s_waitcnt lgkmcnt(0)" ::: "memory")
#define LDS_BARRIER() asm volatile("s_waitcnt lgkmcnt(0)\n\ts_barrier" ::: "memory")
#define VM_WAIT() asm volatile("s_waitcnt vmcnt(0)" ::: "memory")
#define RLX_AGENT __ATOMIC_RELAXED, __HIP_MEMORY_SCOPE_AGENT
__device__ __forceinline__ float bf2f(bf16 v) { return __uint_as_float((unsigned)v << 16); }
__device__ __forceinline__ float bflo(unsigned w) { return __uint_as_float(w << 16); }
__device__ __forceinline__ float bfhi(unsigned w) { return __uint_as_float(w & 0xffff0000u); }
__device__ __forceinline__ unsigned pk2(float lo, float hi) { f32x2 v = {lo, hi}; bf16x2_t b = __builtin_convertvector(v, bf16x2_t); return __builtin_bit_cast(unsigned, b); }
__device__ __forceinline__ unsigned pk4_fp8(float a, float b, float c, float d) { int p = 0; p = __builtin_amdgcn_cvt_pk_fp8_f32(a, b, p, false); p = __builtin_amdgcn_cvt_pk_fp8_f32(c, d, p, true); return (unsigned)p; }
__device__ __forceinline__ bf16 f2bf(float f) { return (bf16)(pk2(f, 0.f) & 0xffffu); }
template <int CTRL> __device__ __forceinline__ float dpp_f(float v) { return __builtin_bit_cast(float, __builtin_amdgcn_update_dpp(0, __builtin_bit_cast(int, v), CTRL, 0xf, 0xf, true)); }
__device__ __forceinline__ float wave_sum(float v) {
    v += dpp_f<0xB1>(v); v += dpp_f<0x4E>(v); v += dpp_f<0x141>(v); v += dpp_f<0x140>(v);
    const float s0 = __builtin_bit_cast(float, __builtin_amdgcn_readlane(__builtin_bit_cast(int, v), 0)), s1 = __builtin_bit_cast(float, __builtin_amdgcn_readlane(__builtin_bit_cast(int, v), 16)),
                s2 = __builtin_bit_cast(float, __builtin_amdgcn_readlane(__builtin_bit_cast(int, v), 32)), s3 = __builtin_bit_cast(float, __builtin_amdgcn_readlane(__builtin_bit_cast(int, v), 48));
    return (s0 + s1) + (s2 + s3);
}
__device__ __forceinline__ float sigmoidf_(float x) { return __builtin_amdgcn_rcpf(1.0f + __expf(-x)); }
__device__ __forceinline__ float logsigmoidf_(float x) { return fminf(x, 0.f) - log1pf(__expf(-fabsf(x))); }

#define XB_TMO      128
#define XB_XCNT(j)  (256  + 64 * (j))
#define XB_XSUB(j)  (1280 + 64 * (j))
#define XB_XGEN(j)  (2304 + 64 * (j))
#define XB_TOP      3328
#define XB_TOPGEN   3392
#define XCD_BAR_WORDS 3456
#define XB_SPIN_CAP (1u << 18)

__device__ __forceinline__ unsigned xb_ld(unsigned* p)              { return __hip_atomic_load(p, __ATOMIC_RELAXED, __HIP_MEMORY_SCOPE_AGENT); }
__device__ __forceinline__ unsigned xb_add(unsigned* p, unsigned v) { return __hip_atomic_fetch_add(p, v, __ATOMIC_RELAXED, __HIP_MEMORY_SCOPE_AGENT); }
__device__ __forceinline__ unsigned xb_xcc_id() { return (unsigned)__builtin_amdgcn_s_getreg((3 << 11) | 20) & 0xFu; }
#define XB_SPIN(cond, bar) do { unsigned _sp = 0; while (cond) { __builtin_amdgcn_s_sleep(1); \
    if ((++_sp & 255u) == 0u) { if (xb_ld(&(bar)[XB_TMO])) break; if (_sp > XB_SPIN_CAP) { atomicAdd(&(bar)[XB_TMO], 1u); break; } } } } while (0)

struct XcdBarrier {
    unsigned* bar; unsigned x;
    volatile LAS unsigned* st;
};

__device__ __forceinline__ XcdBarrier xcd_barrier_post(unsigned* bar, volatile LAS unsigned* st) {
    XcdBarrier b; b.bar = bar; b.x = xb_xcc_id(); b.st = st;
    if (threadIdx.x == 0) (void)xb_add(&bar[XB_XCNT(b.x)], 1u);
    return b;
}
__device__ __forceinline__ void xcd_barrier_complete(unsigned* bar, unsigned x, unsigned& nloc, unsigned& nx) {
    const unsigned G = gridDim.x * gridDim.y * gridDim.z;
    unsigned sum, cnt, mine, sp = 0u;
    for (;;) {
        sum = 0u; cnt = 0u; mine = 0u;
#pragma unroll
        for (unsigned j = 0; j < 16; ++j) { const unsigned c = xb_ld(&bar[XB_XCNT(j)]); sum += c; cnt += (c > 0u) ? 1u : 0u; mine = (j == x) ? c : mine; }
        if (sum == G) break;
        __builtin_amdgcn_s_sleep(1);
        if ((++sp & 255u) == 0u) { if (xb_ld(&bar[XB_TMO])) break; if (sp > XB_SPIN_CAP) { atomicAdd(&bar[XB_TMO], 1u); break; } }
    }
    nloc = mine > 0u ? mine : 1u; nx = cnt > 0u ? cnt : 1u;
}

__device__ __forceinline__ void xcd_barrier(const XcdBarrier& b) {
    asm volatile("s_waitcnt vmcnt(0)" ::: "memory");
    __syncthreads();
    if (threadIdx.x == 0) {
        unsigned* bar = b.bar;
        __builtin_amdgcn_s_waitcnt(0);
        unsigned nloc = b.st[0], nx = b.st[1];
        if (nloc == 0u) { xcd_barrier_complete(bar, b.x, nloc, nx); b.st[0] = nloc; b.st[1] = nx; }
        const unsigned old = xb_add(&bar[XB_XSUB(b.x)], 1u);
        const unsigned gen = old / nloc;
        if (old + 1u == (gen + 1u) * nloc) {
            __builtin_amdgcn_fence(__ATOMIC_RELEASE, "agent");
            asm volatile("s_waitcnt vmcnt(0)" ::: "memory");
            const unsigned og = xb_add(&bar[XB_TOP], 1u);
            const unsigned tg = og / nx;
            if (og + 1u == (tg + 1u) * nx) xb_add(&bar[XB_TOPGEN], 1u);
            else XB_SPIN(xb_ld(&bar[XB_TOPGEN]) == tg, bar);
            __builtin_amdgcn_fence(__ATOMIC_ACQUIRE, "agent");
            xb_add(&bar[XB_XGEN(b.x)], 1u);
            asm volatile("s_waitcnt vmcnt(0)" ::: "memory");
        } else {
            XB_SPIN(xb_ld(&bar[XB_XGEN(b.x)]) == gen, bar);
            __builtin_amdgcn_fence(__ATOMIC_ACQUIRE, "agent");
            asm volatile("s_waitcnt vmcnt(0)" ::: "memory");
        }
    }
    __syncthreads();
}

struct Params { const float* in[31]; float* out; unsigned char* ws; int ph_lo, ph_hi, use_bar, pad; };
enum { I_X = 0, I_C, I_ADA_W, I_ADA_B, I_LN_G, I_LN_B, I_GLA_WIN, I_GLA_WGU, I_GLA_BG, I_GLA_NG, I_GLA_WOUT, I_RG_WIN, I_RG_CW, I_RG_CB, I_RG_WRG, I_RG_BRG,
       I_RG_WIG, I_RG_BIG, I_RG_LAM, I_RG_WOUT, I_FOX_WIN, I_FOX_BF, I_FOX_QG, I_FOX_KG, I_FOX_WOUT, I_MOE_WR, I_MOE_BR, I_MOE_WGU, I_MOE_BGU, I_MOE_WDN, I_MOE_BDN };

__device__ __forceinline__ const float* kin(int i) {
    const char __attribute__((address_space(4)))* ka = (const char __attribute__((address_space(4)))*)__builtin_amdgcn_kernarg_segment_ptr();
    int off = i * 8; asm volatile("" : "+s"(off));
    return *(const float* const __attribute__((address_space(4)))*)(ka + off);
}
__device__ __forceinline__ void tr_item(const float* W, int ldw, int c0, int k0, bf16* WT, int ldt, int mode, LAS float* scr, int lane) {
#pragma unroll
    for (int i4 = 0; i4 < 16; ++i4) { const int kk = 4 * i4 + (lane >> 4);
        __builtin_amdgcn_global_load_lds((const unsigned*)(W + (size_t)(k0 + kk) * ldw + c0 + 4 * ((lane & 15) ^ ((kk >> 3) & 7))), (LAS unsigned*)(scr + i4 * 256), 16, 0, 2); }
    asm volatile("s_waitcnt vmcnt(0)" ::: "memory");
    const int c8 = lane & 7;
#pragma unroll
    for (int jj = 0; jj < 8; ++jj) { const int n = (lane >> 3) + 8 * jj, c = c0 + n;
        const int drow = mode == 0 ? c : (mode == 1 ? ((c >> 8) * 256 + (c & 1) * 128 + ((c >> 1) & 127)) : (c < 3072 ? c : c - 16));
        const LAS float* src = scr + (8 * c8) * 64 + 4 * ((n >> 2) ^ c8) + (n & 3);
        float f[8];
#pragma unroll
        for (int i = 0; i < 8; ++i) f[i] = src[i * 64];
        v4u o; o.x = pk2(f[0], f[1]); o.y = pk2(f[2], f[3]); o.z = pk2(f[4], f[5]); o.w = pk2(f[6], f[7]);
        *(v4u*)(WT + (size_t)drow * ldt + k0 + 8 * c8) = o; }
    LDS_WAIT(); asm volatile("" ::: "memory");
}
__device__ __forceinline__ void tr_item8(const float* W, int ldw, int c0, int k0, unsigned char* WT8, int ldt, int mode, float sc, LAS float* scr, int lane) {
#pragma unroll
    for (int i8 = 0; i8 < 16; ++i8) { const int kk = 8 * i8 + (lane >> 3);
        __builtin_amdgcn_global_load_lds((const unsigned*)(W + (size_t)(k0 + kk) * ldw + c0 + 4 * ((lane & 7) ^ ((kk >> 4) & 7))), (LAS unsigned*)(scr + i8 * 256), 16, 0, 2); }
    asm volatile("s_waitcnt vmcnt(0)" ::: "memory");
    const int c16 = lane & 7;
#pragma unroll
    for (int jj = 0; jj < 4; ++jj) { const int n = (lane >> 3) + 8 * jj, c = c0 + n;
        const int drow = mode == 0 ? c : ((c >> 8) * 256 + (c & 1) * 128 + ((c >> 1) & 127));
        const LAS float* src = scr + (16 * c16) * 32 + 4 * ((n >> 2) ^ c16) + (n & 3);
        float f[16];
#pragma unroll
        for (int i = 0; i < 16; ++i) f[i] = src[i * 32] * sc;
        v4u o; o.x = pk4_fp8(f[0], f[1], f[2], f[3]); o.y = pk4_fp8(f[4], f[5], f[6], f[7]); o.z = pk4_fp8(f[8], f[9], f[10], f[11]); o.w = pk4_fp8(f[12], f[13], f[14], f[15]);
        *(v4u*)(WT8 + (size_t)drow * ldt + k0 + 16 * c16) = o; }
    LDS_WAIT(); asm volatile("" ::: "memory");
}
__device__ __forceinline__ void p0_adaln(const Params& P, LAS unsigned char* lds) {
    const int tid = my_tid(), lane = tid & 63, wave = __builtin_amdgcn_readfirstlane(tid >> 6), G = gridDim.x;
    unsigned char* ws = P.ws;
    { LAS float* csil = (LAS float*)lds; LAS float* red = (LAS float*)(lds + 16384);
      for (int i = tid; i < NB * D; i += 512) { const float c = kin(I_C)[i]; csil[i] = c * sigmoidf_(c); }
      __syncthreads();
      float* mod = (float*)(ws + WS_MOD);
      for (int u = blockIdx.x; u < 4 * 48; u += G) { const int l = u / 48, cg = u % 48, col = cg * 128 + 2 * lane;
          const float* w = kin(I_ADA_W) + (size_t)l * D * 6144 + col; f32x2 a0 = {0.f, 0.f}, a1 = a0, a2 = a0, a3 = a0;
#pragma unroll 16
          for (int kk = 0; kk < 128; ++kk) { const int k = wave * 128 + kk; const f32x2 wv = *(const f32x2*)(w + (size_t)k * 6144);
              a0 += wv * csil[k]; a1 += wv * csil[D + k]; a2 += wv * csil[2 * D + k]; a3 += wv * csil[3 * D + k]; }
          LAS f32x2* red2 = (LAS f32x2*)red;
          red2[(wave * 4 + 0) * 64 + lane] = a0; red2[(wave * 4 + 1) * 64 + lane] = a1; red2[(wave * 4 + 2) * 64 + lane] = a2; red2[(wave * 4 + 3) * 64 + lane] = a3;
          __syncthreads();
          { const int b = tid >> 7, c = tid & 127; float s = kin(I_ADA_B)[l * 6144 + cg * 128 + c];
#pragma unroll
              for (int w8 = 0; w8 < 8; ++w8) s += red[((w8 * 4 + b) * 64) * 2 + c];
              mod[((size_t)l * NB + b) * 6144 + cg * 128 + c] = s; }
          __syncthreads(); }
    }
}
__device__ __forceinline__ void p0_convert(const Params& P, LAS unsigned char* lds) {
    const int tid = my_tid(), lane = tid & 63, wave = __builtin_amdgcn_readfirstlane(tid >> 6), G = gridDim.x;
    unsigned char* ws = P.ws;
    { float* bp = (float*)(ws + WS_BGUP); const float* bs = kin(I_MOE_BGU);
      for (int i = blockIdx.x * 512 + tid; i < 4 * 32 * 2048; i += G * 512) { const int le = i >> 11, r = i & 2047, nt = r >> 8, half = (r >> 7) & 1, j = r & 127;
          bp[i] = bs[(size_t)le * 2048 + 2 * (nt * 128 + j) + half]; } }
    { bf16* wg = (bf16*)(ws + WT_RG_G);
      for (int i = blockIdx.x * 512 + tid; i < 2560 * 16; i += G * 512) { const int rw = i >> 4, c = i & 15; *(v4u*)(wg + (size_t)rw * 256 + 128 + c * 8) = (v4u){0u, 0u, 0u, 0u}; } }
    LAS float* scr = (LAS float*)(lds + wave * 16384);
    const int gw = blockIdx.x * 8 + wave, NGW = G * 8;
    constexpr int N_SMALL = 4288 + 80, N_GU = 128 * 512, N_DN = 128 * 256, N_ITEMS = N_SMALL + N_GU + N_DN;
    for (int it = gw; it < N_ITEMS; it += NGW) {
        int r = it;
        if (r >= N_SMALL + N_GU) { r -= N_SMALL + N_GU; const int le = r >> 8, q = r & 255, kb = q >> 5, cb = q & 31;
            tr_item8(kin(I_MOE_WDN) + (size_t)le * 1024 * 1024, 1024, cb * 32, kb * 128, ws + WT_DN + (size_t)le * 1024 * 1024, 1024, 0, 64.0f, scr, lane); continue; }
        if (r >= N_SMALL) { r -= N_SMALL; const int le = r >> 9, q = r & 511, kb = q >> 6, cb = q & 63;
            tr_item8(kin(I_MOE_WGU) + (size_t)le * 1024 * 2048, 2048, cb * 32, kb * 128, ws + WT_GU + (size_t)le * 2048 * 1024, 1024, 1, 32.0f, scr, lane); continue; }
        if (r < 1536) { const int j = r / 768, q = r % 768, kb = q / 48, cb = q % 48;
            tr_item(kin(I_GLA_WIN) + (size_t)j * 1024 * 3088, 3088, cb * 64, kb * 64, (bf16*)(ws + WT_GLA_IN) + (size_t)j * 3072 * 1024, 1024, 0, scr, lane); continue; } r -= 1536;
        if (r < 512) { const int j = r >> 8, q = r & 255, kb = q >> 4, cb = q & 15;
            tr_item(kin(I_GLA_WOUT) + (size_t)j * 1024 * 1024, 1024, cb * 64, kb * 64, (bf16*)(ws + WT_GLA_OUT) + (size_t)j * 1024 * 1024, 1024, 0, scr, lane); continue; } r -= 512;
        if (r < 640) { const int kb = r / 40, cb = r % 40;
            tr_item(kin(I_RG_WIN), 2560, cb * 64, kb * 64, (bf16*)(ws + WT_RG_IN), 1024, 0, scr, lane); continue; } r -= 640;
        if (r < 320) { const int kb = r >> 4, cb = r & 15;
            tr_item(kin(I_RG_WOUT), 1024, cb * 64, kb * 64, (bf16*)(ws + WT_RG_OUT), 1280, 0, scr, lane); continue; } r -= 320;
        if (r < 1024) { const int kb = r >> 6, cb = r & 63; const int c0 = cb < 48 ? cb * 64 : 3088 + (cb - 48) * 64;
            tr_item(kin(I_FOX_WIN), 4112, c0, kb * 64, (bf16*)(ws + WT_FOX_IN), 1024, 2, scr, lane); continue; } r -= 1024;
        if (r < 256) { const int kb = r >> 4, cb = r & 15;
            tr_item(kin(I_FOX_WOUT), 1024, cb * 64, kb * 64, (bf16*)(ws + WT_FOX_OUT), 1024, 0, scr, lane); continue; } r -= 256;
        { const int blk = r >> 3, g = (r >> 2) & 1, kb = (r >> 1) & 1, cb = r & 1;
            tr_item(kin(g ? I_RG_WIG : I_RG_WRG) + (size_t)blk * 128 * 128, 128, cb * 64, kb * 64, (bf16*)(ws + WT_RG_G) + (size_t)(blk * 256 + g * 128) * 256, 256, 0, scr, lane); }
    }
}

struct TokA {
    const float* xin; int xin_bf, xout_bf; int ymode;
    const float* y; const bf16* yb;
    const float* gvec; const float* gamma; const float* beta; float* xout;
    const float* scvec; const float* shvec; bf16* hout; int h_fp8;
    const float* W; int ldw; const float* bias; float* small_out;
    int* cnt; int* tk_e; int* tk_p; float* tk_w;
};
template <int NC>
__device__ __forceinline__ void tok_phase(const TokA& A, LAS unsigned char* lds) {
    const int tid = my_tid(), lane = tid & 63, wave = __builtin_amdgcn_readfirstlane(tid >> 6), G = gridDim.x;
    const int rows_wg = T / G, b = (blockIdx.x * rows_wg) / SEQ;
    const int rpw = rows_wg / 8;
    v4u nx[2][4]; v2u ny[2][4]; unsigned nyb[2][4][4];
#define TOK_LOAD(r2_, row_) do { \
        if (A.xin_bf) { _Pragma("unroll") for (int j = 0; j < 4; ++j) { const v2u w_ = ((const v2u*)((const bf16*)A.xin + (row_) * D))[64 * j + lane]; nx[r2_][j] = (v4u){w_.x, w_.y, 0u, 0u}; } } \
        else { _Pragma("unroll") for (int j = 0; j < 4; ++j) nx[r2_][j] = ((const v4u*)(A.xin + (row_) * D))[64 * j + lane]; } \
        if (A.ymode == 1) { _Pragma("unroll") for (int j = 0; j < 4; ++j) ny[r2_][j] = ((const v2u*)((const bf16*)A.y + (row_) * D))[64 * j + lane]; } \
        else if (A.ymode == 2) { _Pragma("unroll") for (int j = 0; j < 4; ++j) _Pragma("unroll") for (int k = 0; k < 4; ++k) nyb[r2_][j][k] = ((const unsigned*)((const unsigned char*)A.yb + ((row_) * 4 + k) * D))[64 * j + lane]; } } while (0)
    { const size_t r0 = (size_t)blockIdx.x * rows_wg + wave * rpw; TOK_LOAD(0, r0); TOK_LOAD(1, r0 + 1); }
    LAS float* wl = (LAS float*)lds;
    if constexpr (NC > 0) {
        constexpr int CH = NC / 4;
#pragma unroll 8
        for (int idx = tid; idx < 1024 * CH; idx += 512) { const int k = idx / CH, c = idx % CH; const f32x4 v = *(const f32x4*)(A.W + (size_t)k * A.ldw + 4 * c);
            const int s = (((k >> 8) * 4 + (k & 3)) * 64) + ((k >> 2) & 63);
            *(LAS f32x4*)(wl + (c * 1024 + s) * 4) = v; }
    }
    LAS f32x4* vec = (LAS f32x4*)(lds + L_VEC);
    if constexpr (NC == 32) { if (tid < 32) ((LAS unsigned*)(lds + L_CNT))[tid] = 0u; }
    if (tid < 256) {
        if (A.ymode) { vec[tid] = ((const f32x4*)(A.gvec + (size_t)b * 6144))[tid] + 1.0f; vec[256 + tid] = ((const f32x4*)A.gamma)[tid]; vec[512 + tid] = ((const f32x4*)A.beta)[tid]; }
        if (A.hout) { vec[768 + tid] = ((const f32x4*)(A.scvec + (size_t)b * 6144))[tid] + 1.0f; vec[1024 + tid] = ((const f32x4*)(A.shvec + (size_t)b * 6144))[tid]; } }
    __syncthreads();
    if (wave >= 4) __builtin_amdgcn_s_setprio(1);
#pragma unroll 1
    for (int ir = 0; ir < rpw; ir += 2) {
        const size_t row0 = (size_t)blockIdx.x * rows_wg + wave * rpw + ir;
        asm volatile("" ::: "memory");
        float hv[2][16];
        {
            f32x4 v[2][4], yv[2][4];
#pragma unroll
            for (int r2 = 0; r2 < 2; ++r2) {
#pragma unroll
                for (int j = 0; j < 4; ++j) { if (A.xin_bf) v[r2][j] = (f32x4){bflo(nx[r2][j].x), bfhi(nx[r2][j].x), bflo(nx[r2][j].y), bfhi(nx[r2][j].y)}; else v[r2][j] = __builtin_bit_cast(f32x4, nx[r2][j]); }
                if (A.ymode == 1) {
#pragma unroll
                    for (int j = 0; j < 4; ++j) yv[r2][j] = (f32x4){bflo(ny[r2][j].x), bfhi(ny[r2][j].x), bflo(ny[r2][j].y), bfhi(ny[r2][j].y)};
                } else if (A.ymode == 2) {
#pragma unroll
                    for (int j = 0; j < 4; ++j) { f32x4 s = {0.f, 0.f, 0.f, 0.f};
#pragma unroll
                        for (int k = 0; k < 4; ++k) { const int w = (int)nyb[r2][j][k]; const f32x2 lo = __builtin_amdgcn_cvt_pk_f32_fp8(w, false), hi = __builtin_amdgcn_cvt_pk_f32_fp8(w, true); s += (f32x4){lo.x, lo.y, hi.x, hi.y}; }
                        yv[r2][j] = s * 0.0625f; }
                }
            }
            if (ir + 2 < rpw) { TOK_LOAD(0, row0 + 2); TOK_LOAD(1, row0 + 3); }
#pragma unroll
            for (int r2 = 0; r2 < 2; ++r2) { const size_t row = row0 + r2;
                if (A.ymode) {
                    float s = 0.f;
#pragma unroll
                    for (int j = 0; j < 4; ++j) { v[r2][j] = v[r2][j] * ALPHA + vec[64 * j + lane] * yv[r2][j]; s += (v[r2][j].x + v[r2][j].y) + (v[r2][j].z + v[r2][j].w); }
                    const float mean = wave_sum(s) * (1.0f / D); float s2 = 0.f;
#pragma unroll
                    for (int j = 0; j < 4; ++j) { v[r2][j] = v[r2][j] - mean; s2 += (v[r2][j].x * v[r2][j].x + v[r2][j].y * v[r2][j].y) + (v[r2][j].z * v[r2][j].z + v[r2][j].w * v[r2][j].w); }
                    const float rstd = 1.0f / sqrtf(wave_sum(s2) * (1.0f / D) + LN_EPS);
#pragma unroll
                    for (int j = 0; j < 4; ++j) { v[r2][j] = v[r2][j] * rstd * vec[256 + 64 * j + lane] + vec[512 + 64 * j + lane];
                        if (A.xout_bf) { v2u w; w.x = pk2(v[r2][j].x, v[r2][j].y); w.y = pk2(v[r2][j].z, v[r2][j].w); ((v2u*)((bf16*)A.xout + row * D))[64 * j + lane] = w; } else ((f32x4*)(A.xout + row * D))[64 * j + lane] = v[r2][j]; }
                }
                if (A.hout) {
#pragma unroll
                    for (int j = 0; j < 4; ++j) { const f32x4 h = v[r2][j] * vec[768 + 64 * j + lane] + vec[1024 + 64 * j + lane]; hv[r2][4 * j + 0] = h.x; hv[r2][4 * j + 1] = h.y; hv[r2][4 * j + 2] = h.z; hv[r2][4 * j + 3] = h.w;
                        if (A.h_fp8) ((unsigned*)((unsigned char*)A.hout + row * D))[64 * j + lane] = pk4_fp8(h.x, h.y, h.z, h.w);
                        else { v2u w; w.x = pk2(h.x, h.y); w.y = pk2(h.z, h.w); ((v2u*)(A.hout + row * D))[64 * j + lane] = w; } }
                }
                asm volatile("" ::: "memory");
            }
        }
        if constexpr (NC > 0) {
            constexpr int CH = NC / 4, LOGN = (NC == 32) ? 5 : 4;
            float accA[NC], accB[NC]; const LAS float* wlane = wl + lane * 4;
#pragma unroll
            for (int q = 0; q < NC; ++q) { accA[q] = 0.f; accB[q] = 0.f; }
#pragma unroll
            for (int e = 0; e < 16; ++e) {
                if ((e & 1) == 0) asm volatile("" ::: "memory");
#pragma unroll
                for (int c = 0; c < CH; ++c) { const f32x4 wv = *(const LAS f32x4*)(wlane + (c * 1024 + e * 64) * 4);
#pragma unroll
                    for (int q = 0; q < 4; ++q) { asm("v_fmac_f32 %0, %1, %2" : "+v"(accA[4 * c + q]) : "v"(hv[0][e]), "v"(wv[q])); asm("v_fmac_f32 %0, %1, %2" : "+v"(accB[4 * c + q]) : "v"(hv[1][e]), "v"(wv[q])); } } }
#pragma unroll
            for (int r2 = 0; r2 < 2; ++r2) { const size_t row = row0 + r2;
            float acc[NC];
#pragma unroll
            for (int q = 0; q < NC; ++q) acc[q] = r2 ? accB[q] : accA[q];
#pragma unroll
            for (int i = 0; i < NC / 2; ++i) { const auto rr = __builtin_amdgcn_permlane32_swap(__float_as_uint(acc[i]), __float_as_uint(acc[i + NC / 2]), false, false); acc[i] = __uint_as_float(rr[0]) + __uint_as_float(rr[1]); }
            { const bool up = (lane & 16) != 0;
#pragma unroll
              for (int i = 0; i < NC / 4; ++i) { const float keep = up ? acc[i + NC / 4] : acc[i], send = up ? acc[i] : acc[i + NC / 4]; acc[i] = keep + __shfl_xor(send, 16); } }
            { const bool up = (lane & 8) != 0;
#pragma unroll
              for (int i = 0; i < NC / 8; ++i) { const float keep = up ? acc[i + NC / 8] : acc[i], send = up ? acc[i] : acc[i + NC / 8]; acc[i] = keep + dpp_f<0x128>(send); } }
            { const bool up = (lane & 4) != 0;
#pragma unroll
              for (int i = 0; i < NC / 16; ++i) { const float keep = up ? acc[i + NC / 16] : acc[i], send = up ? acc[i] : acc[i + NC / 16]; acc[i] = keep + dpp_f<0x141>(send); } }
            float val;
            if constexpr (NC == 16) { val = acc[0]; val += dpp_f<0x4E>(val); val += dpp_f<0xB1>(val);
                const int col = ((lane >> 5) & 1) * 8 + ((lane >> 4) & 1) * 4 + ((lane >> 3) & 1) * 2 + ((lane >> 2) & 1);
                if ((lane & 3) == 0) A.small_out[row * 16 + col] = val;
            } else { { const bool up = (lane & 2) != 0; const float keep = up ? acc[1] : acc[0], send = up ? acc[0] : acc[1]; val = keep + dpp_f<0x4E>(send); }
                val += dpp_f<0xB1>(val);
                const int col = ((lane >> 5) & 1) * 16 + ((lane >> 4) & 1) * 8 + ((lane >> 3) & 1) * 4 + ((lane >> 2) & 1) * 2 + ((lane >> 1) & 1);
                val += A.bias[col];
                LAS float* lg = (LAS float*)(lds + L_RLIST + 2048) + wave * 48;
                if ((lane & 1) == 0) lg[col] = val;
                f32x4 o[8];
#pragma unroll
                for (int c4 = 0; c4 < 8; ++c4) o[c4] = *(const LAS f32x4*)(lg + 4 * c4);
                int gt = 0, ge = 0;
#pragma unroll
                for (int c4 = 0; c4 < 8; ++c4)
#pragma unroll
                    for (int q = 0; q < 4; ++q) { gt += (o[c4][q] > val) ? 1 : 0; ge += (o[c4][q] >= val) ? 1 : 0; }
                int rank = gt;
                if (__builtin_amdgcn_ballot_w64(ge - gt != 1) != 0ull) {
                    int colx = col; asm volatile("" : "+v"(colx));
                    rank = 0;
#pragma unroll
                    for (int c4 = 0; c4 < 8; ++c4)
#pragma unroll
                        for (int q = 0; q < 4; ++q) rank += ((o[c4][q] > val) | ((o[c4][q] == val) & ((4 * c4 + q) < colx))) ? 1 : 0; }
                if (rank < 4 && (lane & 1) == 0) { lg[32 + rank] = val; ((LAS int*)lg)[36 + rank] = col; }
                if (lane < 4) { const f32x4 tv = *(const LAS f32x4*)(lg + 32); const int ek = ((const LAS int*)lg)[36 + lane];
                    const float e1 = __expf(tv[1] - tv[0]), e2 = __expf(tv[2] - tv[0]), e3 = __expf(tv[3] - tv[0]); const float inv = 1.0f / (1.0f + e1 + e2 + e3);
                    const float wk = (lane == 0 ? 1.0f : lane == 1 ? e1 : lane == 2 ? e2 : e3) * inv;
                    const unsigned lp = __hip_atomic_fetch_add((LAS unsigned*)(lds + L_CNT) + ek, 1u, __ATOMIC_RELAXED, __HIP_MEMORY_SCOPE_WORKGROUP);
                    const int li = (wave * rpw + ir + r2) * 4 + lane; LAS unsigned* rl = (LAS unsigned*)(lds + L_RLIST);
                    rl[li] = (unsigned)ek | (lp << 8); rl[256 + li] = __float_as_uint(wk); }
                asm volatile("" ::: "memory");
            }
            }
        }
    }
    __builtin_amdgcn_s_setprio(0);
    if constexpr (NC == 32) {
        __syncthreads();
        const int tid = my_tid();
        LAS unsigned* hist = (LAS unsigned*)(lds + L_CNT); LAS unsigned* gb = (LAS unsigned*)(lds + L_TS); LAS unsigned* rl = (LAS unsigned*)(lds + L_RLIST);
        if (tid < 32) gb[tid] = __hip_atomic_fetch_add((unsigned*)A.cnt + tid, hist[tid], RLX_AGENT);
        __syncthreads();
        if (tid < rows_wg * 4) { const unsigned v = rl[tid]; const int ek = (int)(v & 0xffu); const size_t gi = (size_t)blockIdx.x * rows_wg * 4 + tid;
            const size_t q = (size_t)ek * T + (gb[ek] + (v >> 8)); A.tk_e[q] = (int)gi; A.tk_w[q] = __uint_as_float(rl[256 + tid]); }
        __syncthreads();
    }
}

typedef float f32x16 __attribute__((ext_vector_type(16)));
typedef short s16x8 __attribute__((ext_vector_type(8)));
typedef short s16x4 __attribute__((ext_vector_type(4)));
constexpr size_t GLA_QD = 0, GLA_KI = 16 * MiB, GLA_KE = 32 * MiB, GLA_DEC = 48 * MiB, GLA_DSEG = 49 * MiB, GLA_SLOC = 50 * MiB;
constexpr int GP = 272, GPV = 528;
__device__ __forceinline__ int crow16(int i, int h) { return (i & 3) + 8 * (i >> 2) + 4 * h; }
__device__ __forceinline__ s16x4 vtr4(const LAS unsigned char* p) { return __builtin_bit_cast(s16x4, __builtin_amdgcn_ds_read_tr16_b64_v4i16((LAS s16x4*)p)); }
__device__ __forceinline__ s16x8 tr_frag(const LAS unsigned char* img, int pitch, int row_lo, int row_hi, int col0, int lane) {
    const int i16 = lane & 15, q = i16 >> 2, p = i16 & 3, blk = (lane >> 4) & 1; const int cb = (col0 + 16 * blk + 4 * p) * 2;
    const s16x4 lo = vtr4(img + (row_lo + q) * pitch + cb), hi = vtr4(img + (row_hi + q) * pitch + cb);
    return (s16x8){lo[0], lo[1], lo[2], lo[3], hi[0], hi[1], hi[2], hi[3]};
}
__device__ __forceinline__ s16x8 tr_frag_b(const LAS unsigned char* base, int off_lo, int off_hi) {
    const s16x4 lo = vtr4(base + off_lo), hi = vtr4(base + off_hi);
    return (s16x8){lo[0], lo[1], lo[2], lo[3], hi[0], hi[1], hi[2], hi[3]};
}
__device__ __forceinline__ s16x8 pack8(const f32x16& x, int s) {
    v4u p; p.x = pk2(x[8 * s], x[8 * s + 1]); p.y = pk2(x[8 * s + 2], x[8 * s + 3]); p.z = pk2(x[8 * s + 4], x[8 * s + 5]); p.w = pk2(x[8 * s + 6], x[8 * s + 7]);
    return __builtin_bit_cast(s16x8, p);
}
#define MFMA32(a, b, c) __builtin_amdgcn_mfma_f32_32x32x16_bf16((a), (b), (c), 0, 0, 0)
__device__ __forceinline__ void gla_state_update(f32x16 (&S)[4], const LAS unsigned char* keL, const LAS unsigned char* vL, const LAS float* decL, int wave, int lane) {
    const int h = lane >> 5;
    const int i16_ = lane & 15, q_ = i16_ >> 2, p_ = i16_ & 3, blk_ = (lane >> 4) & 1;
    const LAS unsigned char* kb = keL + (q_ + 8 * h) * GP + (16 * blk_ + 4 * p_) * 2;
    const LAS unsigned char* vb = vL + (q_ + 8 * h) * GPV + (32 * wave + 16 * blk_ + 4 * p_) * 2;
#pragma unroll
    for (int dt = 0; dt < 4; ++dt)
#pragma unroll
        for (int g4 = 0; g4 < 4; ++g4) { const f32x4 dv = *(const LAS f32x4*)(decL + 32 * dt + 8 * g4 + 4 * h);
#pragma unroll
            for (int q = 0; q < 4; ++q) S[dt][4 * g4 + q] *= dv[q]; }
    s16x8 bv[2], ak[2][4];
#pragma unroll
    for (int s = 0; s < 2; ++s) { bv[s] = tr_frag_b(vb, 16 * s * GPV, (16 * s + 4) * GPV);
#pragma unroll
        for (int dt = 0; dt < 4; ++dt) ak[s][dt] = tr_frag_b(kb, 16 * s * GP + 64 * dt, (16 * s + 4) * GP + 64 * dt); }
#pragma unroll
    for (int s = 0; s < 2; ++s)
#pragma unroll
        for (int dt = 0; dt < 4; ++dt) S[dt] = MFMA32(ak[s][dt], bv[s], S[dt]);
}
__device__ __forceinline__ void gla_g1(const Params& P, LAS unsigned char* lds, int j) {
    const int tid = my_tid(), lane = tid & 63, wave = __builtin_amdgcn_readfirstlane(tid >> 6), G = gridDim.x;
    const bf16* proj = (const bf16*)(P.ws + WS_PROJ); const float* glr = (const float*)(P.ws + WS_SMALL);
    bf16* qdG = (bf16*)(P.ws + WS_MIX + GLA_QD); bf16* kiG = (bf16*)(P.ws + WS_MIX + GLA_KI); bf16* keG = (bf16*)(P.ws + WS_MIX + GLA_KE);
    float* decG = (float*)(P.ws + WS_MIX + GLA_DEC); float* dsegG = (float*)(P.ws + WS_MIX + GLA_DSEG); float* slocG = (float*)(P.ws + WS_MIX + GLA_SLOC);
    const float* wgu = kin(I_GLA_WGU) + (size_t)j * 16 * 512; const float* bg = kin(I_GLA_BG) + (size_t)j * 512;
    LAS float* glrL = (LAS float*)lds;
    LAS float* decL = (LAS float*)(lds + 16384);
    LAS float* blL = (LAS float*)(lds + 16384 + 4096);
    LAS unsigned char* keL = lds + 24576;
    LAS unsigned char* vL = lds + 24576 + 4 * 32 * GP;
    for (int u = blockIdx.x; u < 256; u += G) {
        const int bh = u >> 4, seg = u & 15, b = bh >> 2, hh = bh & 3; const size_t rowS = (size_t)b * SEQ + seg * 256;
        for (int i = tid; i < 1024; i += 512) ((LAS f32x4*)glrL)[i] = ((const f32x4*)(glr + rowS * 16))[i];
        f32x16 S[4];
#pragma unroll
        for (int dt = 0; dt < 4; ++dt)
#pragma unroll
            for (int i = 0; i < 16; ++i) S[dt][i] = 0.f;
        const int d = tid & 127, g = tid >> 7;
        float w[16];
#pragma unroll
        for (int r = 0; r < 16; ++r) w[r] = wgu[r * 512 + hh * 128 + d];
        const float bias = bg[hh * 128 + d];
        __syncthreads();
        for (int rd = 0; rd < 2; ++rd) {
            const int c = rd * 4 + g; const size_t row0 = rowS + c * 32;
            for (int i = tid; i < 4 * 32 * 32; i += 512) { const int cc = i >> 10, t = (i >> 5) & 31, c16 = i & 31;
                *(LAS v4u*)(vL + (cc * 32 + t) * GPV + c16 * 16) = *(const v4u*)(proj + (rowS + (rd * 4 + cc) * 32 + t) * 3072 + 1024 + hh * 256 + c16 * 8); }
            float la[32]; float tot = 0.f;
#pragma unroll
            for (int t = 0; t < 32; ++t) { float lg = bias;
#pragma unroll
                for (int r4 = 0; r4 < 4; ++r4) { const f32x4 gv = *(const LAS f32x4*)(glrL + (c * 32 + t) * 16 + 4 * r4); lg += gv.x * w[4 * r4] + gv.y * w[4 * r4 + 1] + gv.z * w[4 * r4 + 2] + gv.w * w[4 * r4 + 3]; }
                la[t] = (fminf(lg, 0.f) - __logf(1.0f + __expf(-fabsf(lg)))) * (1.0f / 16.0f); tot += la[t]; }
            float cum = 0.f; const float dc0 = __expf(tot);
#pragma unroll
            for (int t = 0; t < 32; ++t) { cum += la[t]; const size_t row = row0 + t;
                const float qv = bf2f(proj[row * 3072 + hh * 128 + d]) * 0.08838834764831845f, kv = bf2f(proj[row * 3072 + 512 + hh * 128 + d]);
                const float ec = __expf(cum), en = __builtin_amdgcn_rcpf(ec), ee = dc0 * en;
                const bf16 kev = f2bf(kv * ee);
                qdG[row * 512 + hh * 128 + d] = f2bf(qv * ec); kiG[row * 512 + hh * 128 + d] = f2bf(kv * en); keG[row * 512 + hh * 128 + d] = kev;
                *(LAS bf16*)(keL + (g * 32 + t) * GP + d * 2) = kev; }
            const float dc = dc0;
            decL[c * 128 + d] = dc; blL[c * 128 + d] = tot; decG[((size_t)(bh * 128 + seg * 8 + c)) * 128 + d] = dc;
            LDS_BARRIER();
#pragma unroll 1
            for (int cc = 0; cc < 4; ++cc) gla_state_update(S, keL + cc * 32 * GP, vL + cc * 32 * GPV, decL + (rd * 4 + cc) * 128, wave, lane);
            LDS_BARRIER();
        }
        if (tid < 128) { float s = 0.f;
#pragma unroll
            for (int c = 0; c < 8; ++c) s += blL[c * 128 + tid];
            __hip_atomic_store(dsegG + (size_t)u * 128 + tid, __expf(s), RLX_AGENT); }
        { const int h = lane >> 5, r = lane & 31; float* sp = slocG + (size_t)u * 128 * 256;
#pragma unroll
          for (int dt = 0; dt < 4; ++dt)
#pragma unroll
              for (int i = 0; i < 16; ++i) __hip_atomic_store(sp + (size_t)(32 * dt + crow16(i, h)) * 256 + 32 * wave + r, S[dt][i], RLX_AGENT); }
        unsigned* cntw = (unsigned*)(P.ws + WS_CTL) + CW_GLA + (j * 16 + bh) * 64;
        asm volatile("s_waitcnt vmcnt(0)" ::: "memory");
        if (lane == 0) __hip_atomic_fetch_add(cntw, 1u, RLX_AGENT);
        if (wave == 0) { unsigned sp_ = 0;
            while ((unsigned)__builtin_amdgcn_readfirstlane((int)__hip_atomic_load(cntw, RLX_AGENT)) < 128u) { __builtin_amdgcn_s_sleep(2); if (++sp_ > (1u << 22)) break; }
            __builtin_amdgcn_fence(__ATOMIC_ACQUIRE, "agent"); asm volatile("s_waitcnt vmcnt(0)" ::: "memory"); }
        __syncthreads();
        { const int dd = seg * 8 + (tid >> 6), e4 = tid & 63; f32x4 run = {0.f, 0.f, 0.f, 0.f};
#pragma unroll 4
          for (int sg = 0; sg < 16; ++sg) { f32x4* p = (f32x4*)(slocG + ((size_t)(bh * 16 + sg) * 128 + dd) * 256) + e4; const f32x4 loc = *p; *p = run;
              run = run * dsegG[(size_t)(bh * 16 + sg) * 128 + dd] + loc; } }
        __syncthreads();
    }
}
__device__ __forceinline__ void gla_g3(const Params& P, LAS unsigned char* lds, int j) {
    const int tid = my_tid(), lane = tid & 63, wave = __builtin_amdgcn_readfirstlane(tid >> 6), G = gridDim.x;
    const int h = lane >> 5, r = lane & 31;
    const bf16* proj = (const bf16*)(P.ws + WS_PROJ); bf16* core = (bf16*)(P.ws + WS_CORE);
    const bf16* qdG = (const bf16*)(P.ws + WS_MIX + GLA_QD); const bf16* kiG = (const bf16*)(P.ws + WS_MIX + GLA_KI); const bf16* keG = (const bf16*)(P.ws + WS_MIX + GLA_KE);
    const float* decG = (const float*)(P.ws + WS_MIX + GLA_DEC); const float* slocG = (const float*)(P.ws + WS_MIX + GLA_SLOC);
    const float* ng = kin(I_GLA_NG) + (size_t)j * 1024;
    LAS unsigned char* qdL = lds; LAS unsigned char* kiL = lds + 32 * GP; LAS unsigned char* keL = lds + 64 * GP; LAS unsigned char* vL = lds + 96 * GP;
    LAS float* decL = (LAS float*)(lds + 96 * GP + 32 * GPV);
    LAS float* ssqL = decL + 128;
    LAS unsigned char* oL = (LAS unsigned char*)(ssqL + 256);
    const LAS unsigned char* vkb = vL + (((lane & 15) >> 2) + 4 * h) * GPV + (32 * wave + 16 * ((lane >> 4) & 1) + 4 * (lane & 3)) * 2;
    for (int u = blockIdx.x; u < 256; u += G) {
        const int bh = u >> 4, seg = u & 15, b = bh >> 2, hh = bh & 3; const size_t rowS = (size_t)b * SEQ + seg * 256;
        f32x16 S[4];
        { const float* sp = slocG + (size_t)u * 128 * 256;
#pragma unroll
          for (int dt = 0; dt < 4; ++dt)
#pragma unroll
              for (int i = 0; i < 16; ++i) S[dt][i] = sp[(size_t)(32 * dt + crow16(i, h)) * 256 + 32 * wave + r]; }
        v4u pq, pk, pe, pv[2], prg[2]; float pd = 0.f;
#define G3_LOAD(c_) do { const size_t r0_ = rowS + (c_) * 32; const int t_ = tid >> 4, c16_ = tid & 15; const size_t go_ = (r0_ + t_) * 512 + hh * 128 + c16_ * 8; \
            pq = *(const v4u*)(qdG + go_); pk = *(const v4u*)(kiG + go_); pe = *(const v4u*)(keG + go_); \
            _Pragma("unroll") for (int k2 = 0; k2 < 2; ++k2) { const int i_ = tid + 512 * k2, tv_ = i_ >> 5, cv_ = i_ & 31; \
                pv[k2] = *(const v4u*)(proj + (r0_ + tv_) * 3072 + 1024 + hh * 256 + cv_ * 8); prg[k2] = *(const v4u*)(proj + (r0_ + tv_) * 3072 + 2048 + hh * 256 + cv_ * 8); } \
            if (tid < 128) pd = decG[((size_t)(bh * 128 + seg * 8 + (c_))) * 128 + tid]; } while (0)
        G3_LOAD(0);
        if (wave >= 4) __builtin_amdgcn_s_setprio(1);
#pragma unroll 1
        for (int c = 0; c < 8; ++c) {
            const size_t row0 = rowS + c * 32;
            { const int t = tid >> 4, c16 = tid & 15;
              *(LAS v4u*)(qdL + t * GP + c16 * 16) = pq; *(LAS v4u*)(kiL + t * GP + c16 * 16) = pk; *(LAS v4u*)(keL + t * GP + c16 * 16) = pe;
#pragma unroll
              for (int k2 = 0; k2 < 2; ++k2) { const int i = tid + 512 * k2, tv = i >> 5, cv = i & 31; *(LAS v4u*)(vL + tv * GPV + cv * 16) = pv[k2]; }
              if (tid < 128) decL[tid] = pd; }
            const v4u rg0 = prg[0], rg1 = prg[1];
            LDS_BARRIER();
            if (c + 1 < 8) G3_LOAD(c + 1);
            f32x16 pt, pt2;
#pragma unroll
            for (int i = 0; i < 16; ++i) { pt[i] = 0.f; pt2[i] = 0.f; }
#pragma unroll
            for (int hb = 0; hb < 2; ++hb) { s16x8 fa[4], fb[4];
#pragma unroll
                for (int q4 = 0; q4 < 4; ++q4) { const int s8 = 4 * hb + q4; fa[q4] = *(const LAS s16x8*)(kiL + r * GP + (16 * s8 + 8 * h) * 2); fb[q4] = *(const LAS s16x8*)(qdL + r * GP + (16 * s8 + 8 * h) * 2); }
                pt = MFMA32(fa[0], fb[0], pt); pt2 = MFMA32(fa[1], fb[1], pt2); pt = MFMA32(fa[2], fb[2], pt); pt2 = MFMA32(fa[3], fb[3], pt2);
                asm volatile("" ::: "memory"); }
            pt = pt + pt2;
#pragma unroll
            for (int i = 0; i < 16; ++i) if (crow16(i, h) > r) pt[i] = 0.f;
            f32x16 o, o2;
#pragma unroll
            for (int i = 0; i < 16; ++i) { o[i] = 0.f; o2[i] = 0.f; }
            { s16x8 av[2], bq[4][2];
#pragma unroll
              for (int s = 0; s < 2; ++s) av[s] = tr_frag_b(vkb, 16 * s * GPV, (16 * s + 8) * GPV);
#pragma unroll
              for (int dt = 0; dt < 4; ++dt)
#pragma unroll
                  for (int s = 0; s < 2; ++s) { const s16x4 lo = *(const LAS s16x4*)(qdL + r * GP + (32 * dt + 16 * s + 4 * h) * 2), hi = *(const LAS s16x4*)(qdL + r * GP + (32 * dt + 16 * s + 8 + 4 * h) * 2);
                      bq[dt][s] = (s16x8){lo[0], lo[1], lo[2], lo[3], hi[0], hi[1], hi[2], hi[3]}; }
              o = MFMA32(av[0], pack8(pt, 0), o); o2 = MFMA32(av[1], pack8(pt, 1), o2);
#pragma unroll
              for (int dt = 0; dt < 4; ++dt) { o = MFMA32(pack8(S[dt], 0), bq[dt][0], o); o2 = MFMA32(pack8(S[dt], 1), bq[dt][1], o2); }
              o = o + o2; }
            gla_state_update(S, keL, vL, decL, wave, lane);
            float ss = 0.f;
#pragma unroll
            for (int i = 0; i < 16; ++i) ss += o[i] * o[i];
            { const auto rr = __builtin_amdgcn_permlane32_swap(__float_as_uint(ss), __float_as_uint(ss), false, false); ss = __uint_as_float(rr[0]) + __uint_as_float(rr[1]); }
            if (h == 0) ssqL[wave * 32 + r] = ss;
            LDS_BARRIER();
            float tot = 0.f;
#pragma unroll
            for (int w8 = 0; w8 < 8; ++w8) tot += ssqL[w8 * 32 + r];
            const float rs = __builtin_amdgcn_rsqf(tot * (1.0f / 256.0f) + LN_EPS);
#pragma unroll
            for (int i = 0; i < 16; ++i) *(LAS bf16*)(oL + r * GPV + (32 * wave + crow16(i, h)) * 2) = f2bf(o[i] * rs);
            LDS_BARRIER();
#pragma unroll
            for (int k2 = 0; k2 < 2; ++k2) { const int i = tid + 512 * k2, t = i >> 5, c8 = i & 31; const size_t row = row0 + t;
                const v4u ov = *(const LAS v4u*)(oL + t * GPV + c8 * 16); const v4u rv = k2 ? rg1 : rg0;
                const f32x4 g0 = *(const f32x4*)(ng + hh * 256 + c8 * 8), g1 = *(const f32x4*)(ng + hh * 256 + c8 * 8 + 4);
                const unsigned ow[4] = {ov.x, ov.y, ov.z, ov.w}, rw[4] = {rv.x, rv.y, rv.z, rv.w}; const float gg[8] = {g0.x, g0.y, g0.z, g0.w, g1.x, g1.y, g1.z, g1.w};
                unsigned res[4];
#pragma unroll
                for (int q = 0; q < 4; ++q) { const float r0 = bflo(rw[q]), r1 = bfhi(rw[q]); res[q] = pk2(bflo(ow[q]) * gg[2 * q] * (r0 * sigmoidf_(r0)), bfhi(ow[q]) * gg[2 * q + 1] * (r1 * sigmoidf_(r1))); }
                *(v4u*)(core + row * 1024 + hh * 256 + c8 * 8) = (v4u){res[0], res[1], res[2], res[3]}; }
            LDS_BARRIER();
        }
        __builtin_amdgcn_s_setprio(0);
    }
}

__device__ __forceinline__ void rg_conv(const Params& P) {
    const int tid = my_tid(), G = gridDim.x;
    const bf16* proj = (const bf16*)(P.ws + WS_PROJ); bf16* xc = (bf16*)(P.ws + WS_Y);
    const float* cw = kin(I_RG_CW); const float* cb = kin(I_RG_CB);
    for (int i = blockIdx.x * 512 + tid; i < (T + 1) * 160; i += G * 512) { const int row = i / 160, c8 = (i % 160) * 8;
        v4u o = {0u, 0u, 0u, 0u};
        if (row < T) { const int t = row % SEQ; float acc[8];
            { const f32x4 b0 = *(const f32x4*)(cb + c8), b1 = *(const f32x4*)(cb + c8 + 4); acc[0] = b0.x; acc[1] = b0.y; acc[2] = b0.z; acc[3] = b0.w; acc[4] = b1.x; acc[5] = b1.y; acc[6] = b1.z; acc[7] = b1.w; }
#pragma unroll
            for (int jx = 0; jx < 4; ++jx) if (t - 3 + jx >= 0) { const v4u xv = *(const v4u*)(proj + (size_t)(row - 3 + jx) * 2560 + 1280 + c8);
                const f32x4 w0 = *(const f32x4*)(cw + jx * 1280 + c8), w1 = *(const f32x4*)(cw + jx * 1280 + c8 + 4);
                acc[0] += w0.x * bflo(xv.x); acc[1] += w0.y * bfhi(xv.x); acc[2] += w0.z * bflo(xv.y); acc[3] += w0.w * bfhi(xv.y);
                acc[4] += w1.x * bflo(xv.z); acc[5] += w1.y * bfhi(xv.z); acc[6] += w1.z * bflo(xv.w); acc[7] += w1.w * bfhi(xv.w); }
            o.x = pk2(acc[0], acc[1]); o.y = pk2(acc[2], acc[3]); o.z = pk2(acc[4], acc[5]); o.w = pk2(acc[6], acc[7]); }
        *(v4u*)(xc + (size_t)row * 1280 + c8) = o; }
}
constexpr int RG_SEG = 128, RG_NSEG = SEQ / RG_SEG;
__device__ __forceinline__ void rg_scan1(const Params& P) {
    const unsigned* AU = (const unsigned*)(P.ws + WS_MIX); float* cP = (float*)(P.ws + WS_SCAN); float* cH = cP + NB * RG_NSEG * 1280;
    for (int idx = blockIdx.x * 512 + threadIdx.x; idx < NB * RG_NSEG * 640; idx += gridDim.x * 512) { const int cp = idx % 640, bs = idx / 640; const size_t row0 = (size_t)bs * RG_SEG;
        float ls0 = 0.f, h0 = 0.f, ls1 = 0.f, h1 = 0.f;
#pragma unroll 16
        for (int t = 0; t < RG_SEG; ++t) { const v2u w = *(const v2u*)(AU + (row0 + t) * 1280 + 2 * cp); const float la0 = bflo(w.x), la1 = bflo(w.y);
            h0 = __expf(la0) * h0 + bfhi(w.x); ls0 += la0; h1 = __expf(la1) * h1 + bfhi(w.y); ls1 += la1; }
        *(f32x2*)(cP + (size_t)bs * 1280 + 2 * cp) = (f32x2){__expf(ls0), __expf(ls1)}; *(f32x2*)(cH + (size_t)bs * 1280 + 2 * cp) = (f32x2){h0, h1}; }
}
__device__ __forceinline__ void rg_scan2(const Params& P) {
    const unsigned* AU = (const unsigned*)(P.ws + WS_MIX); const float* cP = (const float*)(P.ws + WS_SCAN); const float* cH = cP + NB * RG_NSEG * 1280;
    const bf16* proj = (const bf16*)(P.ws + WS_PROJ); bf16* core = (bf16*)(P.ws + WS_CORE);
    for (int idx = blockIdx.x * 512 + threadIdx.x; idx < NB * RG_NSEG * 640; idx += gridDim.x * 512) { const int cp = idx % 640, bs = idx / 640, b = bs / RG_NSEG, sg = bs % RG_NSEG; const size_t row0 = (size_t)bs * RG_SEG;
        float h0 = 0.f, h1 = 0.f;
#pragma unroll 8
        for (int s2 = 0; s2 < sg; ++s2) { const size_t q = (size_t)(b * RG_NSEG + s2) * 1280 + 2 * cp; const f32x2 p2 = *(const f32x2*)(cP + q), c2 = *(const f32x2*)(cH + q); h0 = p2.x * h0 + c2.x; h1 = p2.y * h1 + c2.y; }
#pragma unroll 16
        for (int t = 0; t < RG_SEG; ++t) { const v2u w = *(const v2u*)(AU + (row0 + t) * 1280 + 2 * cp); h0 = __expf(bflo(w.x)) * h0 + bfhi(w.x); h1 = __expf(bflo(w.y)) * h1 + bfhi(w.y);
            const unsigned yb2 = *(const unsigned*)(proj + (row0 + t) * 2560 + 2 * cp);
            *(unsigned*)(core + (row0 + t) * 1280 + 2 * cp) = pk2(h0 * bflo(yb2), h1 * bfhi(yb2)); } }
}

__device__ __forceinline__ void fox_dcum(const Params& P, LAS unsigned char* lds) {
    const int tid = my_tid(), lane = tid & 63, wave = __builtin_amdgcn_readfirstlane(tid >> 6), G = gridDim.x;
    const float* flog = (const float*)(P.ws + WS_SMALL); float* dcum = (float*)(P.ws + WS_DCUM);
    LAS float* sc = (LAS float*)lds;
    for (int u = blockIdx.x; u < 64; u += G) { const int b = u >> 4, h = u & 15; const float bf = kin(I_FOX_BF)[h];
        float loc[8]; float run = 0.f;
#pragma unroll
        for (int i = 0; i < 8; ++i) { run += logsigmoidf_(flog[((size_t)b * SEQ + tid * 8 + i) * 16 + h] + bf); loc[i] = run; }
        float inc = run;
#pragma unroll
        for (int o = 1; o < 64; o <<= 1) { const float nb = __shfl_up(inc, o); if (lane >= o) inc += nb; }
        if (lane == 63) sc[wave] = inc;
        __syncthreads();
        float wbase = 0.f;
#pragma unroll
        for (int w8 = 0; w8 < 8; ++w8) if (w8 < wave) wbase += sc[w8];
        const float base = wbase + inc - run;
#pragma unroll
        for (int i = 0; i < 8; ++i) dcum[(size_t)u * SEQ + tid * 8 + i] = (base + loc[i]) * LOG2E;
        __syncthreads(); }
}
__device__ __forceinline__ void fox_norm_tile(const Params& P, int pm, int pn) {
    const int tid = my_tid(), lane = tid & 63, wave = __builtin_amdgcn_readfirstlane(tid >> 6);
    bf16* proj = (bf16*)(P.ws + WS_PROJ); const int which = pn >> 2; const int d0 = (lane & 3) * 16; const float* gn = kin(which ? I_FOX_KG : I_FOX_QG) + d0;
#pragma unroll 2
    for (int st = 0; st < 8; ++st) { const int row = pm * 256 + st * 32 + wave * 4 + (lane >> 4); bf16* p = proj + (size_t)row * 4096 + pn * 256 + (lane & 15) * 16;
        const v4u w0 = *(const v4u*)p, w1 = *(const v4u*)(p + 8); float f[16];
        f[0] = bflo(w0.x); f[1] = bfhi(w0.x); f[2] = bflo(w0.y); f[3] = bfhi(w0.y); f[4] = bflo(w0.z); f[5] = bfhi(w0.z); f[6] = bflo(w0.w); f[7] = bfhi(w0.w);
        f[8] = bflo(w1.x); f[9] = bfhi(w1.x); f[10] = bflo(w1.y); f[11] = bfhi(w1.y); f[12] = bflo(w1.z); f[13] = bfhi(w1.z); f[14] = bflo(w1.w); f[15] = bfhi(w1.w);
        float ss = 0.f;
#pragma unroll
        for (int i = 0; i < 16; ++i) ss += f[i] * f[i];
        ss += dpp_f<0xB1>(ss); ss += dpp_f<0x4E>(ss);
        const float rs = __builtin_amdgcn_rsqf(ss * (1.0f / 64.0f) + LN_EPS) * (which ? 1.0f : FOX_C2);
        v4u o0, o1; o0.x = pk2(f[0] * rs * gn[0], f[1] * rs * gn[1]); o0.y = pk2(f[2] * rs * gn[2], f[3] * rs * gn[3]); o0.z = pk2(f[4] * rs * gn[4], f[5] * rs * gn[5]); o0.w = pk2(f[6] * rs * gn[6], f[7] * rs * gn[7]);
        o1.x = pk2(f[8] * rs * gn[8], f[9] * rs * gn[9]); o1.y = pk2(f[10] * rs * gn[10], f[11] * rs * gn[11]); o1.z = pk2(f[12] * rs * gn[12], f[13] * rs * gn[13]); o1.w = pk2(f[14] * rs * gn[14], f[15] * rs * gn[15]);
        *(v4u*)p = o0; *(v4u*)(p + 8) = o1; }
}
#include <hip/hip_bf16.h>
#include <cmath>
namespace attn_body {
using bf16=__hip_bfloat16;
using bf16x8=__attribute__((ext_vector_type(8)))short;
using s16x4=__attribute__((ext_vector_type(4)))short;
using f32x16=__attribute__((ext_vector_type(16)))float;
using u32x4=__attribute__((ext_vector_type(4)))unsigned;
constexpr int BATCH=4,NHEAD=16,SEQ=4096,D=64,PIN=4096,POUT=1024;
constexpr int NW=8,QBLK=32,QB=QBLK*NW,KVBLK=64,NQB=SEQ/QB;
constexpr int ATTN_UNIT_ROWS=QB; constexpr int LDS_DTAB=90112;
__device__ __forceinline__ int crow(int r,int hi){return (r&3)+8*(r>>2)+4*hi;}
#define SBAR() __builtin_amdgcn_sched_barrier(0)
__device__ __forceinline__ void cmask(f32x16&p0,f32x16&p1,int jb,int qrel,int hi){
  const float NEG=-INFINITY; int kb=64*jb+4*hi;
  #pragma unroll
  for(int r=0;r<16;++r){int kv=kb+(r&3)+8*(r>>2); if(kv>qrel)p0[r]=NEG; if(kv+32>qrel)p1[r]=NEG;}
}

constexpr int NSLOT=3, SLOTB=8192;
constexpr int LDS_K=0, LDS_V=NSLOT*SLOTB, LDS_WS=2*NSLOT*SLOTB, LDS_OST=LDS_WS+NW*64*4, LDS_BYTES=LDS_OST+NW*4096;
constexpr float C2=0.125f*1.4426950408889634f;
__device__ __forceinline__ void glds16(const void*gsrc,unsigned lds_dst){unsigned keep;
  asm volatile("s_mov_b32 %0, m0\n\ts_mov_b32 m0, %2\n\ts_nop 0\n\tglobal_load_lds_dwordx4 %1, off\n\ts_mov_b32 m0, %0":"=&s"(keep):"v"(gsrc),"s"(lds_dst):"memory");}
__device__ __forceinline__ float max3f(float a,float b,float c){float r;asm("v_max3_f32 %0, %1, %2, %3":"=v"(r):"v"(a),"v"(b),"v"(c));return r;}
__device__ __forceinline__ float max2f(float a,float b){float r;asm("v_max_f32_e32 %0, %1, %2":"=v"(r):"v"(a),"v"(b));return r;}
__device__ __forceinline__ float fadd_s(float a,float b){float r;asm("v_add_f32_e32 %0, %1, %2":"=v"(r):"v"(a),"v"(b));return r;}
__device__ __forceinline__ float fsub_s(float a,float b){float r;asm("v_sub_f32_e32 %0, %1, %2":"=v"(r):"v"(a),"v"(b));return r;}
typedef float f32x2_t __attribute__((ext_vector_type(2))); typedef __bf16 bf16x2_t __attribute__((ext_vector_type(2)));
__device__ __forceinline__ unsigned cvtpk_s(float lo,float hi){f32x2_t v={lo,hi};bf16x2_t b=__builtin_convertvector(v,bf16x2_t);return __builtin_bit_cast(unsigned,b);}
#define WAIT_BAR(N) asm volatile("s_waitcnt vmcnt(" #N ") lgkmcnt(0)\n\ts_barrier":::"memory")

__device__ __forceinline__ void qkt(f32x16&p0,f32x16&p1,const char*Kslot,const bf16x8*qr,int r32,int hi){
  const char*kb=Kslot+hi*1024+r32*16;
  #pragma unroll
  for(int d0=0;d0<4;++d0){
    const bf16x8 b0=*reinterpret_cast<const bf16x8*>(kb+d0*2048);
    const bf16x8 b1=*reinterpret_cast<const bf16x8*>(kb+d0*2048+512);
    p0=__builtin_amdgcn_mfma_f32_32x32x16_bf16(b0,qr[d0],p0,0,0,0);p1=__builtin_amdgcn_mfma_f32_32x32x16_bf16(b1,qr[d0],p1,0,0,0);}
}
typedef __attribute__((address_space(3))) const char* lds_cptr;
typedef __attribute__((address_space(3))) const float* lds_fptr; typedef float f32x4g __attribute__((ext_vector_type(4)));
typedef short v4i16_t __attribute__((ext_vector_type(4)));
__device__ __forceinline__ void kload8(bf16x8*kf,lds_cptr kp){
  kf[0]=*(const __attribute__((address_space(3))) bf16x8*)(kp);      kf[1]=*(const __attribute__((address_space(3))) bf16x8*)(kp+512);
  kf[2]=*(const __attribute__((address_space(3))) bf16x8*)(kp+2048); kf[3]=*(const __attribute__((address_space(3))) bf16x8*)(kp+2560);
  kf[4]=*(const __attribute__((address_space(3))) bf16x8*)(kp+4096); kf[5]=*(const __attribute__((address_space(3))) bf16x8*)(kp+4608);
  kf[6]=*(const __attribute__((address_space(3))) bf16x8*)(kp+6144); kf[7]=*(const __attribute__((address_space(3))) bf16x8*)(kp+6656);
}
__device__ __forceinline__ void kload2(bf16x8*kf,lds_cptr kp,int j){ kf[2*j]=*(const __attribute__((address_space(3))) bf16x8*)(kp+j*2048); kf[2*j+1]=*(const __attribute__((address_space(3))) bf16x8*)(kp+j*2048+512); }
__device__ __forceinline__ s16x4 vtr(lds_cptr p){ return __builtin_bit_cast(s16x4,__builtin_amdgcn_ds_read_tr16_b64_v4i16((__attribute__((address_space(3))) v4i16_t*)p)); }
__device__ __forceinline__ float rowmax(const f32x16&p0,const f32x16&p1){
  float a=max3f(p0[0],p0[1],p1[0]),b=max3f(p0[2],p0[3],p1[1]);a=max3f(a,p1[2],p1[3]);
  #pragma unroll
  for(int r=4;r<16;r+=4){a=max3f(a,p0[r],p0[r+1]);b=max3f(b,p0[r+2],p0[r+3]);a=max3f(a,p1[r],p1[r+1]);b=max3f(b,p1[r+2],p1[r+3]);}
  const float m=max2f(a,b);
  auto rr=__builtin_amdgcn_permlane32_swap(__float_as_uint(m),__float_as_uint(m),false,false);
  return max2f(__uint_as_float(rr[0]),__uint_as_float(rr[1]));
}
__device__ __forceinline__ void pv(f32x16*o,int vb,bf16x8 pa0,bf16x8 pa1,bf16x8 pa2,bf16x8 pa3){
  #pragma unroll
  for(int d0=0;d0<2;++d0){s16x4 lo[4],hi[4];
    #pragma unroll
    for(int ks=0;ks<4;++ks){
      asm volatile("ds_read_b64_tr_b16 %0,%1 offset:%c2":"=&v"(lo[ks]):"v"(vb),"i"(d0*4096+ks*1024):"memory");
      asm volatile("ds_read_b64_tr_b16 %0,%1 offset:%c2":"=&v"(hi[ks]):"v"(vb),"i"(d0*4096+ks*1024+512):"memory");}
    asm volatile("s_waitcnt lgkmcnt(0)":::"memory");SBAR();
    #define PK(k) (bf16x8){lo[k][0],lo[k][1],lo[k][2],lo[k][3],hi[k][0],hi[k][1],hi[k][2],hi[k][3]}
    o[d0]=__builtin_amdgcn_mfma_f32_32x32x16_bf16(pa0,PK(0),o[d0],0,0,0);
    o[d0]=__builtin_amdgcn_mfma_f32_32x32x16_bf16(pa1,PK(1),o[d0],0,0,0);
    o[d0]=__builtin_amdgcn_mfma_f32_32x32x16_bf16(pa2,PK(2),o[d0],0,0,0);
    o[d0]=__builtin_amdgcn_mfma_f32_32x32x16_bf16(pa3,PK(3),o[d0],0,0,0);
    #undef PK
  }
}

#ifndef ATTN_STORE16
#define ATTN_STORE16(p,v) (*(u32x4*)(p)=(v))
#endif
template<int THRL> __device__ __forceinline__ void attn_unit(int b,int h,int qb,const bf16*Q,const bf16* K,const bf16* V,const bf16*OG,const float*DC,bf16*O,char*shm,bool fill){
  const int tid=threadIdx.x,lane=tid&63,r32=lane&31,hi=lane>>5; const int wid=__builtin_amdgcn_readfirstlane(tid>>6);
  const long rowbase=(long)b*SEQ; const int q0=qb*QB;
  const bf16*Qw=Q+(rowbase+q0+wid*QBLK)*PIN+h*D;
  const bf16*Kh=K+rowbase*PIN+h*D,*Vh=V+rowbase*PIN+h*D;
  const unsigned lds0=(unsigned)(uintptr_t)shm;
  float*wsf=(float*)(shm+LDS_WS)+wid*64;
  const bf16*ksrc=Kh+(long)lane*PIN+wid*8;
  const bf16*vsrc=Vh+(long)(16*(wid&3)+(lane>>2))*PIN+(wid>>2)*32+(lane&3)*8;
  const unsigned kdst=lds0+LDS_K+wid*1024, vdst=lds0+LDS_V+wid*1024;
  #define DMA_K(t,slot) glds16(ksrc+(long)(t)*KVBLK*PIN,(unsigned)__builtin_amdgcn_readfirstlane(kdst+(slot)))
  #define DMA_V(t,slot) glds16(vsrc+(long)(t)*KVBLK*PIN,(unsigned)__builtin_amdgcn_readfirstlane(vdst+(slot)))
  const int vb0=(int)(lds0+LDS_V)+((lane>>4)&1)*32+(lane&3)*8+(4*hi+((lane&15)>>2))*64;
  const char*Kbase=shm+LDS_K; bf16x8 kf[8];
  const lds_cptr shm3=(lds_cptr)shm; const lds_cptr kp0=shm3+LDS_K+hi*1024+r32*16; const lds_cptr vp0=shm3+LDS_V+((lane>>4)&1)*32+(lane&3)*8+(4*hi+((lane&15)>>2))*64;
  const int NT=(q0+QB)/KVBLK;
  const lds_fptr dtab=(lds_fptr)(shm3+LDS_DTAB);
  if(fill){ const f32x4g*src=(const f32x4g*)(DC+(long)(b*NHEAD+h)*SEQ); for(int i=tid;i<SEQ/4;i+=NW*64) ((__attribute__((address_space(3))) f32x4g*)dtab)[i]=src[i]; }
  DMA_K(0,0);DMA_V(0,0);DMA_K(1,SLOTB);
  bf16x8 qr[4];
  #pragma unroll
  for(int d0=0;d0<4;++d0)qr[d0]=*reinterpret_cast<const bf16x8*>(&Qw[(long)r32*PIN+d0*16+hi*8]);
  float mhat=0.f,l_reg=0.f;f32x16 o[2];o[0]=f32x16{};o[1]=f32x16{}; float dq=0.f;
  #define BIAS(C0,C1,t) do{ const float base_=dq-mhat; const lds_fptr dk_=dtab+(t)*KVBLK+4*hi; \
    _Pragma("unroll") for(int g_=0;g_<4;++g_){ const f32x4g a_=*(const __attribute__((address_space(3))) f32x4g*)(dk_+8*g_), b_=*(const __attribute__((address_space(3))) f32x4g*)(dk_+32+8*g_); \
      _Pragma("unroll") for(int q_=0;q_<4;++q_){ C0[4*g_+q_]=base_-a_[q_]; C1[4*g_+q_]=base_-b_[q_]; } } }while(0)
  const int qrel=wid*QBLK+r32;
  #define CMASK(P0,P1,t) do{int jb_=(t)-(NT-4); if(jb_>=0)cmask(P0,P1,jb_,qrel,hi);}while(0)
  bool resc=false;
  #define START(P0,P1) do{ const float rm=rowmax(P0,P1); resc=false; \
    { const float dl=rm; mhat=fadd_s(mhat,dl); \
      _Pragma("unroll") for(int r=0;r<16;++r){P0[r]=fsub_s(P0[r],dl);P1[r]=fsub_s(P1[r],dl);} \
      } \
    _Pragma("unroll") for(int r=0;r<16;++r)P0[r]=__builtin_amdgcn_exp2f(P0[r]); }while(0)
  #define RESC() do{ if(resc){ asm volatile("s_waitcnt lgkmcnt(0)":::"memory"); \
      _Pragma("unroll") for(int d_=0;d_<2;++d_) _Pragma("unroll") for(int r=0;r<16;++r)o[d_][r]*=wsf[crow(r,hi)]; } }while(0)
  f32x16 pA0,pA1,pB0,pB1;
  int sl_prev=0,sl_cur=0,sl_next=SLOTB;
  #define ROT() do{sl_prev=sl_cur;sl_cur=sl_next;sl_next=(sl_next==(NSLOT-1)*SLOTB)?0:sl_next+SLOTB;}while(0)
  DMA_K(2,2*SLOTB);
  WAIT_BAR(3);
  dq=dtab[q0+wid*QBLK+r32];
  BIAS(pA0,pA1,0); qkt(pA0,pA1,Kbase,qr,r32,hi);asm volatile("s_nop 15\n\ts_nop 7":"+v"(pA0),"+v"(pA1));CMASK(pA0,pA1,0);
  START(pA0,pA1);
  _Pragma("unroll") for(int r=0;r<16;++r)pA1[r]=__builtin_amdgcn_exp2f(pA1[r]);
  WAIT_BAR(0);
  DMA_K(3,0);DMA_V(1,SLOTB);
  ROT();
  kload8(kf,kp0+sl_cur);
  WAIT_BAR(2);
  s16x4 vlo[8],vhi[8]; u32x4 pw0,pw1,pw2,pw3;
  #define PKW(P,B) cvtpk_s(P[B],P[B+1])
  #define PAF(k) __builtin_bit_cast(bf16x8,pw##k)
  #define VFR(i) (bf16x8){vlo[i][0],vlo[i][1],vlo[i][2],vlo[i][3],vhi[i][0],vhi[i][1],vhi[i][2],vhi[i][3]}
  #define PIN(x) asm volatile("":"+v"(x))
  #define MX3(a,b,c) __builtin_fmaxf(__builtin_fmaxf((a),(b)),(c))
  #define GAPA(MF,A0,A1,A2,A3,W0,W1,PW) do{ MF; sacc+=A0; sacc+=A1; sacc+=A2; sacc+=A3; PIN(sacc); W0; W1; PIN(PW); SBAR(); }while(0)
  #define EX(v) __builtin_amdgcn_exp2f(v)
  #define GAPB(MF,X,B) do{ MF; X[B]=EX(X[B]); X[B+1]=EX(X[B+1]); X[B+2]=EX(X[B+2]); X[B+3]=EX(X[B+3]); PIN(X); SBAR(); }while(0)
  #define VRD(i) do{ vlo[i]=vtr(vp_+(((i)>>2)*4096+((i)&3)*1024)); vhi[i]=vtr(vp_+(((i)>>2)*4096+((i)&3)*1024+512)); }while(0)
  #define KRD(G,j) do{ if(G){ kload2(kf,kp0+sl_next,j); SBAR(); } }while(0)
  #define STEP(C0,C1,P0,P1,t,GK,GV,GL) do{ SBAR(); BIAS(C0,C1,t); SBAR(); \
    const lds_cptr vp_=vp0+sl_prev; \
    VRD(0); SBAR(); float sacc=(P0[0]+P0[1]); \
    GAPA(C0=__builtin_amdgcn_mfma_f32_32x32x16_bf16(kf[0],qr[0],C0,0,0,0), P0[2],P0[3],P0[4],P0[5],     pw0[0]=PKW(P0,0), pw0[1]=PKW(P0,2), pw0); \
    VRD(4); SBAR(); GAPA(C1=__builtin_amdgcn_mfma_f32_32x32x16_bf16(kf[1],qr[0],C1,0,0,0), P0[6],P0[7],P0[8],P0[9],     pw0[2]=PKW(P0,4), pw0[3]=PKW(P0,6), pw0); \
    VRD(1); SBAR(); GAPA(C0=__builtin_amdgcn_mfma_f32_32x32x16_bf16(kf[2],qr[1],C0,0,0,0),   P0[10],P0[11],P0[12],P0[13], pw1[0]=PKW(P0,8), pw1[1]=PKW(P0,10), pw1); \
    VRD(5); SBAR(); GAPA(C1=__builtin_amdgcn_mfma_f32_32x32x16_bf16(kf[3],qr[1],C1,0,0,0),   P0[14],P0[15],P1[0],P1[1],   pw1[2]=PKW(P0,12),pw1[3]=PKW(P0,14), pw1); \
    VRD(2); SBAR(); GAPA(C0=__builtin_amdgcn_mfma_f32_32x32x16_bf16(kf[4],qr[2],C0,0,0,0),   P1[2],P1[3],P1[4],P1[5],     pw2[0]=PKW(P1,0), pw2[1]=PKW(P1,2), pw2); \
    VRD(6); SBAR(); GAPA(C1=__builtin_amdgcn_mfma_f32_32x32x16_bf16(kf[5],qr[2],C1,0,0,0),   P1[6],P1[7],P1[8],P1[9],     pw2[2]=PKW(P1,4), pw2[3]=PKW(P1,6), pw2); \
    VRD(3); SBAR(); GAPA(C0=__builtin_amdgcn_mfma_f32_32x32x16_bf16(kf[6],qr[3],C0,0,0,0),   P1[10],P1[11],P1[12],P1[13], pw3[0]=PKW(P1,8), pw3[1]=PKW(P1,10), pw3); \
    VRD(7); SBAR(); GAPA(C1=__builtin_amdgcn_mfma_f32_32x32x16_bf16(kf[7],qr[3],C1,0,0,0),   P1[14],P1[15],0.f,0.f,       pw3[2]=PKW(P1,12),pw3[3]=PKW(P1,14), pw3); \
    l_reg+=sacc; \
    if(GK){DMA_K((t)+3,sl_cur);} if(GV){DMA_V((t)+1,sl_next);} \
    CMASK(C0,C1,t); \
    { float a=MX3(C0[0],C0[1],C1[0]),b=MX3(C0[2],C0[3],C1[1]); a=MX3(a,C1[2],C1[3]); \
      _Pragma("unroll") for(int r=4;r<16;r+=4){a=MX3(a,C0[r],C0[r+1]);b=MX3(b,C0[r+2],C0[r+3]);a=MX3(a,C1[r],C1[r+1]);b=MX3(b,C1[r+2],C1[r+3]);} \
      float rm=__builtin_fmaxf(a,b); { auto rr=__builtin_amdgcn_permlane32_swap(__float_as_uint(rm),__float_as_uint(rm),false,false); rm=__builtin_fmaxf(__uint_as_float(rr[0]),__uint_as_float(rr[1])); } \
      resc=false; \
      if(__builtin_expect(__any(rm>(float)THRL),0)){ const float dl=__builtin_fmaxf(rm,0.f); mhat+=dl; \
        _Pragma("unroll") for(int r=0;r<16;++r){C0[r]-=dl;C1[r]-=dl;} \
        const float f=__builtin_amdgcn_exp2f(-dl); l_reg*=f; if(hi==0)wsf[r32]=f; resc=true; } } \
    SBAR(); \
    GAPB(o[0]=__builtin_amdgcn_mfma_f32_32x32x16_bf16(PAF(0),VFR(0),o[0],0,0,0), C0,0); \
    GAPB(o[1]=__builtin_amdgcn_mfma_f32_32x32x16_bf16(PAF(0),VFR(4),o[1],0,0,0), C0,4); \
    KRD(GL,0); GAPB(o[0]=__builtin_amdgcn_mfma_f32_32x32x16_bf16(PAF(1),VFR(1),o[0],0,0,0), C0,8); \
    KRD(GL,1); GAPB(o[1]=__builtin_amdgcn_mfma_f32_32x32x16_bf16(PAF(1),VFR(5),o[1],0,0,0), C0,12); \
    KRD(GL,2); GAPB(o[0]=__builtin_amdgcn_mfma_f32_32x32x16_bf16(PAF(2),VFR(2),o[0],0,0,0), C1,0); \
    KRD(GL,3); GAPB(o[1]=__builtin_amdgcn_mfma_f32_32x32x16_bf16(PAF(2),VFR(6),o[1],0,0,0), C1,4); \
    GAPB(o[0]=__builtin_amdgcn_mfma_f32_32x32x16_bf16(PAF(3),VFR(3),o[0],0,0,0), C1,8); \
    GAPB(o[1]=__builtin_amdgcn_mfma_f32_32x32x16_bf16(PAF(3),VFR(7),o[1],0,0,0), C1,12); \
    }while(0)
  int t=1;
  #undef CMASK
  #define CMASK(P0,P1,t) do{}while(0)
  for(;t+5<NT;t+=2){
    STEP(pB0,pB1,pA0,pA1,t,true,true,true);     WAIT_BAR(2); RESC(); ROT();
    STEP(pA0,pA1,pB0,pB1,t+1,true,true,true);   WAIT_BAR(2); RESC(); ROT();
  }
  #undef CMASK
  #define CMASK(P0,P1,t) do{int jb_=(t)-(NT-4); if(jb_>=0)cmask(P0,P1,jb_,qrel,hi);}while(0)
  #define ENDW(tt) do{ if((tt)+3<NT){WAIT_BAR(2);} else if((tt)+2<NT){WAIT_BAR(1);} else {WAIT_BAR(0);} }while(0)
  for(;t+1<NT;t+=2){
    STEP(pB0,pB1,pA0,pA1,t,(t+3<NT),(t+1<NT),(t+1<NT));       ENDW(t);   RESC(); ROT();
    STEP(pA0,pA1,pB0,pB1,t+1,(t+4<NT),(t+2<NT),(t+2<NT));     ENDW(t+1); RESC(); ROT();
  }
  STEP(pB0,pB1,pA0,pA1,NT-1,false,false,false); RESC();
  { float sacc=pB0[0]+pB0[1]; _Pragma("unroll") for(int r=2;r<16;++r)sacc+=pB0[r]; _Pragma("unroll") for(int r=0;r<16;++r)sacc+=pB1[r]; l_reg+=sacc;
    pw0=(u32x4){PKW(pB0,0),PKW(pB0,2),PKW(pB0,4),PKW(pB0,6)};pw1=(u32x4){PKW(pB0,8),PKW(pB0,10),PKW(pB0,12),PKW(pB0,14)};pw2=(u32x4){PKW(pB1,0),PKW(pB1,2),PKW(pB1,4),PKW(pB1,6)};pw3=(u32x4){PKW(pB1,8),PKW(pB1,10),PKW(pB1,12),PKW(pB1,14)};
    SBAR(); pv(o,vb0+sl_cur,PAF(0),PAF(1),PAF(2),PAF(3)); }
  #undef PKW
  #undef PAF
  #undef VFR
  #undef PIN
  #undef MX3
  #undef GAPA
  #undef GAPB
  #undef EX
  #undef VRD
  #undef KRD
  #undef STEP
  #undef ENDW
  {auto rr=__builtin_amdgcn_permlane32_swap(__float_as_uint(l_reg),__float_as_uint(l_reg),false,false);l_reg=__uint_as_float(rr[0])+__uint_as_float(rr[1]);}
  if(hi==0)wsf[32+r32]=l_reg;asm volatile("s_waitcnt lgkmcnt(0)":::"memory");
  float rli[16];
  #pragma unroll
  for(int r=0;r<16;++r)rli[r]=__builtin_amdgcn_rcpf(wsf[32+crow(r,hi)]);
  bf16*Ow=O+(rowbase+q0+wid*QBLK)*POUT+h*D; const bf16*Gw=OG+(rowbase+q0+wid*QBLK)*PIN+h*D;
  { bf16*stg=(bf16*)(shm+LDS_OST)+wid*2048;
    #pragma unroll
    for(int r=0;r<16;++r){const int orow=crow(r,hi);
      #pragma unroll
      for(int d0=0;d0<2;++d0)stg[orow*64+d0*32+r32]=__float2bfloat16(o[d0][r]*rli[r]);}
    asm volatile("s_waitcnt lgkmcnt(0)":::"memory");
    #pragma unroll
    for(int i=0;i<4;++i){const int row=i*8+(lane>>3),ch=lane&7; const u32x4 v=*(const u32x4*)(stg+row*64+ch*8); const u32x4 g=*(const u32x4*)(Gw+(long)row*PIN+ch*8); u32x4 w;
      _Pragma("unroll") for(int q_=0;q_<4;++q_){ const float gl=__uint_as_float(g[q_]<<16),gh=__uint_as_float(g[q_]&0xffff0000u),vl=__uint_as_float(v[q_]<<16),vh=__uint_as_float(v[q_]&0xffff0000u);
        w[q_]=cvtpk_s(vl*__builtin_amdgcn_rcpf(1.f+__builtin_amdgcn_exp2f(-1.4426950408889634f*gl)),vh*__builtin_amdgcn_rcpf(1.f+__builtin_amdgcn_exp2f(-1.4426950408889634f*gh))); }
      ATTN_STORE16(Ow+(long)row*POUT+ch*8,w);} }
  asm volatile("s_waitcnt lgkmcnt(0)\n\ts_barrier":::"memory");
  #undef DMA_K
  #undef DMA_V
  #undef CMASK
  #undef START
  #undef RESC
  #undef ROT
  #undef BIAS
}
constexpr int ATTN_LDS_BYTES=LDS_BYTES;
struct AttnTensors { const bf16* Q; const bf16* K; const bf16* V; const bf16* OG; const float* DC; bf16* O; };
struct AttnUnit { int bh; int qb; };
struct StaticOrder {
  int vcu;
  __device__ __forceinline__ explicit StaticOrder(int grid,int block):vcu((block%8)*(grid/8)+block/8){}
  __device__ __forceinline__ bool next(int i,AttnUnit&u)const{ if(i>=4)return false; const int s=vcu&3; u.bh=vcu>>2; u.qb=(i==0)?s:(i==1)?7-s:(i==2)?8+s:15-s; return true; }
  __device__ __forceinline__ void a_ready(const AttnUnit&)const{}
  __device__ __forceinline__ void done(const AttnUnit&)const{}
};
template<class Sched,int THRL=8> __device__ __forceinline__ void attn_phase(char*lds,const AttnTensors&T,const Sched&S){
  AttnUnit u;
  int last_bh=-1;
  for(int i=0;S.next(i,u);++i){ S.a_ready(u); attn_unit<THRL>(u.bh/NHEAD,u.bh%NHEAD,u.qb,T.Q,T.K,T.V,T.OG,T.DC,T.O,lds,u.bh!=last_bh); last_bh=u.bh; S.done(u); }
}
#undef SBAR
#undef WAIT_BAR
}

__device__ __forceinline__ void moe_tables(const Params& P, LAS unsigned char* lds, int l) {
    LAS int* ts = (LAS int*)(lds + L_TS); LAS int* lc = (LAS int*)(lds + L_CNT);
    const unsigned* cnt = (const unsigned*)(P.ws + WS_CTL) + CW_CNT + 64 * l;
    if (threadIdx.x < 64) { const int ln = (int)threadIdx.x; const int c = ln < 32 ? (int)__hip_atomic_load(cnt + (ln & 31), RLX_AGENT) : 0; const int t = (c + 255) >> 8; int inc = t;
#pragma unroll
        for (int o = 1; o < 32; o <<= 1) { const int nb = __shfl_up(inc, o); if (ln >= o) inc += nb; }
        if (ln < 32) { lc[ln] = c; ts[ln] = inc - t; if (ln == 31) ts[32] = inc; } }
    __syncthreads();
}
__device__ __forceinline__ int moe_units(LAS unsigned char* lds, int NT, int vcu, const int* elist, const float* ewt, const float* bias) {
    const LAS int* ts = (const LAS int*)(lds + L_TS); LAS unsigned* ul = (LAS unsigned*)(lds + L_ULIST); LAS int* nu = (LAS int*)(lds + L_NU);
    { const int G = gridDim.x, total = ts[32] * NT, i = (int)threadIdx.x;
      if (i < 64) { const int L = i * G + vcu;
          if (L < total) { int e = 0;
#pragma unroll 1
              for (int q = 16; q >= 1; q >>= 1) if (ts[e + q] * NT <= L) e += q;
              const int up = L - ts[e] * NT, te = ts[e + 1] - ts[e]; const int nt = up / te, rt = up % te; ul[i] = (unsigned)(ts[e] + rt) | ((unsigned)(e * NT + nt) << 16); } }
      if (i == 0) nu[0] = vcu < total ? (total - vcu + G - 1) / G : 0; }
    __syncthreads();
    const LAS int* lc = (const LAS int*)(lds + L_CNT); const int n = nu[0];
    if (NT == 8) {
        LAS unsigned* tab = (LAS unsigned*)(lds + L_VEC); LAS float* bt = (LAS float*)(lds + L_VEC + 10240);
#pragma unroll 5
        for (int i = threadIdx.x; i < n * 256; i += 512) { const unsigned uw = ul[i >> 8]; const int pm = (int)(uw & 0xffffu), pn = (int)(uw >> 16), e = pn / NT; const int p = (pm - ts[e]) * 256 + (i & 255);
            tab[i] = (p < lc[e]) ? (unsigned)(elist[(size_t)e * T + p] >> 2) * 1024u : 0u; bt[i] = 32.0f * bias[(size_t)pn * 256 + (i & 255)] + ((i & 128) ? 32.0f : 0.0f); }
    } else {
        LAS unsigned* tab = (LAS unsigned*)(lds + L_VEC); LAS float* bt = (LAS float*)(lds + L_VEC + 10240);
#pragma unroll 3
        for (int i = threadIdx.x; i < n * 256; i += 512) { const unsigned uw = ul[i >> 8]; const int pm = (int)(uw & 0xffffu), pn = (int)(uw >> 16), e = pn / NT; const int p = (pm - ts[e]) * 256 + (i & 255);
            int info = -1; float w = 0.f; if (p < lc[e]) { info = elist[(size_t)e * T + p]; w = ewt[(size_t)e * T + p] * 0.25f; }
            tab[2 * i] = (unsigned)info; tab[2 * i + 1] = __float_as_uint(w); bt[i] = 64.0f * bias[(size_t)pn * 256 + (i & 255)]; }
    }
    __syncthreads();
    return nu[0];
}

constexpr int NPH = 46;
__host__ __device__ inline bool phase_active(int ph) { if (ph < 2) return true; const int s = (ph - 2) % 11, kind = ((ph - 2) / 11) % 3; if (s == 1) return kind != 2; if (s == 2) return kind != 0; if (s == 3) return kind != 2; if (s == 4) return kind == 1; if (s == 7) return false; return true; }


#ifndef ONLY
#define ONLY -1
#endif
#ifndef DUP_SEL
#define DUP_SEL 0
#endif
#ifndef PHMASK
#define PHMASK 0xffffffffu
#endif
#define PHM(x) ((ONLY < 0 || ONLY == (x)) && ((PHMASK >> (x)) & 1))
#define IN(k) (PHM(k) && lo <= (k) && (k) < hi)
#define INL(s) (PHM(2 + (s)) && lo <= (base + (s)) && (base + (s)) < hi)
#define SEAM(k) do { if ((k) + 1 < hi && P.use_bar) { xcd_barrier(bar); if (DUP_SEL == 9) xcd_barrier(bar); } } while (0)
#define TOKDUP(NCV, A) do { if (DUP_SEL == 6) { TokA A2 = A; unsigned char* dz = ws + WS_ACT; if (A2.xout) A2.xout = (float*)dz; if (A2.hout) A2.hout = (bf16*)(dz + 64 * MiB); A2.small_out = (float*)(dz + 96 * MiB); A2.tk_e = (int*)(dz + 100 * MiB); A2.tk_p = nullptr; A2.tk_w = (float*)(dz + 104 * MiB); A2.cnt = (int*)(ctl + 65536);     tok_phase<NCV>(A2, lds); __syncthreads(); } tok_phase<NCV>(A, lds); } while (0)
#define NREP(sel) ((DUP_SEL == (sel)) ? 2 : 1)
template <int l>
__device__ __forceinline__ void layer_body(const Params& P, LAS unsigned char* lds, const XcdBarrier& bar, const int vcu) {
    constexpr int kind = l % 3, j = l / 3, base = 2 + 11 * l;
    const int lo = P.ph_lo, hi = P.ph_hi; const int G = gridDim.x, bx = blockIdx.x;
    unsigned char* ws = P.ws; unsigned* ctl = (unsigned*)(ws + WS_CTL);
    float* X = (float*)(ws + WS_X); bf16* Hb = (bf16*)(ws + WS_H); float* Y = (float*)(ws + WS_Y); bf16* proj = (bf16*)(ws + WS_PROJ); bf16* core = (bf16*)(ws + WS_CORE);
    const float* mod = (const float*)(ws + WS_MOD); float* small = (float*)(ws + WS_SMALL);
    int* tke = (int*)(ws + WS_TKE); int* tkp = (int*)(ws + WS_TKP); float* tkw = (float*)(ws + WS_TKW);

        const float* modl = mod + (size_t)l * NB * 6144;
        if (INL(0)) {
            pg8::Gemm g{}; pg8::EpiBf16Plain E{};
            g.A = Hb; g.M = T; g.K = 1024; g.lda = 1024; g.a_pn_stride = 0; E.O = proj;
            if (kind == 0) { g.Bt = (const bf16*)(ws + WT_GLA_IN) + (size_t)j * 3072 * 1024; g.N = 3072; E.ldc = 3072; E.gelu_pn_lt = 0; }
            else if (kind == 1) { g.Bt = (const bf16*)(ws + WT_RG_IN); g.N = 2560; E.ldc = 2560; E.gelu_pn_lt = 5; }
            else { g.Bt = (const bf16*)(ws + WT_FOX_IN); g.N = 4096; E.ldc = 4096; E.gelu_pn_lt = 0; }
            pg8::StaticOrder S; S.init(T, g.N, G, bx);
            if (kind == 2) fox_dcum(P, lds);
            for (int rep = 0; rep < NREP(3); ++rep) pg8::gemm_phase<pg8::EpiBf16Plain, pg8::StaticOrder, true, true>(lds, g, S, E);
            if (kind == 2) {
                __builtin_amdgcn_fence(__ATOMIC_ACQUIRE, "agent"); asm volatile("s_waitcnt vmcnt(0)" ::: "memory");
                pg8::Unit uu; for (int i = 0; S.next(i, uu); ++i) if (uu.pn < 8) fox_norm_tile(P, uu.pm, uu.pn); }
            SEAM(base + 0);
        }
        if (INL(1) && kind != 2) {
            if (kind == 0) { for (int rep = 0; rep < NREP(1); ++rep) gla_g1(P, lds, j); } else if (kind == 1) { for (int rep = 0; rep < NREP(4); ++rep) rg_conv(P); }
            SEAM(base + 1);
        }
        if (INL(2) && kind != 0) {
            if (kind == 1) {
                pg8::Gemm g{}; g.A = (const bf16*)(ws + WS_Y); g.Bt = (const bf16*)(ws + WT_RG_G); g.M = T; g.N = 2560; { int kq = 256; asm volatile("" : "+s"(kq)); g.K = kq; }     g.lda = 1280; g.a_pn_stride = 256;
                pg8::EpiRgGate E{(unsigned*)(ws + WS_MIX), (const bf16*)(ws + WS_Y), kin(I_RG_BRG), kin(I_RG_BIG), kin(I_RG_LAM)};
                pg8::StaticOrder S; S.init(T, 2560, G, bx);
                for (int rep = 0; rep < NREP(4); ++rep) pg8::gemm_phase<pg8::EpiRgGate, pg8::StaticOrder, true, true>(lds, g, S, E);
            } else { const attn_body::AttnTensors AT{(const attn_body::bf16*)proj, (const attn_body::bf16*)(proj + 1024), (const attn_body::bf16*)(proj + 2048), (const attn_body::bf16*)(proj + 3072), (const float*)(ws + WS_DCUM), (attn_body::bf16*)core};
                const attn_body::StaticOrder S(G, bx);
                for (int rep = 0; rep < NREP(2); ++rep) attn_body::attn_phase<attn_body::StaticOrder>((char*)lds, AT, S); }
            SEAM(base + 2);
        }
        if (INL(3) && kind != 2) { if (kind == 0) { for (int rep = 0; rep < NREP(11); ++rep) gla_g3(P, lds, j); } else { for (int rep = 0; rep < NREP(4); ++rep) rg_scan1(P); } SEAM(base + 3); }
        if (INL(4) && kind == 1) { for (int rep = 0; rep < NREP(4); ++rep) rg_scan2(P); SEAM(base + 4); }
        if (INL(5)) {
            pg8::Gemm g{}; g.A = core; g.M = T; g.N = 1024; g.a_pn_stride = 0;
            if (kind == 0) { g.Bt = (const bf16*)(ws + WT_GLA_OUT) + (size_t)j * 1024 * 1024; g.K = 1024; }
            else if (kind == 1) { g.Bt = (const bf16*)(ws + WT_RG_OUT); g.K = 1280; }
            else { g.Bt = (const bf16*)(ws + WT_FOX_OUT); g.K = 1024; }
            g.lda = g.K;
            pg8::EpiBf16Plain E{(bf16*)Y, 1024, 0}; pg8::StaticOrder S; S.init(T, 1024, G, bx);
            for (int rep = 0; rep < NREP(3); ++rep) pg8::gemm_phase<pg8::EpiBf16Plain, pg8::StaticOrder, true, true>(lds, g, S, E);
            SEAM(base + 5);
        }
        if (INL(6)) {
            TokA A{}; A.xin = (l == 0) ? kin(I_X) : X; A.xin_bf = (l != 0); A.xout_bf = 1; A.ymode = 1; A.y = Y; A.gvec = modl + 2048; A.gamma = kin(I_LN_G) + (size_t)(l * 2) * D; A.beta = kin(I_LN_B) + (size_t)(l * 2) * D; A.xout = X;
            A.scvec = modl + 4096; A.shvec = modl + 3072; A.hout = Hb; A.h_fp8 = 1; A.W = kin(I_MOE_WR) + (size_t)l * D * 32; A.ldw = 32; A.bias = kin(I_MOE_BR) + l * 32;
            A.cnt = (int*)(ctl + CW_CNT + 64 * l); A.tk_e = (int*)(ws + WS_ELIST); A.tk_p = nullptr; A.tk_w = (float*)(ws + WS_EWT);
            TOKDUP(32, A); SEAM(base + 6);
        }
        if (INL(8)) {
            moe_tables(P, lds, l); const int n = moe_units(lds, 8, vcu, (const int*)(ws + WS_ELIST), nullptr, (const float*)(ws + WS_BGUP) + (size_t)l * 32 * 2048);
            pg8::Gemm g{}; g.A = Hb; g.Bt = (const bf16*)(ws + WT_GU + (size_t)l * 32 * 2048 * 1024); g.M = NPAD_MAX; g.N = 32 * 2048; { int kq = 512; asm volatile("" : "+s"(kq)); g.K = kq; } g.lda = 512; g.a_pn_stride = 0; g.wscale = 0x7a7a7a7a;
            pg8::EpiSwiglu E{(bf16*)(ws + WS_ACT), (const LAS float*)(lds + L_VEC + 10240)};
            pg8::ListOrder S{(const LAS unsigned*)(lds + L_ULIST), n};
            for (int rep = 0; rep < NREP(3); ++rep) pg8::gemm_phase<pg8::EpiSwiglu, pg8::ListOrder, true, true, true, true>(lds, g, S, E, (const LAS unsigned*)(lds + L_VEC));
            SEAM(base + 8);
        }
        if (INL(9)) {
            moe_tables(P, lds, l); const int n = moe_units(lds, 4, vcu, (const int*)(ws + WS_ELIST), (const float*)(ws + WS_EWT), kin(I_MOE_BDN) + (size_t)l * 32 * 1024);
            pg8::Gemm g{}; g.A = (const bf16*)(ws + WS_ACT); g.Bt = (const bf16*)(ws + WT_DN + (size_t)l * 32 * 1024 * 1024); g.M = NPAD_MAX; g.N = 32 * 1024; { int kq = 512; asm volatile("" : "+s"(kq)); g.K = kq; } g.lda = 512; g.a_pn_stride = 0; g.wscale = 0x79797979;
            pg8::EpiDown E{(bf16*)(ws + WS_YB), (const LAS unsigned*)(lds + L_VEC), (const LAS float*)(lds + L_VEC + 10240)};
            pg8::ListOrder S{(const LAS unsigned*)(lds + L_ULIST), n};
            for (int rep = 0; rep < NREP(3); ++rep) pg8::gemm_phase<pg8::EpiDown, pg8::ListOrder, true, true, false, true>(lds, g, S, E);
            SEAM(base + 9);
        }
        if (INL(10)) {
            TokA A{}; A.xin = X; A.xin_bf = 1; A.xout_bf = (l != 3); A.ymode = 2; A.yb = (const bf16*)(ws + WS_YB); A.gvec = modl + 5120; A.gamma = kin(I_LN_G) + (size_t)(l * 2 + 1) * D; A.beta = kin(I_LN_B) + (size_t)(l * 2 + 1) * D;
            A.xout = (l == 3) ? P.out : X;
            if (l < 3) { const float* modn = mod + (size_t)(l + 1) * NB * 6144; A.scvec = modn + 1024; A.shvec = modn; A.hout = Hb; A.small_out = small;
                const int nk = (l + 1) % 3;
                if (nk == 0) { A.W = kin(I_GLA_WIN) + (size_t)((l + 1) / 3) * 1024 * 3088 + 3072; A.ldw = 3088; TOKDUP(16, A); }
                else if (nk == 2) { A.W = kin(I_FOX_WIN) + 3072; A.ldw = 4112; TOKDUP(16, A); }
                else TOKDUP(0, A);
            } else TOKDUP(0, A);
            SEAM(base + 10);
        }
    }

__global__ void __launch_bounds__(512, 2) mega_fwd(Params P) {
    extern __shared__ __attribute__((aligned(16))) unsigned char lds_raw[];
    LAS unsigned char* lds = (LAS unsigned char*)lds_raw;
    const int tid = my_tid(), G = gridDim.x, bx = blockIdx.x;
    for (int i = tid; i < (LDS_BYTES - CTRL_OFF) / 4; i += 512) ((LAS unsigned*)(lds + CTRL_OFF))[i] = 0u;
    __syncthreads();
    unsigned char* ws = P.ws;
    unsigned* ctl = (unsigned*)(ws + WS_CTL);
    XcdBarrier bar; bar.bar = ctl + CW_BAR; bar.x = 0; bar.st = nullptr;
    if (P.use_bar) bar = xcd_barrier_post(ctl + CW_BAR, (volatile LAS unsigned*)(lds + L_MISC));
    const int vcu = (G % 8 == 0) ? (bx % 8) * (G / 8) + bx / 8 : bx;
    const int lo = P.ph_lo, hi = P.ph_hi;
    float* X = (float*)(ws + WS_X); bf16* Hb = (bf16*)(ws + WS_H); float* Y = (float*)(ws + WS_Y); bf16* proj = (bf16*)(ws + WS_PROJ); bf16* core = (bf16*)(ws + WS_CORE);
    const float* mod = (const float*)(ws + WS_MOD); float* small = (float*)(ws + WS_SMALL);
    int* tke = (int*)(ws + WS_TKE); int* tkp = (int*)(ws + WS_TKP); float* tkw = (float*)(ws + WS_TKW);

    if (IN(0)) { p0_adaln(P, lds); SEAM(0); }
    if (IN(1)) {
        TokA A{}; A.xin = kin(I_X); A.ymode = 0; A.scvec = mod + 1024; A.shvec = mod; A.hout = Hb; A.W = kin(I_GLA_WIN) + 3072; A.ldw = 3088; A.small_out = small;
        tok_phase<16>(A, lds); __syncthreads();
        for (int rep = 0; rep < NREP(5); ++rep) { p0_convert(P, lds); __syncthreads(); }
        SEAM(1);
    }
    layer_body<0>(P, lds, bar, vcu); layer_body<1>(P, lds, bar, vcu); layer_body<2>(P, lds, bar, vcu); layer_body<3>(P, lds, bar, vcu);
#undef IN
#undef INL
#undef SEAM
}

#ifndef MK_ONE_LAUNCH
#define MK_ONE_LAUNCH 1
#endif
extern "C" void kernel_launch(void* const* d_in, const int* in_sizes, int n_in, void* d_out, int out_size, void* d_ws, size_t ws_size, hipStream_t stream) {
    static int grid = 0;
    if (grid == 0) {
        if (n_in != 31 || out_size != T * D || ws_size < WS_END) { fprintf(stderr, "kernel_launch: unexpected shapes (n_in %d out %d ws %zu need %zu)\n", n_in, out_size, ws_size, (size_t)WS_END); grid = -1; return; }
        int dev = 0, cus = 0;
        if (hipGetDevice(&dev) != hipSuccess || hipDeviceGetAttribute(&cus, hipDeviceAttributeMultiprocessorCount, dev) != hipSuccess) { grid = -1; return; }
        if (hipFuncSetAttribute((const void*)mega_fwd, hipFuncAttributeMaxDynamicSharedMemorySize, LDS_BYTES) != hipSuccess) { fprintf(stderr, "kernel_launch: hipFuncSetAttribute failed\n"); grid = -1; return; }
        int per_cu = 0; (void)hipOccupancyMaxActiveBlocksPerMultiprocessor(&per_cu, (const void*)mega_fwd, 512, LDS_BYTES); (void)hipGetLastError();
        if (per_cu < 1) fprintf(stderr, "kernel_launch: occupancy query says %d\n", per_cu);
        grid = 256;
        if (cus != 256) fprintf(stderr, "kernel_launch: built for 256 CUs, device reports %d\n", cus);
    }
    if (grid < 0) return;
    (void)hipMemsetAsync((char*)d_ws + WS_CTL, 0, CTL_ZERO_BYTES, stream);
    Params p{};
    for (int i = 0; i < 31; ++i) p.in[i] = (const float*)d_in[i];
    p.out = (float*)d_out; p.ws = (unsigned char*)d_ws; p.pad = 0;
#if MK_ONE_LAUNCH
    p.ph_lo = 0; p.ph_hi = NPH; p.use_bar = 1;
    hipLaunchKernelGGL(mega_fwd, dim3(grid), dim3(512), LDS_BYTES, stream, p);
#else
    for (int ph = 0; ph < NPH; ++ph) { if (!phase_active(ph)) continue; p.ph_lo = ph; p.ph_hi = ph + 1; p.use_bar = 0;
        hipLaunchKernelGGL(mega_fwd, dim3(grid), dim3(512), LDS_BYTES, stream, p); }
#endif
}
```

```cpp
#include <hip/hip_runtime.h>
#include <cstdio>
#include <cstdint>
__device__ __forceinline__ int my_tid() { int t = (int)threadIdx.x; asm volatile("" : "+v"(t)); return t; }
namespace pg8 {
#define PG8_LAS __attribute__((address_space(3)))
typedef unsigned short bf16_t;
typedef short bf16x8 __attribute__((ext_vector_type(8)));
typedef float f32x4 __attribute__((ext_vector_type(4)));
typedef unsigned u32x4 __attribute__((ext_vector_type(4)));
constexpr int BM = 256, BK = 64, HALF = 128, HTB = HALF * BK * 2  , STAGE_BYTES = 8 * HTB, NXCD = 8, WGM = 8;
__host__ __device__ __forceinline__ int lds_byte(int r, int c) { const int st = (r >> 4) * 2 + (c >> 5), rr = r & 15, cc = c & 31, ob = rr * 64 + cc * 2; return st * 1024 + (ob ^ (((ob >> 9) & 1) << 5)); }
__host__ __device__ __forceinline__ void stage_rc(int b, int& R, int& C) { const int st = b / 1024, sb = b % 1024, swz = sb ^ (((sb >> 9) & 1) << 5); R = (st >> 1) * 16 + swz / 64; C = (st & 1) * 32 + (swz % 64) / 2; }
__host__ __device__ __forceinline__ int perm32(int rho) { const int n = rho >> 4, i = rho & 15; return 8 * (i >> 2) + 4 * n + (i & 3); }

struct Unit { int pm, pn, ui; };
struct Gemm { const bf16_t* A; const bf16_t* Bt; int M, N, K; int lda; size_t a_pn_stride; int wscale; };

struct StaticOrder {
    int nM, nN, nwg, G, c;
    __host__ __device__ void init(int M, int N, int G_, int c_) { nM = M / BM; nN = N / BM; nwg = nM * nN; G = G_; c = c_; }
    __host__ __device__ bool next(int i, Unit& u) const {
        const long L = (long)i * G + c; if (L >= nwg) return false;
        int wgid = (int)L; { const int q = nwg / NXCD, r = nwg % NXCD, xcd = wgid % NXCD, off = wgid / NXCD; wgid = (xcd < r ? xcd * (q + 1) : r * (q + 1) + (xcd - r) * q) + off; }
        const int nig = WGM * nN, gid = wgid / nig, fm = gid * WGM, gsz = (nM - fm) < WGM ? (nM - fm) : WGM;
        u.pm = fm + ((wgid % nig) % gsz); u.pn = (wgid % nig) / gsz; return true;
    }
    __device__ __forceinline__ void a_ready(const Unit&) const {}
    __device__ __forceinline__ void done(const Unit&) const {}
};

__device__ __forceinline__ unsigned cvt_pk_bf16(float lo, float hi) { unsigned r; asm volatile("v_cvt_pk_bf16_f32 %0, %1, %2" : "=v"(r) : "v"(lo), "v"(hi)); return r; }
typedef float f32x2 __attribute__((ext_vector_type(2)));

__device__ __forceinline__ float fast_sigmoid(float x) { return __builtin_amdgcn_rcpf(1.0f + __builtin_amdgcn_exp2f(-1.4426950408889634f * x)); }
__device__ __forceinline__ float gelu_tanh(float x) { const float u = 0.7978845608028654f * (x + 0.044715f * x * x * x); return x * fast_sigmoid(2.0f * u); }
struct EpiBf16Plain {
    static constexpr bool PERM = true, AFTER_DRAIN = false, BIAS_INIT = false;
    bf16_t* O; int ldc; int gelu_pn_lt;
    __device__ __forceinline__ void operator()(const f32x4 (&acc)[2][2][4][2], const Unit& u, int wr, int wc, int fr, int fq) const {
        const int row0 = u.pm * BM + wr * 64 + fr, col0 = u.pn * BM + wc * 32 + 8 * fq; const bool g = u.pn < gelu_pn_lt;
#pragma unroll
        for (int ai = 0; ai < 2; ++ai)
#pragma unroll
            for (int m = 0; m < 4; ++m) { bf16_t* rowp = O + (size_t)(row0 + ai * HALF + m * 16) * ldc + col0;
#pragma unroll
                for (int bj = 0; bj < 2; ++bj) { f32x4 v0 = acc[ai][bj][m][0], v1 = acc[ai][bj][m][1];
                    if (g) {
#pragma unroll
                        for (int q = 0; q < 4; ++q) { v0[q] = gelu_tanh(v0[q]); v1[q] = gelu_tanh(v1[q]); } }
                    u32x4 w; w.x = cvt_pk_bf16(v0[0], v0[1]); w.y = cvt_pk_bf16(v0[2], v0[3]); w.z = cvt_pk_bf16(v1[0], v1[1]); w.w = cvt_pk_bf16(v1[2], v1[3]);
                    *(u32x4*)(rowp + bj * HALF) = w; } }
    }
};
struct EpiSwiglu {
    static constexpr bool PERM = true, AFTER_DRAIN = false, BIAS_INIT = true;
    bf16_t* act; const PG8_LAS float* bl;
    __device__ __forceinline__ void bias_init(f32x4 (&b)[2][2], const Unit& u, int wc, int fq) const { const PG8_LAS float* bp = bl + u.ui * 256 + wc * 32 + 8 * fq;
#pragma unroll
        for (int bj = 0; bj < 2; ++bj)
#pragma unroll
            for (int n = 0; n < 2; ++n) b[bj][n] = *(const PG8_LAS f32x4*)(bp + bj * HALF + 4 * n); }
    __device__ __forceinline__ void operator()(const f32x4 (&acc)[2][2][4][2], const Unit& u, int wr, int wc, int fr, int fq) const {
        const int nt = u.pn & 7; const int row0 = u.pm * BM + wr * 64 + fr, cl = wc * 32 + 8 * fq, colo = nt * 128 + cl;
#pragma unroll
        for (int ai = 0; ai < 2; ++ai)
#pragma unroll
            for (int m = 0; m < 4; ++m) { unsigned char* rowp = (unsigned char*)act + (size_t)(row0 + ai * HALF + m * 16) * 1024 + colo;
                float o[8];
#pragma unroll
                for (int n = 0; n < 2; ++n) { const f32x4 G = acc[ai][0][m][n], U = acc[ai][1][m][n]; f32x4 gc, uc, ex, r;
#pragma unroll
                    for (int q = 0; q < 4; ++q) { gc[q] = __builtin_amdgcn_fmed3f(G[q], -3.0e38f, 224.0f); uc[q] = __builtin_amdgcn_fmed3f(U[q], -192.0f, 256.0f); }
                    const f32x4 ea = gc * -0.07673331611f + 10.0f;
#pragma unroll
                    for (int q = 0; q < 4; ++q) ex[q] = __builtin_amdgcn_exp2f(ea[q]);
                    const f32x4 den = ex + 1024.0f;
#pragma unroll
                    for (int q = 0; q < 4; ++q) r[q] = __builtin_amdgcn_rcpf(den[q]);
                    const f32x4 o4 = uc * gc * r;
#pragma unroll
                    for (int q = 0; q < 4; ++q) o[n * 4 + q] = o4[q]; }
                int p0 = 0, p1 = 0; p0 = __builtin_amdgcn_cvt_pk_fp8_f32(o[0], o[1], p0, false); p0 = __builtin_amdgcn_cvt_pk_fp8_f32(o[2], o[3], p0, true); p1 = __builtin_amdgcn_cvt_pk_fp8_f32(o[4], o[5], p1, false); p1 = __builtin_amdgcn_cvt_pk_fp8_f32(o[6], o[7], p1, true);
                typedef unsigned u32x2_ __attribute__((ext_vector_type(2))); *(u32x2_*)rowp = (u32x2_){(unsigned)p0, (unsigned)p1}; }
    }
};
struct EpiDown {
    static constexpr bool PERM = true, AFTER_DRAIN = false, BIAS_INIT = true;
    bf16_t* yb; const PG8_LAS unsigned* rt; const PG8_LAS float* bl;
    __device__ __forceinline__ void bias_init(f32x4 (&b)[2][2], const Unit& u, int wc, int fq) const { const PG8_LAS float* bp = bl + u.ui * 256 + wc * 32 + 8 * fq;
#pragma unroll
        for (int bj = 0; bj < 2; ++bj)
#pragma unroll
            for (int n = 0; n < 2; ++n) b[bj][n] = *(const PG8_LAS f32x4*)(bp + bj * HALF + 4 * n); }
    __device__ __forceinline__ void operator()(const f32x4 (&acc)[2][2][4][2], const Unit& u, int wr, int wc, int fr, int fq) const {
        const int nt = u.pn & 3; const int cl = wc * 32 + 8 * fq, col0 = nt * 256 + cl;
        typedef unsigned u32x2_ __attribute__((ext_vector_type(2)));
        const PG8_LAS unsigned* rp = rt + (u.ui * 256 + wr * 64 + fr) * 2;
#pragma unroll
        for (int ai = 0; ai < 2; ++ai)
#pragma unroll
            for (int m = 0; m < 4; ++m) { const u32x2_ iw = *(const PG8_LAS u32x2_*)(rp + (ai * HALF + m * 16) * 2); const int info = (int)iw.x; const float w = __uint_as_float(iw.y);
                if (info >= 0) { unsigned char* rowp = (unsigned char*)yb + (size_t)info * 1024 + col0;
#pragma unroll
                    for (int bj = 0; bj < 2; ++bj) {
                        const f32x4 v0 = acc[ai][bj][m][0] * w, v1 = acc[ai][bj][m][1] * w;
                        f32x4 c0, c1;
#pragma unroll
                        for (int q_ = 0; q_ < 4; ++q_) { c0[q_] = __builtin_amdgcn_fmed3f(v0[q_], -440.f, 440.f); c1[q_] = __builtin_amdgcn_fmed3f(v1[q_], -440.f, 440.f); }
                        int q0 = 0, q1 = 0; q0 = __builtin_amdgcn_cvt_pk_fp8_f32(c0[0], c0[1], q0, false); q0 = __builtin_amdgcn_cvt_pk_fp8_f32(c0[2], c0[3], q0, true); q1 = __builtin_amdgcn_cvt_pk_fp8_f32(c1[0], c1[1], q1, false); q1 = __builtin_amdgcn_cvt_pk_fp8_f32(c1[2], c1[3], q1, true);
                        *(u32x2_*)(rowp + bj * HALF) = (u32x2_){(unsigned)q0, (unsigned)q1}; } } }
    }
};
struct EpiRgGate {
    static constexpr bool PERM = false, AFTER_DRAIN = false, BIAS_INIT = false;
    unsigned* AU; const bf16_t* xc; const float* brg; const float* big; const float* lam;
    __device__ __forceinline__ void operator()(const f32x4 (&acc)[2][2][4][2], const Unit& u, int wr, int wc, int fr, int fq) const {
        const int row0 = u.pm * BM + wr * 64 + fr, ch0 = u.pn * 128 + wc * 32 + 4 * fq;
        unsigned long long xw[2][2][4];
#pragma unroll
        for (int n = 0; n < 2; ++n)
#pragma unroll
            for (int ai = 0; ai < 2; ++ai)
#pragma unroll
                for (int m = 0; m < 4; ++m) xw[n][ai][m] = *(const unsigned long long*)(xc + (size_t)(row0 + ai * HALF + m * 16) * 1280 + ch0 + 16 * n);
#pragma unroll
        for (int n = 0; n < 2; ++n) { const int ch = ch0 + 16 * n;
            const f32x4 br = *(const f32x4*)(brg + ch), bi = *(const f32x4*)(big + ch), lm = *(const f32x4*)(lam + ch); f32x4 sp;
#pragma unroll
            for (int q = 0; q < 4; ++q) sp[q] = lm[q] < -20.f ? -lm[q] : log1pf(__expf(-lm[q]));
#pragma unroll
            for (int ai = 0; ai < 2; ++ai)
#pragma unroll
                for (int m = 0; m < 4; ++m) { const size_t row = (size_t)(row0 + ai * HALF + m * 16);
                    const unsigned long long xq = xw[n][ai][m];
                    const float xv[4] = {__uint_as_float((unsigned)xq << 16), __uint_as_float((unsigned)xq & 0xffff0000u), __uint_as_float((unsigned)(xq >> 32) << 16), __uint_as_float((unsigned)(xq >> 32) & 0xffff0000u)};
                    u32x4 au;
#pragma unroll
                    for (int q = 0; q < 4; ++q) { const float rr = fast_sigmoid(acc[ai][0][m][n][q] + br[q]), ii = fast_sigmoid(acc[ai][1][m][n][q] + bi[q]); const float la = -8.0f * rr * sp[q];
                        const float x2 = 2.0f * la; const float om = x2 > -0.01f ? -x2 * (1.0f + x2 * (0.5f + x2 * 0.16666667f)) : 1.0f - __expf(x2);
                        au[q] = cvt_pk_bf16(la, __builtin_amdgcn_sqrtf(om) * (ii * xv[q])); }
                    *(u32x4*)(AU + row * 1280 + ch) = au; } }
    }
};
struct ListOrder {
    const PG8_LAS unsigned* list; int n;
    __device__ __forceinline__ bool next(int i, Unit& u) const { if (i >= n) return false; const unsigned v = (unsigned)__builtin_amdgcn_readfirstlane((int)list[i]); u.pm = (int)(v & 0xffffu); u.pn = (int)(v >> 16); u.ui = i; return true; }
    __device__ __forceinline__ void a_ready(const Unit&) const {}
    __device__ __forceinline__ void done(const Unit&) const {}
};
template <class Epi, class Sched, bool ALIGN_EPI = false, bool SP2 = false, bool GATHER = false, bool FP8 = false>
__device__ __forceinline__ void gemm_phase(PG8_LAS unsigned char* lds, const Gemm g, const Sched& S, const Epi& E, const PG8_LAS unsigned* gtab = nullptr) {
    const int tid = my_tid(), wid = __builtin_amdgcn_readfirstlane(tid >> 6), lane = tid & 63, wr = wid >> 2, wc = wid & 3, fr = lane & 15, fq = lane >> 4;
    const int K = g.K, nt = K / BK;
    unsigned voffA[2], voffB[2];
#pragma unroll
    for (int i = 0; i < 2; ++i) { int R, C; stage_rc(tid * 16 + i * 8192, R, C); const int Rb = Epi::PERM ? ((R & ~31) + perm32(R & 31)) : R;
        voffA[i] = (unsigned)(R * g.lda + C) * 2u; voffB[i] = (unsigned)(Rb * K + C) * 2u; }
    const size_t kstep = (size_t)(BK * 2);
    const size_t hstepA = (size_t)HALF * g.lda * 2, hstepB = (size_t)HALF * K * 2;
    const size_t tstepA = 2 * hstepA, tstepB = 2 * hstepB;
    const unsigned ldsw = (unsigned)wid * 1024u;
    const int aoff = lds_byte(wr * 64 + fr, fq * 8), boff = lds_byte(wc * 32 + fr, fq * 8);
#define PG8_SA(b, h) (((b) * 2 + (h)) * HTB)
#define PG8_SB(b, h) ((4 + (b) * 2 + (h)) * HTB)
#define PG8_STAGE(bufoff, gbase, voff) do { _Pragma("unroll") for (int _i = 0; _i < 2; ++_i) { unsigned o_ = (voff)[_i]; asm volatile("" : "+v"(o_));     \
        __builtin_amdgcn_global_load_lds((const unsigned*)((const char*)(gbase) + o_), (PG8_LAS unsigned*)(lds + (bufoff) + ldsw + _i * 8192), 16, 0, 0); } } while (0)
#define PG8_LDA(dst, b, h) do { _Pragma("unroll") for (int m = 0; m < 4; ++m) { dst[m].lo = *(const PG8_LAS bf16x8*)(lds + PG8_SA(b, h) + aoff + m * 2048); dst[m].hi = *(const PG8_LAS bf16x8*)(lds + PG8_SA(b, h) + aoff + m * 2048 + 1024); } } while (0)
#define PG8_LDB(dst, b, h) do { _Pragma("unroll") for (int n = 0; n < 2; ++n) { dst[n].lo = *(const PG8_LAS bf16x8*)(lds + PG8_SB(b, h) + boff + n * 2048); dst[n].hi = *(const PG8_LAS bf16x8*)(lds + PG8_SB(b, h) + boff + n * 2048 + 1024); } } while (0)
#define PG8_MMA(ai, bj, At, Bt) do { __builtin_amdgcn_s_setprio(1); \
        if constexpr (FP8) { typedef int v8i_ __attribute__((ext_vector_type(8))); \
            _Pragma("unroll") for (int m = 0; m < 4; ++m) _Pragma("unroll") for (int n = 0; n < 2; ++n) \
                acc[ai][bj][m][n] = __builtin_amdgcn_mfma_scale_f32_16x16x128_f8f6f4(__builtin_bit_cast(v8i_, Bt[n]), __builtin_bit_cast(v8i_, At[m]), acc[ai][bj][m][n], 0, 0, 0, 0, 0, 0);     \
        } else { _Pragma("unroll") for (int m = 0; m < 4; ++m) _Pragma("unroll") for (int n = 0; n < 2; ++n) { \
            acc[ai][bj][m][n] = __builtin_amdgcn_mfma_f32_16x16x32_bf16(Bt[n].lo, At[m].lo, acc[ai][bj][m][n], 0, 0, 0); \
            acc[ai][bj][m][n] = __builtin_amdgcn_mfma_f32_16x16x32_bf16(Bt[n].hi, At[m].hi, acc[ai][bj][m][n], 0, 0, 0); } } __builtin_amdgcn_s_setprio(0); } while (0)
#define PG8_WAIT_V(n) asm volatile("s_waitcnt vmcnt(" #n ")" ::: "memory")
#define PG8_WAIT_L(n) asm volatile("s_waitcnt lgkmcnt(" #n ")" ::: "memory")
#define PG8_BAR __builtin_amdgcn_s_barrier()
#define PG8_SCHED __builtin_amdgcn_sched_barrier(0)
    Unit cur, nxt; int ui = 0;
    if (!S.next(0, cur)) return;
    f32x4 acc[2][2][4][2];
#define PG8_ACC_INIT(unit_) do { f32x4 i_[2][2]; if constexpr (Epi::BIAS_INIT) { int t3_ = (int)threadIdx.x; asm volatile("" : "+v"(t3_)); E.bias_init(i_, unit_, wc, (t3_ & 63) >> 4); } \
        else { _Pragma("unroll") for (int b = 0; b < 2; ++b) _Pragma("unroll") for (int n = 0; n < 2; ++n) i_[b][n] = (f32x4){0.f, 0.f, 0.f, 0.f}; } \
        _Pragma("unroll") for (int a = 0; a < 2; ++a) _Pragma("unroll") for (int b = 0; b < 2; ++b) _Pragma("unroll") for (int m = 0; m < 4; ++m) _Pragma("unroll") for (int n = 0; n < 2; ++n) acc[a][b][m][n] = i_[b][n]; } while (0)
    PG8_ACC_INIT(cur);
    typedef short bf16x16 __attribute__((ext_vector_type(16)));
    bf16x16 At[4], B0[2], B1[2];
    const char* cA = GATHER ? (const char*)g.A : (const char*)g.A + (size_t)cur.pm * tstepA + (size_t)cur.pn * g.a_pn_stride;
    unsigned gvc[2][2];
#define PG8_GLOAD(dst, ui_) do { int t_ = (int)threadIdx.x; asm volatile("" : "+v"(t_));     \
        _Pragma("unroll") for (int i_ = 0; i_ < 2; ++i_) { int R_, C_; stage_rc(t_ * 16 + i_ * 8192, R_, C_); \
            _Pragma("unroll") for (int h_ = 0; h_ < 2; ++h_) dst[h_][i_] = gtab[(ui_) * 256 + h_ * HALF + R_] + (unsigned)C_ * 2u; } } while (0)
#define PG8_AH(p, h) (GATHER ? (p) : (p) + (h) * hstepA)
    if constexpr (GATHER) { PG8_GLOAD(gvc, 0); }
    else { _Pragma("unroll") for (int h_ = 0; h_ < 2; ++h_) _Pragma("unroll") for (int i_ = 0; i_ < 2; ++i_) gvc[h_][i_] = voffA[i_]; }
    const char* cB = (const char*)g.Bt + (size_t)cur.pn * tstepB;
    S.a_ready(cur);
    if constexpr (SP2) {
        PG8_STAGE(PG8_SB(0, 0), cB, voffB); PG8_STAGE(PG8_SB(0, 1), cB + hstepB, voffB); PG8_STAGE(PG8_SA(0, 0), cA, gvc[0]); PG8_STAGE(PG8_SA(0, 1), PG8_AH(cA, 1), gvc[1]);
        if (wr == 1) PG8_BAR;
        PG8_WAIT_V(2); PG8_BAR;
        PG8_STAGE(PG8_SB(1, 0), cB + kstep, voffB); PG8_STAGE(PG8_SA(1, 0), cA + kstep, gvc[0]); PG8_STAGE(PG8_SB(1, 1), cB + hstepB + kstep, voffB);
        PG8_WAIT_V(6); PG8_BAR;
    } else {
        PG8_STAGE(PG8_SB(0, 0), cB, voffB); PG8_STAGE(PG8_SA(0, 0), cA, gvc[0]); PG8_STAGE(PG8_SB(0, 1), cB + hstepB, voffB); PG8_STAGE(PG8_SA(0, 1), PG8_AH(cA, 1), gvc[1]);
        if (wr == 1) PG8_BAR;
        PG8_WAIT_V(4); PG8_BAR;
        PG8_STAGE(PG8_SB(1, 0), cB + kstep, voffB); PG8_STAGE(PG8_SA(1, 0), cA + kstep, gvc[0]); PG8_STAGE(PG8_SB(1, 1), cB + hstepB + kstep, voffB);
        PG8_WAIT_V(6); PG8_BAR;
    }
    for (;;) {
        const bool has_next = S.next(ui + 1, nxt);
        const char* nA = GATHER ? cA : (has_next ? (const char*)g.A + (size_t)nxt.pm * tstepA + (size_t)nxt.pn * g.a_pn_stride : cA);
        const char* nB = has_next ? (const char*)g.Bt + (size_t)nxt.pn * tstepB : cB;
        for (int t = 0; t < nt; t += 2) {
            const bool last = (t == nt - 2);
            const char* a1 = cA + (size_t)(t + 1) * kstep;
            const char* a2 = last ? (GATHER ? (const char*)g.A : nA) : cA + (size_t)(t + 2) * kstep; const char* b2 = last ? nB : cB + (size_t)(t + 2) * kstep;
            const char* a3 = a2 + kstep; const char* b3 = b2 + kstep;
            if (last && has_next) S.a_ready(nxt);
            if constexpr (SP2) {
            PG8_LDB(B0, 0, 0); PG8_LDB(B1, 0, 1); PG8_SCHED; PG8_LDA(At, 0, 0); PG8_STAGE(PG8_SA(1, 1), PG8_AH(a1, 1), gvc[1]); if constexpr (GATHER) { if (last && has_next) PG8_GLOAD(gvc, ui + 1); }
            PG8_WAIT_V(8); PG8_WAIT_L(0); PG8_BAR; PG8_MMA(0, 0, At, B0); PG8_MMA(0, 1, At, B1); PG8_BAR; PG8_SCHED;
            PG8_LDA(At, 0, 1); PG8_STAGE(PG8_SB(0, 0), b2, voffB); PG8_STAGE(PG8_SB(0, 1), b2 + hstepB, voffB); PG8_STAGE(PG8_SA(0, 0), a2, gvc[0]);
            PG8_WAIT_V(8); PG8_WAIT_L(0); PG8_BAR; PG8_MMA(1, 0, At, B0); PG8_MMA(1, 1, At, B1); PG8_BAR; PG8_SCHED;
            PG8_LDB(B0, 1, 0); PG8_LDB(B1, 1, 1); PG8_SCHED; PG8_LDA(At, 1, 0); PG8_STAGE(PG8_SA(0, 1), PG8_AH(a2, 1), gvc[1]);
            PG8_WAIT_V(8); PG8_WAIT_L(0); PG8_BAR; PG8_MMA(0, 0, At, B0); PG8_MMA(0, 1, At, B1); PG8_BAR; PG8_SCHED;
            PG8_LDA(At, 1, 1); PG8_STAGE(PG8_SB(1, 0), b3, voffB); PG8_STAGE(PG8_SB(1, 1), b3 + hstepB, voffB); PG8_STAGE(PG8_SA(1, 0), a3, gvc[0]);
            PG8_WAIT_V(8); PG8_WAIT_L(0); PG8_BAR; PG8_MMA(1, 0, At, B0); PG8_MMA(1, 1, At, B1); PG8_BAR; PG8_SCHED;
            } else {
            PG8_LDB(B0, 0, 0); PG8_SCHED; PG8_LDA(At, 0, 0); PG8_STAGE(PG8_SA(1, 1), PG8_AH(a1, 1), gvc[1]); if constexpr (GATHER) { if (last && has_next) PG8_GLOAD(gvc, ui + 1); }
            PG8_WAIT_L(8); PG8_BAR; PG8_WAIT_L(0); PG8_MMA(0, 0, At, B0); PG8_BAR; PG8_SCHED;
            PG8_LDB(B1, 0, 1); PG8_STAGE(PG8_SB(0, 0), b2, voffB);
            PG8_BAR; PG8_WAIT_L(0); PG8_MMA(0, 1, At, B1); PG8_BAR;
            PG8_LDA(At, 0, 1); PG8_STAGE(PG8_SA(0, 0), a2, gvc[0]);
            PG8_BAR; PG8_WAIT_L(0); PG8_MMA(1, 0, At, B0); PG8_BAR; PG8_SCHED;
            PG8_STAGE(PG8_SB(0, 1), b2 + hstepB, voffB);
            PG8_WAIT_V(6); PG8_BAR; PG8_MMA(1, 1, At, B1); PG8_BAR;
            PG8_LDB(B0, 1, 0); PG8_SCHED; PG8_LDA(At, 1, 0); PG8_STAGE(PG8_SA(0, 1), PG8_AH(a2, 1), gvc[1]);
            PG8_WAIT_L(8); PG8_BAR; PG8_WAIT_L(0); PG8_MMA(0, 0, At, B0); PG8_BAR; PG8_SCHED;
            PG8_LDB(B1, 1, 1); PG8_STAGE(PG8_SB(1, 0), b3, voffB);
            PG8_BAR; PG8_WAIT_L(0); PG8_MMA(0, 1, At, B1); PG8_BAR;
            PG8_LDA(At, 1, 1); PG8_STAGE(PG8_SA(1, 0), a3, gvc[0]);
            PG8_BAR; PG8_WAIT_L(0); PG8_MMA(1, 0, At, B0); PG8_BAR; PG8_SCHED;
            PG8_STAGE(PG8_SB(1, 1), b3 + hstepB, voffB);
            PG8_WAIT_V(6); PG8_BAR; PG8_MMA(1, 1, At, B1); PG8_BAR;
            }
        }
        if constexpr (ALIGN_EPI) { if (wr == 0) PG8_BAR; }
        if constexpr (!Epi::AFTER_DRAIN) { int t2_ = (int)threadIdx.x; asm volatile("" : "+v"(t2_));
            const int l2_ = t2_ & 63; E(acc, cur, wr, wc, l2_ & 15, l2_ >> 4); S.done(cur); }
        if (!has_next) break;
        cur = nxt; cA = nA; cB = nB; ++ui;
        PG8_ACC_INIT(cur);

        if constexpr (ALIGN_EPI) { if (wr == 1) PG8_BAR; }
    }
    PG8_WAIT_V(0);
    if constexpr (!ALIGN_EPI) { if (wr == 0) PG8_BAR; }
    PG8_BAR;
    if constexpr (Epi::AFTER_DRAIN) { E.fused(acc, cur, wr, wc, fr, fq, lds, wid, lane); S.done(cur); }
#undef PG8_GLOAD
#undef PG8_ACC_INIT
#undef PG8_AH
#undef PG8_SA
#undef PG8_SB
#undef PG8_STAGE
#undef PG8_LDA
#undef PG8_LDB
#undef PG8_MMA
#undef PG8_WAIT_V
#undef PG8_WAIT_L
#undef PG8_BAR
#undef PG8_SCHED
}
}

constexpr int NB = 4, SEQ = 4096, D = 1024, T = NB * SEQ;
constexpr float ALPHA = 1.681792830507429f;
constexpr float LN_EPS = 1e-5f;
constexpr int NE = 32;
constexpr int NPAD_MAX = T * 4 + NE * 256;
constexpr float LOG2E = 1.4426950408889634f;
constexpr float FOX_C2 = 0.125f * LOG2E;

constexpr size_t KiB = 1024, MiB = 1u << 20;
constexpr size_t WS_CTL = 0, CTL_ZERO_BYTES = 320 * KiB;
constexpr size_t WS_MOD = 1 * MiB;
constexpr size_t WS_SMALL = 2 * MiB;
constexpr size_t WS_TKE = 3 * MiB, WS_TKP = 3 * MiB + 256 * KiB, WS_TKW = 3 * MiB + 512 * KiB;
constexpr size_t WS_ROWINFO = 4 * MiB, WS_ROWW = 4 * MiB + 512 * KiB;
constexpr size_t WS_BGUP = 5 * MiB;
constexpr size_t WS_DCUM = 6 * MiB;
constexpr size_t WS_SCAN = 7 * MiB;
constexpr size_t WS_ELIST = 10 * MiB, WS_EWT = 12 * MiB;
constexpr size_t WS_X = 16 * MiB;
constexpr size_t WS_H = 80 * MiB;
constexpr size_t WS_Y = 112 * MiB;
constexpr size_t WS_PROJ = 176 * MiB;
constexpr size_t WS_CORE = 304 * MiB;
constexpr size_t WS_MIX = 352 * MiB;
constexpr size_t WS_XG = 512 * MiB;
constexpr size_t WS_ACT = 656 * MiB;
constexpr size_t WS_YB = 800 * MiB;
constexpr size_t WS_WT = 1024 * MiB;
constexpr size_t WT_GLA_IN = WS_WT, WT_GLA_OUT = WT_GLA_IN + 12 * MiB, WT_RG_IN = WT_GLA_OUT + 4 * MiB, WT_RG_OUT = WT_RG_IN + 5 * MiB,
                 WT_FOX_IN = WT_RG_OUT + 3 * MiB, WT_FOX_OUT = WT_FOX_IN + 8 * MiB, WT_RG_G = WT_FOX_OUT + 2 * MiB, WT_GU = WT_RG_G + 2 * MiB, WT_DN = WT_GU + 512 * MiB, WS_END = WT_DN + 256 * MiB;
constexpr int CW_TMO = 0, CW_BAR = 4096, CW_CNT = 16384, CW_GLA = 20480;

constexpr int RING_BYTES = 131072, CTRL_OFF = 135168, LDS_BYTES = 163840;
constexpr int L_MISC = CTRL_OFF, L_TS = CTRL_OFF + 64, L_CNT = CTRL_OFF + 256, L_ULIST = CTRL_OFF + 512, L_NU = CTRL_OFF + 1024, L_VEC = CTRL_OFF + 2048, L_RLIST = CTRL_OFF + 2048 + 20480;

#define GAS __attribute__((address_space(1)))
#define LAS __attribute__((address_space(3)))
typedef unsigned short bf16;
typedef unsigned v4u __attribute__((ext_vector_type(4)));
typedef unsigned v2u __attribute__((ext_vector_type(2)));
typedef float f32x4 __attribute__((ext_vector_type(4)));
typedef float f32x2 __attribute__((ext_vector_type(2)));
typedef __bf16 bf16x2_t __attribute__((ext_vector_type(2)));
#define LDS_WAIT() asm volatile("s_waitcnt lgkmcnt(0)" ::: "memory")
#define LDS_BARRIER() asm volatile("s_waitcnt lgkmcnt(0)\n\ts_barrier" ::: "memory")
#define VM_WAIT() asm volatile("s_waitcnt vmcnt(0)" ::: "memory")
#define RLX_AGENT __ATOMIC_RELAXED, __HIP_MEMORY_SCOPE_AGENT
__device__ __forceinline__ float bf2f(bf16 v) { return __uint_as_float((unsigned)v << 16); }
__device__ __forceinline__ float bflo(unsigned w) { return __uint_as_float(w << 16); }
__device__ __forceinline__ float bfhi(unsigned w) { return __uint_as_float(w & 0xffff0000u); }
__device__ __forceinline__ unsigned pk2(float lo, float hi) { f32x2 v = {lo, hi}; bf16x2_t b = __builtin_convertvector(v, bf16x2_t); return __builtin_bit_cast(unsigned, b); }
__device__ __forceinline__ unsigned pk4_fp8(float a, float b, float c, float d) { int p = 0; p = __builtin_amdgcn_cvt_pk_fp8_f32(a, b, p, false); p = __builtin_amdgcn_cvt_pk_fp8_f32(c, d, p, true); return (unsigned)p; }
__device__ __forceinline__ bf16 f2bf(float f) { return (bf16)(pk2(f, 0.f) & 0xffffu); }
template <int CTRL> __device__ __forceinline__ float dpp_f(float v) { return __builtin_bit_cast(float, __builtin_amdgcn_update_dpp(0, __builtin_bit_cast(int, v), CTRL, 0xf, 0xf, true)); }
__device__ __forceinline__ float wave_sum(float v) {
    v += dpp_f<0xB1>(v); v += dpp_f<0x4E>(v); v += dpp_f<0x141>(v); v += dpp_f<0x140>(v);
    const float s0 = __builtin_bit_cast(float, __builtin_amdgcn_readlane(__builtin_bit_cast(int, v), 0)), s1 = __builtin_bit_cast(float, __builtin_amdgcn_readlane(__builtin_bit_cast(int, v), 16)),
                s2 = __builtin_bit_cast(float, __builtin_amdgcn_readlane(__builtin_bit_cast(int, v), 32)), s3 = __builtin_bit_cast(float, __builtin_amdgcn_readlane(__builtin_bit_cast(int, v), 48));
    return (s0 + s1) + (s2 + s3);
}
__device__ __forceinline__ float sigmoidf_(float x) { return __builtin_amdgcn_rcpf(1.0f + __expf(-x)); }
__device__ __forceinline__ float logsigmoidf_(float x) { return fminf(x, 0.f) - log1pf(__expf(-fabsf(x))); }

#define XB_TMO      128
#define XB_XCNT(j)  (256  + 64 * (j))
#define XB_XSUB(j)  (1280 + 64 * (j))
#define XB_XGEN(j)  (2304 + 64 * (j))
#define XB_TOP      3328
#define XB_TOPGEN   3392
#define XCD_BAR_WORDS 3456
#define XB_SPIN_CAP (1u << 18)

__device__ __forceinline__ unsigned xb_ld(unsigned* p)              { return __hip_atomic_load(p, __ATOMIC_RELAXED, __HIP_MEMORY_SCOPE_AGENT); }
__device__ __forceinline__ unsigned xb_add(unsigned* p, unsigned v) { return __hip_atomic_fetch_add(p, v, __ATOMIC_RELAXED, __HIP_MEMORY_SCOPE_AGENT); }
__device__ __forceinline__ unsigned xb_xcc_id() { return (unsigned)__builtin_amdgcn_s_getreg((3 << 11) | 20) & 0xFu; }
#define XB_SPIN(cond, bar) do { unsigned _sp = 0; while (cond) { __builtin_amdgcn_s_sleep(1); \
    if ((++_sp & 255u) == 0u) { if (xb_ld(&(bar)[XB_TMO])) break; if (_sp > XB_SPIN_CAP) { atomicAdd(&(bar)[XB_TMO], 1u); break; } } } } while (0)

struct XcdBarrier {
    unsigned* bar; unsigned x;
    volatile LAS unsigned* st;
};

__device__ __forceinline__ XcdBarrier xcd_barrier_post(unsigned* bar, volatile LAS unsigned* st) {
    XcdBarrier b; b.bar = bar; b.x = xb_xcc_id(); b.st = st;
    if (threadIdx.x == 0) (void)xb_add(&bar[XB_XCNT(b.x)], 1u);
    return b;
}
__device__ __forceinline__ void xcd_barrier_complete(unsigned* bar, unsigned x, unsigned& nloc, unsigned& nx) {
    const unsigned G = gridDim.x * gridDim.y * gridDim.z;
    unsigned sum, cnt, mine, sp = 0u;
    for (;;) {
        sum = 0u; cnt = 0u; mine = 0u;
#pragma unroll
        for (unsigned j = 0; j < 16; ++j) { const unsigned c = xb_ld(&bar[XB_XCNT(j)]); sum += c; cnt += (c > 0u) ? 1u : 0u; mine = (j == x) ? c : mine; }
        if (sum == G) break;
        __builtin_amdgcn_s_sleep(1);
        if ((++sp & 255u) == 0u) { if (xb_ld(&bar[XB_TMO])) break; if (sp > XB_SPIN_CAP) { atomicAdd(&bar[XB_TMO], 1u); break; } }
    }
    nloc = mine > 0u ? mine : 1u; nx = cnt > 0u ? cnt : 1u;
}

__device__ __forceinline__ void xcd_barrier(const XcdBarrier& b) {
    asm volatile("s_waitcnt vmcnt(0)" ::: "memory");
    __syncthreads();
    if (threadIdx.x == 0) {
        unsigned* bar = b.bar;
        __builtin_amdgcn_s_waitcnt(0);
        unsigned nloc = b.st[0], nx = b.st[1];
        if (nloc == 0u) { xcd_barrier_complete(bar, b.x, nloc, nx); b.st[0] = nloc; b.st[1] = nx; }
        const unsigned old = xb_add(&bar[XB_XSUB(b.x)], 1u);
        const unsigned gen = old / nloc;
        if (old + 1u == (gen + 1u) * nloc) {
            __builtin_amdgcn_fence(__ATOMIC_RELEASE, "agent");
            asm volatile("s_waitcnt vmcnt(0)" ::: "memory");
            const unsigned og = xb_add(&bar[XB_TOP], 1u);
            const unsigned tg = og / nx;
            if (og + 1u == (tg + 1u) * nx) xb_add(&bar[XB_TOPGEN], 1u);
            else XB_SPIN(xb_ld(&bar[XB_TOPGEN]) == tg, bar);
            __builtin_amdgcn_fence(__ATOMIC_ACQUIRE, "agent");
            xb_add(&bar[XB_XGEN(b.x)], 1u);
            asm volatile("s_waitcnt vmcnt(0)" ::: "memory");
        } else {
            XB_SPIN(xb_ld(&bar[XB_XGEN(b.x)]) == gen, bar);
            __builtin_amdgcn_fence(__ATOMIC_ACQUIRE, "agent");
            asm volatile("s_waitcnt vmcnt(0)" ::: "memory");
        }
    }
    __syncthreads();
}

struct Params { const float* in[31]; float* out; unsigned char* ws; int ph_lo, ph_hi, use_bar, pad; };
enum { I_X = 0, I_C, I_ADA_W, I_ADA_B, I_LN_G, I_LN_B, I_GLA_WIN, I_GLA_WGU, I_GLA_BG, I_GLA_NG, I_GLA_WOUT, I_RG_WIN, I_RG_CW, I_RG_CB, I_RG_WRG, I_RG_BRG,
       I_RG_WIG, I_RG_BIG, I_RG_LAM, I_RG_WOUT, I_FOX_WIN, I_FOX_BF, I_FOX_QG, I_FOX_KG, I_FOX_WOUT, I_MOE_WR, I_MOE_BR, I_MOE_WGU, I_MOE_BGU, I_MOE_WDN, I_MOE_BDN };

__device__ __forceinline__ const float* kin(int i) {
    const char __attribute__((address_space(4)))* ka = (const char __attribute__((address_space(4)))*)__builtin_amdgcn_kernarg_segment_ptr();
    int off = i * 8; asm volatile("" : "+s"(off));
    return *(const float* const __attribute__((address_space(4)))*)(ka + off);
}
__device__ __forceinline__ void tr_item(const float* W, int ldw, int c0, int k0, bf16* WT, int ldt, int mode, LAS float* scr, int lane) {
#pragma unroll
    for (int i4 = 0; i4 < 16; ++i4) { const int kk = 4 * i4 + (lane >> 4);
        __builtin_amdgcn_global_load_lds((const unsigned*)(W + (size_t)(k0 + kk) * ldw + c0 + 4 * ((lane & 15) ^ ((kk >> 3) & 7))), (LAS unsigned*)(scr + i4 * 256), 16, 0, 2); }
    asm volatile("s_waitcnt vmcnt(0)" ::: "memory");
    const int c8 = lane & 7;
#pragma unroll
    for (int jj = 0; jj < 8; ++jj) { const int n = (lane >> 3) + 8 * jj, c = c0 + n;
        const int drow = mode == 0 ? c : (mode == 1 ? ((c >> 8) * 256 + (c & 1) * 128 + ((c >> 1) & 127)) : (c < 3072 ? c : c - 16));
        const LAS float* src = scr + (8 * c8) * 64 + 4 * ((n >> 2) ^ c8) + (n & 3);
        float f[8];
#pragma unroll
        for (int i = 0; i < 8; ++i) f[i] = src[i * 64];
        v4u o; o.x = pk2(f[0], f[1]); o.y = pk2(f[2], f[3]); o.z = pk2(f[4], f[5]); o.w = pk2(f[6], f[7]);
        *(v4u*)(WT + (size_t)drow * ldt + k0 + 8 * c8) = o; }
    LDS_WAIT(); asm volatile("" ::: "memory");
}
__device__ __forceinline__ void tr_item8(const float* W, int ldw, int c0, int k0, unsigned char* WT8, int ldt, int mode, float sc, LAS float* scr, int lane) {
#pragma unroll
    for (int i8 = 0; i8 < 16; ++i8) { const int kk = 8 * i8 + (lane >> 3);
        __builtin_amdgcn_global_load_lds((const unsigned*)(W + (size_t)(k0 + kk) * ldw + c0 + 4 * ((lane & 7) ^ ((kk >> 4) & 7))), (LAS unsigned*)(scr + i8 * 256), 16, 0, 2); }
    asm volatile("s_waitcnt vmcnt(0)" ::: "memory");
    const int c16 = lane & 7;
#pragma unroll
    for (int jj = 0; jj < 4; ++jj) { const int n = (lane >> 3) + 8 * jj, c = c0 + n;
        const int drow = mode == 0 ? c : ((c >> 8) * 256 + (c & 1) * 128 + ((c >> 1) & 127));
        const LAS float* src = scr + (16 * c16) * 32 + 4 * ((n >> 2) ^ c16) + (n & 3);
        float f[16];
#pragma unroll
        for (int i = 0; i < 16; ++i) f[i] = src[i * 32] * sc;
        v4u o; o.x = pk4_fp8(f[0], f[1], f[2], f[3]); o.y = pk4_fp8(f[4], f[5], f[6], f[7]); o.z = pk4_fp8(f[8], f[9], f[10], f[11]); o.w = pk4_fp8(f[12], f[13], f[14], f[15]);
        *(v4u*)(WT8 + (size_t)drow * ldt + k0 + 16 * c16) = o; }
    LDS_WAIT(); asm volatile("" ::: "memory");
}
__device__ __forceinline__ void p0_adaln(const Params& P, LAS unsigned char* lds) {
    const int tid = my_tid(), lane = tid & 63, wave = __builtin_amdgcn_readfirstlane(tid >> 6), G = gridDim.x;
    unsigned char* ws = P.ws;
    { LAS float* csil = (LAS float*)lds; LAS float* red = (LAS float*)(lds + 16384);
      for (int i = tid; i < NB * D; i += 512) { const float c = kin(I_C)[i]; csil[i] = c * sigmoidf_(c); }
      __syncthreads();
      float* mod = (float*)(ws + WS_MOD);
      for (int u = blockIdx.x; u < 4 * 48; u += G) { const int l = u / 48, cg = u % 48, col = cg * 128 + 2 * lane;
          const float* w = kin(I_ADA_W) + (size_t)l * D * 6144 + col; f32x2 a0 = {0.f, 0.f}, a1 = a0, a2 = a0, a3 = a0;
#pragma unroll 16
          for (int kk = 0; kk < 128; ++kk) { const int k = wave * 128 + kk; const f32x2 wv = *(const f32x2*)(w + (size_t)k * 6144);
              a0 += wv * csil[k]; a1 += wv * csil[D + k]; a2 += wv * csil[2 * D + k]; a3 += wv * csil[3 * D + k]; }
          LAS f32x2* red2 = (LAS f32x2*)red;
          red2[(wave * 4 + 0) * 64 + lane] = a0; red2[(wave * 4 + 1) * 64 + lane] = a1; red2[(wave * 4 + 2) * 64 + lane] = a2; red2[(wave * 4 + 3) * 64 + lane] = a3;
          __syncthreads();
          { const int b = tid >> 7, c = tid & 127; float s = kin(I_ADA_B)[l * 6144 + cg * 128 + c];
#pragma unroll
              for (int w8 = 0; w8 < 8; ++w8) s += red[((w8 * 4 + b) * 64) * 2 + c];
              mod[((size_t)l * NB + b) * 6144 + cg * 128 + c] = s; }
          __syncthreads(); }
    }
}
__device__ __forceinline__ void p0_convert(const Params& P, LAS unsigned char* lds) {
    const int tid = my_tid(), lane = tid & 63, wave = __builtin_amdgcn_readfirstlane(tid >> 6), G = gridDim.x;
    unsigned char* ws = P.ws;
    { float* bp = (float*)(ws + WS_BGUP); const float* bs = kin(I_MOE_BGU);
      for (int i = blockIdx.x * 512 + tid; i < 4 * 32 * 2048; i += G * 512) { const int le = i >> 11, r = i & 2047, nt = r >> 8, half = (r >> 7) & 1, j = r & 127;
          bp[i] = bs[(size_t)le * 2048 + 2 * (nt * 128 + j) + half]; } }
    { bf16* wg = (bf16*)(ws + WT_RG_G);
      for (int i = blockIdx.x * 512 + tid; i < 2560 * 16; i += G * 512) { const int rw = i >> 4, c = i & 15; *(v4u*)(wg + (size_t)rw * 256 + 128 + c * 8) = (v4u){0u, 0u, 0u, 0u}; } }
    LAS float* scr = (LAS float*)(lds + wave * 16384);
    const int gw = blockIdx.x * 8 + wave, NGW = G * 8;
    constexpr int N_SMALL = 4288 + 80, N_GU = 128 * 512, N_DN = 128 * 256, N_ITEMS = N_SMALL + N_GU + N_DN;
    for (int it = gw; it < N_ITEMS; it += NGW) {
        int r = it;
        if (r >= N_SMALL + N_GU) { r -= N_SMALL + N_GU; const int le = r >> 8, q = r & 255, kb = q >> 5, cb = q & 31;
            tr_item8(kin(I_MOE_WDN) + (size_t)le * 1024 * 1024, 1024, cb * 32, kb * 128, ws + WT_DN + (size_t)le * 1024 * 1024, 1024, 0, 64.0f, scr, lane); continue; }
        if (r >= N_SMALL) { r -= N_SMALL; const int le = r >> 9, q = r & 511, kb = q >> 6, cb = q & 63;
            tr_item8(kin(I_MOE_WGU) + (size_t)le * 1024 * 2048, 2048, cb * 32, kb * 128, ws + WT_GU + (size_t)le * 2048 * 1024, 1024, 1, 32.0f, scr, lane); continue; }
        if (r < 1536) { const int j = r / 768, q = r % 768, kb = q / 48, cb = q % 48;
            tr_item(kin(I_GLA_WIN) + (size_t)j * 1024 * 3088, 3088, cb * 64, kb * 64, (bf16*)(ws + WT_GLA_IN) + (size_t)j * 3072 * 1024, 1024, 0, scr, lane); continue; } r -= 1536;
        if (r < 512) { const int j = r >> 8, q = r & 255, kb = q >> 4, cb = q & 15;
            tr_item(kin(I_GLA_WOUT) + (size_t)j * 1024 * 1024, 1024, cb * 64, kb * 64, (bf16*)(ws + WT_GLA_OUT) + (size_t)j * 1024 * 1024, 1024, 0, scr, lane); continue; } r -= 512;
        if (r < 640) { const int kb = r / 40, cb = r % 40;
            tr_item(kin(I_RG_WIN), 2560, cb * 64, kb * 64, (bf16*)(ws + WT_RG_IN), 1024, 0, scr, lane); continue; } r -= 640;
        if (r < 320) { const int kb = r >> 4, cb = r & 15;
            tr_item(kin(I_RG_WOUT), 1024, cb * 64, kb * 64, (bf16*)(ws + WT_RG_OUT), 1280, 0, scr, lane); continue; } r -= 320;
        if (r < 1024) { const int kb = r >> 6, cb = r & 63; const int c0 = cb < 48 ? cb * 64 : 3088 + (cb - 48) * 64;
            tr_item(kin(I_FOX_WIN), 4112, c0, kb * 64, (bf16*)(ws + WT_FOX_IN), 1024, 2, scr, lane); continue; } r -= 1024;
        if (r < 256) { const int kb = r >> 4, cb = r & 15;
            tr_item(kin(I_FOX_WOUT), 1024, cb * 64, kb * 64, (bf16*)(ws + WT_FOX_OUT), 1024, 0, scr, lane); continue; } r -= 256;
        { const int blk = r >> 3, g = (r >> 2) & 1, kb = (r >> 1) & 1, cb = r & 1;
            tr_item(kin(g ? I_RG_WIG : I_RG_WRG) + (size_t)blk * 128 * 128, 128, cb * 64, kb * 64, (bf16*)(ws + WT_RG_G) + (size_t)(blk * 256 + g * 128) * 256, 256, 0, scr, lane); }
    }
}

struct TokA {
    const float* xin; int xin_bf, xout_bf; int ymode;
    const float* y; const bf16* yb;
    const float* gvec; const float* gamma; const float* beta; float* xout;
    const float* scvec; const float* shvec; bf16* hout; int h_fp8;
    const float* W; int ldw; const float* bias; float* small_out;
    int* cnt; int* tk_e; int* tk_p; float* tk_w;
};
template <int NC>
__device__ __forceinline__ void tok_phase(const TokA& A, LAS unsigned char* lds) {
    const int tid = my_tid(), lane = tid & 63, wave = __builtin_amdgcn_readfirstlane(tid >> 6), G = gridDim.x;
    const int rows_wg = T / G, b = (blockIdx.x * rows_wg) / SEQ;
    const int rpw = rows_wg / 8;
    v4u nx[4]; v2u ny[4]; unsigned nyb[4][4];
#define TOK_LOAD(row_) do { \
        if (A.xin_bf) { _Pragma("unroll") for (int j = 0; j < 4; ++j) { const v2u w_ = ((const v2u*)((const bf16*)A.xin + (row_) * D))[64 * j + lane]; nx[j] = (v4u){w_.x, w_.y, 0u, 0u}; } } \
        else { _Pragma("unroll") for (int j = 0; j < 4; ++j) nx[j] = ((const v4u*)(A.xin + (row_) * D))[64 * j + lane]; } \
        if (A.ymode == 1) { _Pragma("unroll") for (int j = 0; j < 4; ++j) ny[j] = ((const v2u*)((const bf16*)A.y + (row_) * D))[64 * j + lane]; } \
        else if (A.ymode == 2) { _Pragma("unroll") for (int j = 0; j < 4; ++j) _Pragma("unroll") for (int k = 0; k < 4; ++k) nyb[j][k] = ((const unsigned*)((const unsigned char*)A.yb + ((row_) * 4 + k) * D))[64 * j + lane]; } } while (0)
    { const size_t r0 = (size_t)blockIdx.x * rows_wg + wave * rpw; TOK_LOAD(r0); }
    LAS float* wl = (LAS float*)lds;
    if constexpr (NC > 0) {
        constexpr int CH = NC / 4;
#pragma unroll 8
        for (int idx = tid; idx < 1024 * CH; idx += 512) { const int k = idx / CH, c = idx % CH; const f32x4 v = *(const f32x4*)(A.W + (size_t)k * A.ldw + 4 * c);
            const int s = (((k >> 8) * 4 + (k & 3)) * 64) + ((k >> 2) & 63);
            *(LAS f32x4*)(wl + (c * 1024 + s) * 4) = v; }
    }
    LAS f32x4* vec = (LAS f32x4*)(lds + L_VEC);
    if constexpr (NC == 32) { if (tid < 32) ((LAS unsigned*)(lds + L_CNT))[tid] = 0u; }
    if (tid < 256) {
        if (A.ymode) { vec[tid] = ((const f32x4*)(A.gvec + (size_t)b * 6144))[tid] + 1.0f; vec[256 + tid] = ((const f32x4*)A.gamma)[tid]; vec[512 + tid] = ((const f32x4*)A.beta)[tid]; }
        if (A.hout) { vec[768 + tid] = ((const f32x4*)(A.scvec + (size_t)b * 6144))[tid] + 1.0f; vec[1024 + tid] = ((const f32x4*)(A.shvec + (size_t)b * 6144))[tid]; } }
    __syncthreads();
    if (wave >= 4) __builtin_amdgcn_s_setprio(1);
#pragma unroll 2
    for (int ir = 0; ir < rpw; ++ir) {
        const size_t row = (size_t)blockIdx.x * rows_wg + wave * rpw + ir;
        asm volatile("" ::: "memory");
        float hv[16];
        {
            f32x4 v[4];
#pragma unroll
            for (int j = 0; j < 4; ++j) { if (A.xin_bf) v[j] = (f32x4){bflo(nx[j].x), bfhi(nx[j].x), bflo(nx[j].y), bfhi(nx[j].y)}; else v[j] = __builtin_bit_cast(f32x4, nx[j]); }
            f32x4 yv[4];
            if (A.ymode == 1) {
#pragma unroll
                for (int j = 0; j < 4; ++j) yv[j] = (f32x4){bflo(ny[j].x), bfhi(ny[j].x), bflo(ny[j].y), bfhi(ny[j].y)};
            } else if (A.ymode == 2) {
#pragma unroll
                for (int j = 0; j < 4; ++j) { f32x4 s = {0.f, 0.f, 0.f, 0.f};
#pragma unroll
                    for (int k = 0; k < 4; ++k) { const int w = (int)nyb[j][k]; const f32x2 lo = __builtin_amdgcn_cvt_pk_f32_fp8(w, false), hi = __builtin_amdgcn_cvt_pk_f32_fp8(w, true); s += (f32x4){lo.x, lo.y, hi.x, hi.y}; }
                    yv[j] = s * 0.0625f; }
            }
            if (ir + 1 < rpw) { const size_t rn = row + 1; TOK_LOAD(rn); }
            if (A.ymode) {
                float s = 0.f;
#pragma unroll
                for (int j = 0; j < 4; ++j) { v[j] = v[j] * ALPHA + vec[64 * j + lane] * yv[j]; s += (v[j].x + v[j].y) + (v[j].z + v[j].w); }
                const float mean = wave_sum(s) * (1.0f / D); float s2 = 0.f;
#pragma unroll
                for (int j = 0; j < 4; ++j) { v[j] = v[j] - mean; s2 += (v[j].x * v[j].x + v[j].y * v[j].y) + (v[j].z * v[j].z + v[j].w * v[j].w); }
                const float rstd = 1.0f / sqrtf(wave_sum(s2) * (1.0f / D) + LN_EPS);
#pragma unroll
                for (int j = 0; j < 4; ++j) { v[j] = v[j] * rstd * vec[256 + 64 * j + lane] + vec[512 + 64 * j + lane];
                    if (A.xout_bf) { v2u w; w.x = pk2(v[j].x, v[j].y); w.y = pk2(v[j].z, v[j].w); ((v2u*)((bf16*)A.xout + row * D))[64 * j + lane] = w; } else ((f32x4*)(A.xout + row * D))[64 * j + lane] = v[j]; }
            }
            if (A.hout) {
#pragma unroll
                for (int j = 0; j < 4; ++j) { const f32x4 h = v[j] * vec[768 + 64 * j + lane] + vec[1024 + 64 * j + lane]; hv[4 * j + 0] = h.x; hv[4 * j + 1] = h.y; hv[4 * j + 2] = h.z; hv[4 * j + 3] = h.w;
                    if (A.h_fp8) ((unsigned*)((unsigned char*)A.hout + row * D))[64 * j + lane] = pk4_fp8(h.x, h.y, h.z, h.w);
                    else { v2u w; w.x = pk2(h.x, h.y); w.y = pk2(h.z, h.w); ((v2u*)(A.hout + row * D))[64 * j + lane] = w; } }
            }
        }
        asm volatile("" ::: "memory");
        if constexpr (NC > 0) {
            constexpr int CH = NC / 4, LOGN = (NC == 32) ? 5 : 4;
            float acc[NC]; const LAS float* wlane = wl + lane * 4;
#pragma unroll
            for (int q = 0; q < NC; ++q) acc[q] = 0.f;
#pragma unroll
            for (int e = 0; e < 16; ++e) {
                if ((e & 1) == 0) asm volatile("" ::: "memory");
#pragma unroll
                for (int c = 0; c < CH; ++c) { const f32x4 wv = *(const LAS f32x4*)(wlane + (c * 1024 + e * 64) * 4);
#pragma unroll
                    for (int q = 0; q < 4; ++q) acc[4 * c + q] += hv[e] * wv[q]; } }
#pragma unroll
            for (int i = 0; i < NC / 2; ++i) { const auto rr = __builtin_amdgcn_permlane32_swap(__float_as_uint(acc[i]), __float_as_uint(acc[i + NC / 2]), false, false); acc[i] = __uint_as_float(rr[0]) + __uint_as_float(rr[1]); }
            { const bool up = (lane & 16) != 0;
#pragma unroll
              for (int i = 0; i < NC / 4; ++i) { const float keep = up ? acc[i + NC / 4] : acc[i], send = up ? acc[i] : acc[i + NC / 4]; acc[i] = keep + __shfl_xor(send, 16); } }
            { const bool up = (lane & 8) != 0;
#pragma unroll
              for (int i = 0; i < NC / 8; ++i) { const float keep = up ? acc[i + NC / 8] : acc[i], send = up ? acc[i] : acc[i + NC / 8]; acc[i] = keep + dpp_f<0x128>(send); } }
            { const bool up = (lane & 4) != 0;
#pragma unroll
              for (int i = 0; i < NC / 16; ++i) { const float keep = up ? acc[i + NC / 16] : acc[i], send = up ? acc[i] : acc[i + NC / 16]; acc[i] = keep + dpp_f<0x141>(send); } }
            float val;
            if constexpr (NC == 16) { val = acc[0]; val += dpp_f<0x4E>(val); val += dpp_f<0xB1>(val);
                const int col = ((lane >> 5) & 1) * 8 + ((lane >> 4) & 1) * 4 + ((lane >> 3) & 1) * 2 + ((lane >> 2) & 1);
                if ((lane & 3) == 0) A.small_out[row * 16 + col] = val;
            } else { { const bool up = (lane & 2) != 0; const float keep = up ? acc[1] : acc[0], send = up ? acc[0] : acc[1]; val = keep + dpp_f<0x4E>(send); }
                val += dpp_f<0xB1>(val);
                const int col = ((lane >> 5) & 1) * 16 + ((lane >> 4) & 1) * 8 + ((lane >> 3) & 1) * 4 + ((lane >> 2) & 1) * 2 + ((lane >> 1) & 1);
                val += A.bias[col];
                LAS float* lg = (LAS float*)(lds + L_RLIST + 2048) + wave * 48;
                if ((lane & 1) == 0) lg[col] = val;
                f32x4 o[8];
#pragma unroll
                for (int c4 = 0; c4 < 8; ++c4) o[c4] = *(const LAS f32x4*)(lg + 4 * c4);
                int gt = 0, ge = 0;
#pragma unroll
                for (int c4 = 0; c4 < 8; ++c4)
#pragma unroll
                    for (int q = 0; q < 4; ++q) { gt += (o[c4][q] > val) ? 1 : 0; ge += (o[c4][q] >= val) ? 1 : 0; }
                int rank = gt;
                if (__builtin_amdgcn_ballot_w64(ge - gt != 1) != 0ull) {
                    int colx = col; asm volatile("" : "+v"(colx));
                    rank = 0;
#pragma unroll
                    for (int c4 = 0; c4 < 8; ++c4)
#pragma unroll
                        for (int q = 0; q < 4; ++q) rank += ((o[c4][q] > val) | ((o[c4][q] == val) & ((4 * c4 + q) < colx))) ? 1 : 0; }
                if (rank < 4 && (lane & 1) == 0) { lg[32 + rank] = val; ((LAS int*)lg)[36 + rank] = col; }
                if (lane < 4) { const f32x4 tv = *(const LAS f32x4*)(lg + 32); const int ek = ((const LAS int*)lg)[36 + lane];
                    const float e1 = __expf(tv[1] - tv[0]), e2 = __expf(tv[2] - tv[0]), e3 = __expf(tv[3] - tv[0]); const float inv = 1.0f / (1.0f + e1 + e2 + e3);
                    const float wk = (lane == 0 ? 1.0f : lane == 1 ? e1 : lane == 2 ? e2 : e3) * inv;
                    const unsigned lp = __hip_atomic_fetch_add((LAS unsigned*)(lds + L_CNT) + ek, 1u, __ATOMIC_RELAXED, __HIP_MEMORY_SCOPE_WORKGROUP);
                    const int li = (wave * rpw + ir) * 4 + lane; LAS unsigned* rl = (LAS unsigned*)(lds + L_RLIST);
                    rl[li] = (unsigned)ek | (lp << 8); rl[256 + li] = __float_as_uint(wk); }
            }
        }
    }
    __builtin_amdgcn_s_setprio(0);
    if constexpr (NC == 32) {
        __syncthreads();
        LAS unsigned* hist = (LAS unsigned*)(lds + L_CNT); LAS unsigned* gb = (LAS unsigned*)(lds + L_TS); LAS unsigned* rl = (LAS unsigned*)(lds + L_RLIST);
        if (tid < 32) gb[tid] = __hip_atomic_fetch_add((unsigned*)A.cnt + tid, hist[tid], RLX_AGENT);
        __syncthreads();
        if (tid < rows_wg * 4) { const unsigned v = rl[tid]; const int ek = (int)(v & 0xffu); const size_t gi = (size_t)blockIdx.x * rows_wg * 4 + tid;
            const size_t q = (size_t)ek * T + (gb[ek] + (v >> 8)); A.tk_e[q] = (int)gi; A.tk_w[q] = __uint_as_float(rl[256 + tid]); }
        __syncthreads();
    }
}

typedef float f32x16 __attribute__((ext_vector_type(16)));
typedef short s16x8 __attribute__((ext_vector_type(8)));
typedef short s16x4 __attribute__((ext_vector_type(4)));
constexpr size_t GLA_QD = 0, GLA_KI = 16 * MiB, GLA_KE = 32 * MiB, GLA_DEC = 48 * MiB, GLA_DSEG = 49 * MiB, GLA_SLOC = 50 * MiB;
constexpr int GP = 272, GPV = 528;
__device__ __forceinline__ int crow16(int i, int h) { return (i & 3) + 8 * (i >> 2) + 4 * h; }
__device__ __forceinline__ s16x4 vtr4(const LAS unsigned char* p) { return __builtin_bit_cast(s16x4, __builtin_amdgcn_ds_read_tr16_b64_v4i16((LAS s16x4*)p)); }
__device__ __forceinline__ s16x8 tr_frag(const LAS unsigned char* img, int pitch, int row_lo, int row_hi, int col0, int lane) {
    const int i16 = lane & 15, q = i16 >> 2, p = i16 & 3, blk = (lane >> 4) & 1; const int cb = (col0 + 16 * blk + 4 * p) * 2;
    const s16x4 lo = vtr4(img + (row_lo + q) * pitch + cb), hi = vtr4(img + (row_hi + q) * pitch + cb);
    return (s16x8){lo[0], lo[1], lo[2], lo[3], hi[0], hi[1], hi[2], hi[3]};
}
__device__ __forceinline__ s16x8 tr_frag_b(const LAS unsigned char* base, int off_lo, int off_hi) {
    const s16x4 lo = vtr4(base + off_lo), hi = vtr4(base + off_hi);
    return (s16x8){lo[0], lo[1], lo[2], lo[3], hi[0], hi[1], hi[2], hi[3]};
}
__device__ __forceinline__ s16x8 pack8(const f32x16& x, int s) {
    v4u p; p.x = pk2(x[8 * s], x[8 * s + 1]); p.y = pk2(x[8 * s + 2], x[8 * s + 3]); p.z = pk2(x[8 * s + 4], x[8 * s + 5]); p.w = pk2(x[8 * s + 6], x[8 * s + 7]);
    return __builtin_bit_cast(s16x8, p);
}
#define MFMA32(a, b, c) __builtin_amdgcn_mfma_f32_32x32x16_bf16((a), (b), (c), 0, 0, 0)
__device__ __forceinline__ void gla_state_update(f32x16 (&S)[4], const LAS unsigned char* keL, const LAS unsigned char* vL, const LAS float* decL, int wave, int lane) {
    const int h = lane >> 5;
    const int i16_ = lane & 15, q_ = i16_ >> 2, p_ = i16_ & 3, blk_ = (lane >> 4) & 1;
    const LAS unsigned char* kb = keL + (q_ + 8 * h) * GP + (16 * blk_ + 4 * p_) * 2;
    const LAS unsigned char* vb = vL + (q_ + 8 * h) * GPV + (32 * wave + 16 * blk_ + 4 * p_) * 2;
#pragma unroll
    for (int dt = 0; dt < 4; ++dt)
#pragma unroll
        for (int g4 = 0; g4 < 4; ++g4) { const f32x4 dv = *(const LAS f32x4*)(decL + 32 * dt + 8 * g4 + 4 * h);
#pragma unroll
            for (int q = 0; q < 4; ++q) S[dt][4 * g4 + q] *= dv[q]; }
    s16x8 bv[2], ak[2][4];
#pragma unroll
    for (int s = 0; s < 2; ++s) { bv[s] = tr_frag_b(vb, 16 * s * GPV, (16 * s + 4) * GPV);
#pragma unroll
        for (int dt = 0; dt < 4; ++dt) ak[s][dt] = tr_frag_b(kb, 16 * s * GP + 64 * dt, (16 * s + 4) * GP + 64 * dt); }
#pragma unroll
    for (int s = 0; s < 2; ++s)
#pragma unroll
        for (int dt = 0; dt < 4; ++dt) S[dt] = MFMA32(ak[s][dt], bv[s], S[dt]);
}
__device__ __forceinline__ void gla_g1(const Params& P, LAS unsigned char* lds, int j) {
    const int tid = my_tid(), lane = tid & 63, wave = __builtin_amdgcn_readfirstlane(tid >> 6), G = gridDim.x;
    const bf16* proj = (const bf16*)(P.ws + WS_PROJ); const float* glr = (const float*)(P.ws + WS_SMALL);
    bf16* qdG = (bf16*)(P.ws + WS_MIX + GLA_QD); bf16* kiG = (bf16*)(P.ws + WS_MIX + GLA_KI); bf16* keG = (bf16*)(P.ws + WS_MIX + GLA_KE);
    float* decG = (float*)(P.ws + WS_MIX + GLA_DEC); float* dsegG = (float*)(P.ws + WS_MIX + GLA_DSEG); float* slocG = (float*)(P.ws + WS_MIX + GLA_SLOC);
    const float* wgu = kin(I_GLA_WGU) + (size_t)j * 16 * 512; const float* bg = kin(I_GLA_BG) + (size_t)j * 512;
    LAS float* glrL = (LAS float*)lds;
    LAS float* decL = (LAS float*)(lds + 16384);
    LAS float* blL = (LAS float*)(lds + 16384 + 4096);
    LAS unsigned char* keL = lds + 24576;
    LAS unsigned char* vL = lds + 24576 + 4 * 32 * GP;
    for (int u = blockIdx.x; u < 256; u += G) {
        const int bh = u >> 4, seg = u & 15, b = bh >> 2, hh = bh & 3; const size_t rowS = (size_t)b * SEQ + seg * 256;
        for (int i = tid; i < 1024; i += 512) ((LAS f32x4*)glrL)[i] = ((const f32x4*)(glr + rowS * 16))[i];
        f32x16 S[4];
#pragma unroll
        for (int dt = 0; dt < 4; ++dt)
#pragma unroll
            for (int i = 0; i < 16; ++i) S[dt][i] = 0.f;
        const int d = tid & 127, g = tid >> 7;
        float w[16];
#pragma unroll
        for (int r = 0; r < 16; ++r) w[r] = wgu[r * 512 + hh * 128 + d];
        const float bias = bg[hh * 128 + d];
        __syncthreads();
        for (int rd = 0; rd < 2; ++rd) {
            const int c = rd * 4 + g; const size_t row0 = rowS + c * 32;
            for (int i = tid; i < 4 * 32 * 32; i += 512) { const int cc = i >> 10, t = (i >> 5) & 31, c16 = i & 31;
                *(LAS v4u*)(vL + (cc * 32 + t) * GPV + c16 * 16) = *(const v4u*)(proj + (rowS + (rd * 4 + cc) * 32 + t) * 3072 + 1024 + hh * 256 + c16 * 8); }
            float la[32]; float tot = 0.f;
#pragma unroll
            for (int t = 0; t < 32; ++t) { float lg = bias;
#pragma unroll
                for (int r4 = 0; r4 < 4; ++r4) { const f32x4 gv = *(const LAS f32x4*)(glrL + (c * 32 + t) * 16 + 4 * r4); lg += gv.x * w[4 * r4] + gv.y * w[4 * r4 + 1] + gv.z * w[4 * r4 + 2] + gv.w * w[4 * r4 + 3]; }
                la[t] = (fminf(lg, 0.f) - __logf(1.0f + __expf(-fabsf(lg)))) * (1.0f / 16.0f); tot += la[t]; }
            float cum = 0.f; const float dc0 = __expf(tot);
#pragma unroll
            for (int t = 0; t < 32; ++t) { cum += la[t]; const size_t row = row0 + t;
                const float qv = bf2f(proj[row * 3072 + hh * 128 + d]) * 0.08838834764831845f, kv = bf2f(proj[row * 3072 + 512 + hh * 128 + d]);
                const float ec = __expf(cum), en = __builtin_amdgcn_rcpf(ec), ee = dc0 * en;
                const bf16 kev = f2bf(kv * ee);
                qdG[row * 512 + hh * 128 + d] = f2bf(qv * ec); kiG[row * 512 + hh * 128 + d] = f2bf(kv * en); keG[row * 512 + hh * 128 + d] = kev;
                *(LAS bf16*)(keL + (g * 32 + t) * GP + d * 2) = kev; }
            const float dc = dc0;
            decL[c * 128 + d] = dc; blL[c * 128 + d] = tot; decG[((size_t)(bh * 128 + seg * 8 + c)) * 128 + d] = dc;
            LDS_BARRIER();
#pragma unroll 1
            for (int cc = 0; cc < 4; ++cc) gla_state_update(S, keL + cc * 32 * GP, vL + cc * 32 * GPV, decL + (rd * 4 + cc) * 128, wave, lane);
            LDS_BARRIER();
        }
        if (tid < 128) { float s = 0.f;
#pragma unroll
            for (int c = 0; c < 8; ++c) s += blL[c * 128 + tid];
            __hip_atomic_store(dsegG + (size_t)u * 128 + tid, __expf(s), RLX_AGENT); }
        { const int h = lane >> 5, r = lane & 31; float* sp = slocG + (size_t)u * 128 * 256;
#pragma unroll
          for (int dt = 0; dt < 4; ++dt)
#pragma unroll
              for (int i = 0; i < 16; ++i) __hip_atomic_store(sp + (size_t)(32 * dt + crow16(i, h)) * 256 + 32 * wave + r, S[dt][i], RLX_AGENT); }
        unsigned* cntw = (unsigned*)(P.ws + WS_CTL) + CW_GLA + (j * 16 + bh) * 64;
        asm volatile("s_waitcnt vmcnt(0)" ::: "memory");
        if (lane == 0) __hip_atomic_fetch_add(cntw, 1u, RLX_AGENT);
        if (wave == 0) { unsigned sp_ = 0;
            while ((unsigned)__builtin_amdgcn_readfirstlane((int)__hip_atomic_load(cntw, RLX_AGENT)) < 128u) { __builtin_amdgcn_s_sleep(2); if (++sp_ > (1u << 22)) break; }
            __builtin_amdgcn_fence(__ATOMIC_ACQUIRE, "agent"); asm volatile("s_waitcnt vmcnt(0)" ::: "memory"); }
        __syncthreads();
        { const int dd = seg * 8 + (tid >> 6), e4 = tid & 63; f32x4 run = {0.f, 0.f, 0.f, 0.f};
#pragma unroll 4
          for (int sg = 0; sg < 16; ++sg) { f32x4* p = (f32x4*)(slocG + ((size_t)(bh * 16 + sg) * 128 + dd) * 256) + e4; const f32x4 loc = *p; *p = run;
              run = run * dsegG[(size_t)(bh * 16 + sg) * 128 + dd] + loc; } }
        __syncthreads();
    }
}
__device__ __forceinline__ void gla_g3(const Params& P, LAS unsigned char* lds, int j) {
    const int tid = my_tid(), lane = tid & 63, wave = __builtin_amdgcn_readfirstlane(tid >> 6), G = gridDim.x;
    const int h = lane >> 5, r = lane & 31;
    const bf16* proj = (const bf16*)(P.ws + WS_PROJ); bf16* core = (bf16*)(P.ws + WS_CORE);
    const bf16* qdG = (const bf16*)(P.ws + WS_MIX + GLA_QD); const bf16* kiG = (const bf16*)(P.ws + WS_MIX + GLA_KI); const bf16* keG = (const bf16*)(P.ws + WS_MIX + GLA_KE);
    const float* decG = (const float*)(P.ws + WS_MIX + GLA_DEC); const float* slocG = (const float*)(P.ws + WS_MIX + GLA_SLOC);
    const float* ng = kin(I_GLA_NG) + (size_t)j * 1024;
    LAS unsigned char* qdL = lds; LAS unsigned char* kiL = lds + 32 * GP; LAS unsigned char* keL = lds + 64 * GP; LAS unsigned char* vL = lds + 96 * GP;
    LAS float* decL = (LAS float*)(lds + 96 * GP + 32 * GPV);
    LAS float* ssqL = decL + 128;
    LAS unsigned char* oL = (LAS unsigned char*)(ssqL + 256);
    const LAS unsigned char* vkb = vL + (((lane & 15) >> 2) + 4 * h) * GPV + (32 * wave + 16 * ((lane >> 4) & 1) + 4 * (lane & 3)) * 2;
    for (int u = blockIdx.x; u < 256; u += G) {
        const int bh = u >> 4, seg = u & 15, b = bh >> 2, hh = bh & 3; const size_t rowS = (size_t)b * SEQ + seg * 256;
        f32x16 S[4];
        { const float* sp = slocG + (size_t)u * 128 * 256;
#pragma unroll
          for (int dt = 0; dt < 4; ++dt)
#pragma unroll
              for (int i = 0; i < 16; ++i) S[dt][i] = sp[(size_t)(32 * dt + crow16(i, h)) * 256 + 32 * wave + r]; }
        v4u pq, pk, pe, pv[2], prg[2]; float pd = 0.f;
#define G3_LOAD(c_) do { const size_t r0_ = rowS + (c_) * 32; const int t_ = tid >> 4, c16_ = tid & 15; const size_t go_ = (r0_ + t_) * 512 + hh * 128 + c16_ * 8; \
            pq = *(const v4u*)(qdG + go_); pk = *(const v4u*)(kiG + go_); pe = *(const v4u*)(keG + go_); \
            _Pragma("unroll") for (int k2 = 0; k2 < 2; ++k2) { const int i_ = tid + 512 * k2, tv_ = i_ >> 5, cv_ = i_ & 31; \
                pv[k2] = *(const v4u*)(proj + (r0_ + tv_) * 3072 + 1024 + hh * 256 + cv_ * 8); prg[k2] = *(const v4u*)(proj + (r0_ + tv_) * 3072 + 2048 + hh * 256 + cv_ * 8); } \
            if (tid < 128) pd = decG[((size_t)(bh * 128 + seg * 8 + (c_))) * 128 + tid]; } while (0)
        G3_LOAD(0);
        if (wave >= 4) __builtin_amdgcn_s_setprio(1);
#pragma unroll 1
        for (int c = 0; c < 8; ++c) {
            const size_t row0 = rowS + c * 32;
            { const int t = tid >> 4, c16 = tid & 15;
              *(LAS v4u*)(qdL + t * GP + c16 * 16) = pq; *(LAS v4u*)(kiL + t * GP + c16 * 16) = pk; *(LAS v4u*)(keL + t * GP + c16 * 16) = pe;
#pragma unroll
              for (int k2 = 0; k2 < 2; ++k2) { const int i = tid + 512 * k2, tv = i >> 5, cv = i & 31; *(LAS v4u*)(vL + tv * GPV + cv * 16) = pv[k2]; }
              if (tid < 128) decL[tid] = pd; }
            const v4u rg0 = prg[0], rg1 = prg[1];
            LDS_BARRIER();
            if (c + 1 < 8) G3_LOAD(c + 1);
            f32x16 pt, pt2;
#pragma unroll
            for (int i = 0; i < 16; ++i) { pt[i] = 0.f; pt2[i] = 0.f; }
#pragma unroll
            for (int hb = 0; hb < 2; ++hb) { s16x8 fa[4], fb[4];
#pragma unroll
                for (int q4 = 0; q4 < 4; ++q4) { const int s8 = 4 * hb + q4; fa[q4] = *(const LAS s16x8*)(kiL + r * GP + (16 * s8 + 8 * h) * 2); fb[q4] = *(const LAS s16x8*)(qdL + r * GP + (16 * s8 + 8 * h) * 2); }
                pt = MFMA32(fa[0], fb[0], pt); pt2 = MFMA32(fa[1], fb[1], pt2); pt = MFMA32(fa[2], fb[2], pt); pt2 = MFMA32(fa[3], fb[3], pt2);
                asm volatile("" ::: "memory"); }
            pt = pt + pt2;
#pragma unroll
            for (int i = 0; i < 16; ++i) if (crow16(i, h) > r) pt[i] = 0.f;
            f32x16 o, o2;
#pragma unroll
            for (int i = 0; i < 16; ++i) { o[i] = 0.f; o2[i] = 0.f; }
            { s16x8 av[2], bq[4][2];
#pragma unroll
              for (int s = 0; s < 2; ++s) av[s] = tr_frag_b(vkb, 16 * s * GPV, (16 * s + 8) * GPV);
#pragma unroll
              for (int dt = 0; dt < 4; ++dt)
#pragma unroll
                  for (int s = 0; s < 2; ++s) { const s16x4 lo = *(const LAS s16x4*)(qdL + r * GP + (32 * dt + 16 * s + 4 * h) * 2), hi = *(const LAS s16x4*)(qdL + r * GP + (32 * dt + 16 * s + 8 + 4 * h) * 2);
                      bq[dt][s] = (s16x8){lo[0], lo[1], lo[2], lo[3], hi[0], hi[1], hi[2], hi[3]}; }
              o = MFMA32(av[0], pack8(pt, 0), o); o2 = MFMA32(av[1], pack8(pt, 1), o2);
#pragma unroll
              for (int dt = 0; dt < 4; ++dt) { o = MFMA32(pack8(S[dt], 0), bq[dt][0], o); o2 = MFMA32(pack8(S[dt], 1), bq[dt][1], o2); }
              o = o + o2; }
            gla_state_update(S, keL, vL, decL, wave, lane);
            float ss = 0.f;
#pragma unroll
            for (int i = 0; i < 16; ++i) ss += o[i] * o[i];
            { const auto rr = __builtin_amdgcn_permlane32_swap(__float_as_uint(ss), __float_as_uint(ss), false, false); ss = __uint_as_float(rr[0]) + __uint_as_float(rr[1]); }
            if (h == 0) ssqL[wave * 32 + r] = ss;
            LDS_BARRIER();
            float tot = 0.f;
#pragma unroll
            for (int w8 = 0; w8 < 8; ++w8) tot += ssqL[w8 * 32 + r];
            const float rs = __builtin_amdgcn_rsqf(tot * (1.0f / 256.0f) + LN_EPS);
#pragma unroll
            for (int i = 0; i < 16; ++i) *(LAS bf16*)(oL + r * GPV + (32 * wave + crow16(i, h)) * 2) = f2bf(o[i] * rs);
            LDS_BARRIER();
#pragma unroll
            for (int k2 = 0; k2 < 2; ++k2) { const int i = tid + 512 * k2, t = i >> 5, c8 = i & 31; const size_t row = row0 + t;
                const v4u ov = *(const LAS v4u*)(oL + t * GPV + c8 * 16); const v4u rv = k2 ? rg1 : rg0;
                const f32x4 g0 = *(const f32x4*)(ng + hh * 256 + c8 * 8), g1 = *(const f32x4*)(ng + hh * 256 + c8 * 8 + 4);
                const unsigned ow[4] = {ov.x, ov.y, ov.z, ov.w}, rw[4] = {rv.x, rv.y, rv.z, rv.w}; const float gg[8] = {g0.x, g0.y, g0.z, g0.w, g1.x, g1.y, g1.z, g1.w};
                unsigned res[4];
#pragma unroll
                for (int q = 0; q < 4; ++q) { const float r0 = bflo(rw[q]), r1 = bfhi(rw[q]); res[q] = pk2(bflo(ow[q]) * gg[2 * q] * (r0 * sigmoidf_(r0)), bfhi(ow[q]) * gg[2 * q + 1] * (r1 * sigmoidf_(r1))); }
                *(v4u*)(core + row * 1024 + hh * 256 + c8 * 8) = (v4u){res[0], res[1], res[2], res[3]}; }
            LDS_BARRIER();
        }
        __builtin_amdgcn_s_setprio(0);
    }
}

__device__ __forceinline__ void rg_conv(const Params& P) {
    const int tid = my_tid(), G = gridDim.x;
    const bf16* proj = (const bf16*)(P.ws + WS_PROJ); bf16* xc = (bf16*)(P.ws + WS_Y);
    const float* cw = kin(I_RG_CW); const float* cb = kin(I_RG_CB);
    for (int i = blockIdx.x * 512 + tid; i < (T + 1) * 160; i += G * 512) { const int row = i / 160, c8 = (i % 160) * 8;
        v4u o = {0u, 0u, 0u, 0u};
        if (row < T) { const int t = row % SEQ; float acc[8];
            { const f32x4 b0 = *(const f32x4*)(cb + c8), b1 = *(const f32x4*)(cb + c8 + 4); acc[0] = b0.x; acc[1] = b0.y; acc[2] = b0.z; acc[3] = b0.w; acc[4] = b1.x; acc[5] = b1.y; acc[6] = b1.z; acc[7] = b1.w; }
#pragma unroll
            for (int jx = 0; jx < 4; ++jx) if (t - 3 + jx >= 0) { const v4u xv = *(const v4u*)(proj + (size_t)(row - 3 + jx) * 2560 + 1280 + c8);
                const f32x4 w0 = *(const f32x4*)(cw + jx * 1280 + c8), w1 = *(const f32x4*)(cw + jx * 1280 + c8 + 4);
                acc[0] += w0.x * bflo(xv.x); acc[1] += w0.y * bfhi(xv.x); acc[2] += w0.z * bflo(xv.y); acc[3] += w0.w * bfhi(xv.y);
                acc[4] += w1.x * bflo(xv.z); acc[5] += w1.y * bfhi(xv.z); acc[6] += w1.z * bflo(xv.w); acc[7] += w1.w * bfhi(xv.w); }
            o.x = pk2(acc[0], acc[1]); o.y = pk2(acc[2], acc[3]); o.z = pk2(acc[4], acc[5]); o.w = pk2(acc[6], acc[7]); }
        *(v4u*)(xc + (size_t)row * 1280 + c8) = o; }
}
constexpr int RG_SEG = 128, RG_NSEG = SEQ / RG_SEG;
__device__ __forceinline__ void rg_scan1(const Params& P) {
    const unsigned* AU = (const unsigned*)(P.ws + WS_MIX); float* cP = (float*)(P.ws + WS_SCAN); float* cH = cP + NB * RG_NSEG * 1280;
    for (int idx = blockIdx.x * 512 + threadIdx.x; idx < NB * RG_NSEG * 640; idx += gridDim.x * 512) { const int cp = idx % 640, bs = idx / 640; const size_t row0 = (size_t)bs * RG_SEG;
        float ls0 = 0.f, h0 = 0.f, ls1 = 0.f, h1 = 0.f;
#pragma unroll 16
        for (int t = 0; t < RG_SEG; ++t) { const v2u w = *(const v2u*)(AU + (row0 + t) * 1280 + 2 * cp); const float la0 = bflo(w.x), la1 = bflo(w.y);
            h0 = __expf(la0) * h0 + bfhi(w.x); ls0 += la0; h1 = __expf(la1) * h1 + bfhi(w.y); ls1 += la1; }
        *(f32x2*)(cP + (size_t)bs * 1280 + 2 * cp) = (f32x2){__expf(ls0), __expf(ls1)}; *(f32x2*)(cH + (size_t)bs * 1280 + 2 * cp) = (f32x2){h0, h1}; }
}
__device__ __forceinline__ void rg_scan2(const Params& P) {
    const unsigned* AU = (const unsigned*)(P.ws + WS_MIX); const float* cP = (const float*)(P.ws + WS_SCAN); const float* cH = cP + NB * RG_NSEG * 1280;
    const bf16* proj = (const bf16*)(P.ws + WS_PROJ); bf16* core = (bf16*)(P.ws + WS_CORE);
    for (int idx = blockIdx.x * 512 + threadIdx.x; idx < NB * RG_NSEG * 640; idx += gridDim.x * 512) { const int cp = idx % 640, bs = idx / 640, b = bs / RG_NSEG, sg = bs % RG_NSEG; const size_t row0 = (size_t)bs * RG_SEG;
        float h0 = 0.f, h1 = 0.f;
#pragma unroll 8
        for (int s2 = 0; s2 < sg; ++s2) { const size_t q = (size_t)(b * RG_NSEG + s2) * 1280 + 2 * cp; const f32x2 p2 = *(const f32x2*)(cP + q), c2 = *(const f32x2*)(cH + q); h0 = p2.x * h0 + c2.x; h1 = p2.y * h1 + c2.y; }
#pragma unroll 16
        for (int t = 0; t < RG_SEG; ++t) { const v2u w = *(const v2u*)(AU + (row0 + t) * 1280 + 2 * cp); h0 = __expf(bflo(w.x)) * h0 + bfhi(w.x); h1 = __expf(bflo(w.y)) * h1 + bfhi(w.y);
            const unsigned yb2 = *(const unsigned*)(proj + (row0 + t) * 2560 + 2 * cp);
            *(unsigned*)(core + (row0 + t) * 1280 + 2 * cp) = pk2(h0 * bflo(yb2), h1 * bfhi(yb2)); } }
}

__device__ __forceinline__ void fox_dcum(const Params& P, LAS unsigned char* lds) {
    const int tid = my_tid(), lane = tid & 63, wave = __builtin_amdgcn_readfirstlane(tid >> 6), G = gridDim.x;
    const float* flog = (const float*)(P.ws + WS_SMALL); float* dcum = (float*)(P.ws + WS_DCUM);
    LAS float* sc = (LAS float*)lds;
    for (int u = blockIdx.x; u < 64; u += G) { const int b = u >> 4, h = u & 15; const float bf = kin(I_FOX_BF)[h];
        float loc[8]; float run = 0.f;
#pragma unroll
        for (int i = 0; i < 8; ++i) { run += logsigmoidf_(flog[((size_t)b * SEQ + tid * 8 + i) * 16 + h] + bf); loc[i] = run; }
        float inc = run;
#pragma unroll
        for (int o = 1; o < 64; o <<= 1) { const float nb = __shfl_up(inc, o); if (lane >= o) inc += nb; }
        if (lane == 63) sc[wave] = inc;
        __syncthreads();
        float wbase = 0.f;
#pragma unroll
        for (int w8 = 0; w8 < 8; ++w8) if (w8 < wave) wbase += sc[w8];
        const float base = wbase + inc - run;
#pragma unroll
        for (int i = 0; i < 8; ++i) dcum[(size_t)u * SEQ + tid * 8 + i] = (base + loc[i]) * LOG2E;
        __syncthreads(); }
}
__device__ __forceinline__ void fox_norm_tile(const Params& P, int pm, int pn) {
    const int tid = my_tid(), lane = tid & 63, wave = __builtin_amdgcn_readfirstlane(tid >> 6);
    bf16* proj = (bf16*)(P.ws + WS_PROJ); const int which = pn >> 2; const int d0 = (lane & 3) * 16; const float* gn = kin(which ? I_FOX_KG : I_FOX_QG) + d0;
#pragma unroll 2
    for (int st = 0; st < 8; ++st) { const int row = pm * 256 + st * 32 + wave * 4 + (lane >> 4); bf16* p = proj + (size_t)row * 4096 + pn * 256 + (lane & 15) * 16;
        const v4u w0 = *(const v4u*)p, w1 = *(const v4u*)(p + 8); float f[16];
        f[0] = bflo(w0.x); f[1] = bfhi(w0.x); f[2] = bflo(w0.y); f[3] = bfhi(w0.y); f[4] = bflo(w0.z); f[5] = bfhi(w0.z); f[6] = bflo(w0.w); f[7] = bfhi(w0.w);
        f[8] = bflo(w1.x); f[9] = bfhi(w1.x); f[10] = bflo(w1.y); f[11] = bfhi(w1.y); f[12] = bflo(w1.z); f[13] = bfhi(w1.z); f[14] = bflo(w1.w); f[15] = bfhi(w1.w);
        float ss = 0.f;
#pragma unroll
        for (int i = 0; i < 16; ++i) ss += f[i] * f[i];
        ss += dpp_f<0xB1>(ss); ss += dpp_f<0x4E>(ss);
        const float rs = __builtin_amdgcn_rsqf(ss * (1.0f / 64.0f) + LN_EPS) * (which ? 1.0f : FOX_C2);
        v4u o0, o1; o0.x = pk2(f[0] * rs * gn[0], f[1] * rs * gn[1]); o0.y = pk2(f[2] * rs * gn[2], f[3] * rs * gn[3]); o0.z = pk2(f[4] * rs * gn[4], f[5] * rs * gn[5]); o0.w = pk2(f[6] * rs * gn[6], f[7] * rs * gn[7]);
        o1.x = pk2(f[8] * rs * gn[8], f[9] * rs * gn[9]); o1.y = pk2(f[10] * rs * gn[10], f[11] * rs * gn[11]); o1.z = pk2(f[12] * rs * gn[12], f[13] * rs * gn[13]); o1.w = pk2(f[14] * rs * gn[14], f[15] * rs * gn[15]);
        *(v4u*)p = o0; *(v4u*)(p + 8) = o1; }
}
#include <hip/hip_bf16.h>
#include <cmath>
namespace attn_body {
using bf16=__hip_bfloat16;
using bf16x8=__attribute__((ext_vector_type(8)))short;
using s16x4=__attribute__((ext_vector_type(4)))short;
using f32x16=__attribute__((ext_vector_type(16)))float;
using u32x4=__attribute__((ext_vector_type(4)))unsigned;
constexpr int BATCH=4,NHEAD=16,SEQ=4096,D=64,PIN=4096,POUT=1024;
constexpr int NW=8,QBLK=32,QB=QBLK*NW,KVBLK=64,NQB=SEQ/QB;
constexpr int ATTN_UNIT_ROWS=QB; constexpr int LDS_DTAB=90112;
__device__ __forceinline__ int crow(int r,int hi){return (r&3)+8*(r>>2)+4*hi;}
#define SBAR() __builtin_amdgcn_sched_barrier(0)
__device__ __forceinline__ void cmask(f32x16&p0,f32x16&p1,int jb,int qrel,int hi){
  const float NEG=-INFINITY; int kb=64*jb+4*hi;
  #pragma unroll
  for(int r=0;r<16;++r){int kv=kb+(r&3)+8*(r>>2); if(kv>qrel)p0[r]=NEG; if(kv+32>qrel)p1[r]=NEG;}
}

constexpr int NSLOT=3, SLOTB=8192;
constexpr int LDS_K=0, LDS_V=NSLOT*SLOTB, LDS_WS=2*NSLOT*SLOTB, LDS_OST=LDS_WS+NW*64*4, LDS_BYTES=LDS_OST+NW*4096;
constexpr float C2=0.125f*1.4426950408889634f;
__device__ __forceinline__ void glds16(const void*gsrc,unsigned lds_dst){unsigned keep;
  asm volatile("s_mov_b32 %0, m0\n\ts_mov_b32 m0, %2\n\ts_nop 0\n\tglobal_load_lds_dwordx4 %1, off\n\ts_mov_b32 m0, %0":"=&s"(keep):"v"(gsrc),"s"(lds_dst):"memory");}
__device__ __forceinline__ float max3f(float a,float b,float c){float r;asm("v_max3_f32 %0, %1, %2, %3":"=v"(r):"v"(a),"v"(b),"v"(c));return r;}
__device__ __forceinline__ float max2f(float a,float b){float r;asm("v_max_f32_e32 %0, %1, %2":"=v"(r):"v"(a),"v"(b));return r;}
__device__ __forceinline__ float fadd_s(float a,float b){float r;asm("v_add_f32_e32 %0, %1, %2":"=v"(r):"v"(a),"v"(b));return r;}
__device__ __forceinline__ float fsub_s(float a,float b){float r;asm("v_sub_f32_e32 %0, %1, %2":"=v"(r):"v"(a),"v"(b));return r;}
typedef float f32x2_t __attribute__((ext_vector_type(2))); typedef __bf16 bf16x2_t __attribute__((ext_vector_type(2)));
__device__ __forceinline__ unsigned cvtpk_s(float lo,float hi){f32x2_t v={lo,hi};bf16x2_t b=__builtin_convertvector(v,bf16x2_t);return __builtin_bit_cast(unsigned,b);}
#define WAIT_BAR(N) asm volatile("s_waitcnt vmcnt(" #N ") lgkmcnt(0)\n\ts_barrier":::"memory")

__device__ __forceinline__ void qkt(f32x16&p0,f32x16&p1,const char*Kslot,const bf16x8*qr,int r32,int hi){
  const char*kb=Kslot+hi*1024+r32*16;
  #pragma unroll
  for(int d0=0;d0<4;++d0){
    const bf16x8 b0=*reinterpret_cast<const bf16x8*>(kb+d0*2048);
    const bf16x8 b1=*reinterpret_cast<const bf16x8*>(kb+d0*2048+512);
    p0=__builtin_amdgcn_mfma_f32_32x32x16_bf16(b0,qr[d0],p0,0,0,0);p1=__builtin_amdgcn_mfma_f32_32x32x16_bf16(b1,qr[d0],p1,0,0,0);}
}
typedef __attribute__((address_space(3))) const char* lds_cptr;
typedef __attribute__((address_space(3))) const float* lds_fptr; typedef float f32x4g __attribute__((ext_vector_type(4)));
typedef short v4i16_t __attribute__((ext_vector_type(4)));
__device__ __forceinline__ void kload8(bf16x8*kf,lds_cptr kp){
  kf[0]=*(const __attribute__((address_space(3))) bf16x8*)(kp);      kf[1]=*(const __attribute__((address_space(3))) bf16x8*)(kp+512);
  kf[2]=*(const __attribute__((address_space(3))) bf16x8*)(kp+2048); kf[3]=*(const __attribute__((address_space(3))) bf16x8*)(kp+2560);
  kf[4]=*(const __attribute__((address_space(3))) bf16x8*)(kp+4096); kf[5]=*(const __attribute__((address_space(3))) bf16x8*)(kp+4608);
  kf[6]=*(const __attribute__((address_space(3))) bf16x8*)(kp+6144); kf[7]=*(const __attribute__((address_space(3))) bf16x8*)(kp+6656);
}
__device__ __forceinline__ void kload2(bf16x8*kf,lds_cptr kp,int j){ kf[2*j]=*(const __attribute__((address_space(3))) bf16x8*)(kp+j*2048); kf[2*j+1]=*(const __attribute__((address_space(3))) bf16x8*)(kp+j*2048+512); }
__device__ __forceinline__ s16x4 vtr(lds_cptr p){ return __builtin_bit_cast(s16x4,__builtin_amdgcn_ds_read_tr16_b64_v4i16((__attribute__((address_space(3))) v4i16_t*)p)); }
__device__ __forceinline__ float rowmax(const f32x16&p0,const f32x16&p1){
  float a=max3f(p0[0],p0[1],p1[0]),b=max3f(p0[2],p0[3],p1[1]);a=max3f(a,p1[2],p1[3]);
  #pragma unroll
  for(int r=4;r<16;r+=4){a=max3f(a,p0[r],p0[r+1]);b=max3f(b,p0[r+2],p0[r+3]);a=max3f(a,p1[r],p1[r+1]);b=max3f(b,p1[r+2],p1[r+3]);}
  const float m=max2f(a,b);
  auto rr=__builtin_amdgcn_permlane32_swap(__float_as_uint(m),__float_as_uint(m),false,false);
  return max2f(__uint_as_float(rr[0]),__uint_as_float(rr[1]));
}
__device__ __forceinline__ void pv(f32x16*o,int vb,bf16x8 pa0,bf16x8 pa1,bf16x8 pa2,bf16x8 pa3){
  #pragma unroll
  for(int d0=0;d0<2;++d0){s16x4 lo[4],hi[4];
    #pragma unroll
    for(int ks=0;ks<4;++ks){
      asm volatile("ds_read_b64_tr_b16 %0,%1 offset:%c2":"=&v"(lo[ks]):"v"(vb),"i"(d0*4096+ks*1024):"memory");
      asm volatile("ds_read_b64_tr_b16 %0,%1 offset:%c2":"=&v"(hi[ks]):"v"(vb),"i"(d0*4096+ks*1024+512):"memory");}
    asm volatile("s_waitcnt lgkmcnt(0)":::"memory");SBAR();
    #define PK(k) (bf16x8){lo[k][0],lo[k][1],lo[k][2],lo[k][3],hi[k][0],hi[k][1],hi[k][2],hi[k][3]}
    o[d0]=__builtin_amdgcn_mfma_f32_32x32x16_bf16(pa0,PK(0),o[d0],0,0,0);
    o[d0]=__builtin_amdgcn_mfma_f32_32x32x16_bf16(pa1,PK(1),o[d0],0,0,0);
    o[d0]=__builtin_amdgcn_mfma_f32_32x32x16_bf16(pa2,PK(2),o[d0],0,0,0);
    o[d0]=__builtin_amdgcn_mfma_f32_32x32x16_bf16(pa3,PK(3),o[d0],0,0,0);
    #undef PK
  }
}

#ifndef ATTN_STORE16
#define ATTN_STORE16(p,v) (*(u32x4*)(p)=(v))
#endif
template<int THRL> __device__ __forceinline__ void attn_unit(int b,int h,int qb,const bf16*Q,const bf16* K,const bf16* V,const bf16*OG,const float*DC,bf16*O,char*shm,bool fill){
  const int tid=threadIdx.x,lane=tid&63,r32=lane&31,hi=lane>>5; const int wid=__builtin_amdgcn_readfirstlane(tid>>6);
  const long rowbase=(long)b*SEQ; const int q0=qb*QB;
  const bf16*Qw=Q+(rowbase+q0+wid*QBLK)*PIN+h*D;
  const bf16*Kh=K+rowbase*PIN+h*D,*Vh=V+rowbase*PIN+h*D;
  const unsigned lds0=(unsigned)(uintptr_t)shm;
  float*wsf=(float*)(shm+LDS_WS)+wid*64;
  const bf16*ksrc=Kh+(long)lane*PIN+wid*8;
  const bf16*vsrc=Vh+(long)(16*(wid&3)+(lane>>2))*PIN+(wid>>2)*32+(lane&3)*8;
  const unsigned kdst=lds0+LDS_K+wid*1024, vdst=lds0+LDS_V+wid*1024;
  #define DMA_K(t,slot) glds16(ksrc+(long)(t)*KVBLK*PIN,(unsigned)__builtin_amdgcn_readfirstlane(kdst+(slot)))
  #define DMA_V(t,slot) glds16(vsrc+(long)(t)*KVBLK*PIN,(unsigned)__builtin_amdgcn_readfirstlane(vdst+(slot)))
  const int vb0=(int)(lds0+LDS_V)+((lane>>4)&1)*32+(lane&3)*8+(4*hi+((lane&15)>>2))*64;
  const char*Kbase=shm+LDS_K; bf16x8 kf[8];
  const lds_cptr shm3=(lds_cptr)shm; const lds_cptr kp0=shm3+LDS_K+hi*1024+r32*16; const lds_cptr vp0=shm3+LDS_V+((lane>>4)&1)*32+(lane&3)*8+(4*hi+((lane&15)>>2))*64;
  const int NT=(q0+QB)/KVBLK;
  const lds_fptr dtab=(lds_fptr)(shm3+LDS_DTAB);
  if(fill){ const f32x4g*src=(const f32x4g*)(DC+(long)(b*NHEAD+h)*SEQ); for(int i=tid;i<SEQ/4;i+=NW*64) ((__attribute__((address_space(3))) f32x4g*)dtab)[i]=src[i]; }
  DMA_K(0,0);DMA_V(0,0);DMA_K(1,SLOTB);
  bf16x8 qr[4];
  #pragma unroll
  for(int d0=0;d0<4;++d0)qr[d0]=*reinterpret_cast<const bf16x8*>(&Qw[(long)r32*PIN+d0*16+hi*8]);
  float mhat=0.f,l_reg=0.f;f32x16 o[2];o[0]=f32x16{};o[1]=f32x16{}; float dq=0.f;
  #define BIAS(C0,C1,t) do{ const float base_=dq-mhat; const lds_fptr dk_=dtab+(t)*KVBLK+4*hi; \
    _Pragma("unroll") for(int g_=0;g_<4;++g_){ const f32x4g a_=*(const __attribute__((address_space(3))) f32x4g*)(dk_+8*g_), b_=*(const __attribute__((address_space(3))) f32x4g*)(dk_+32+8*g_); \
      _Pragma("unroll") for(int q_=0;q_<4;++q_){ C0[4*g_+q_]=base_-a_[q_]; C1[4*g_+q_]=base_-b_[q_]; } } }while(0)
  const int qrel=wid*QBLK+r32;
  #define CMASK(P0,P1,t) do{int jb_=(t)-(NT-4); if(jb_>=0)cmask(P0,P1,jb_,qrel,hi);}while(0)
  bool resc=false;
  #define START(P0,P1) do{ const float rm=rowmax(P0,P1); resc=false; \
    { const float dl=rm; mhat=fadd_s(mhat,dl); \
      _Pragma("unroll") for(int r=0;r<16;++r){P0[r]=fsub_s(P0[r],dl);P1[r]=fsub_s(P1[r],dl);} \
      } \
    _Pragma("unroll") for(int r=0;r<16;++r)P0[r]=__builtin_amdgcn_exp2f(P0[r]); }while(0)
  #define RESC() do{ if(resc){ asm volatile("s_waitcnt lgkmcnt(0)":::"memory"); \
      _Pragma("unroll") for(int d_=0;d_<2;++d_) _Pragma("unroll") for(int r=0;r<16;++r)o[d_][r]*=wsf[crow(r,hi)]; } }while(0)
  f32x16 pA0,pA1,pB0,pB1;
  int sl_prev=0,sl_cur=0,sl_next=SLOTB;
  #define ROT() do{sl_prev=sl_cur;sl_cur=sl_next;sl_next=(sl_next==(NSLOT-1)*SLOTB)?0:sl_next+SLOTB;}while(0)
  DMA_K(2,2*SLOTB);
  WAIT_BAR(3);
  dq=dtab[q0+wid*QBLK+r32];
  BIAS(pA0,pA1,0); qkt(pA0,pA1,Kbase,qr,r32,hi);asm volatile("s_nop 15\n\ts_nop 7":"+v"(pA0),"+v"(pA1));CMASK(pA0,pA1,0);
  START(pA0,pA1);
  _Pragma("unroll") for(int r=0;r<16;++r)pA1[r]=__builtin_amdgcn_exp2f(pA1[r]);
  WAIT_BAR(0);
  DMA_K(3,0);DMA_V(1,SLOTB);
  ROT();
  kload8(kf,kp0+sl_cur);
  WAIT_BAR(2);
  s16x4 vlo[8],vhi[8]; u32x4 pw0,pw1,pw2,pw3;
  #define PKW(P,B) cvtpk_s(P[B],P[B+1])
  #define PAF(k) __builtin_bit_cast(bf16x8,pw##k)
  #define VFR(i) (bf16x8){vlo[i][0],vlo[i][1],vlo[i][2],vlo[i][3],vhi[i][0],vhi[i][1],vhi[i][2],vhi[i][3]}
  #define PIN(x) asm volatile("":"+v"(x))
  #define MX3(a,b,c) __builtin_fmaxf(__builtin_fmaxf((a),(b)),(c))
  #define GAPA(MF,A0,A1,A2,A3,W0,W1,PW) do{ MF; sacc+=A0; sacc+=A1; sacc+=A2; sacc+=A3; PIN(sacc); W0; W1; PIN(PW); SBAR(); }while(0)
  #define EX(v) __builtin_amdgcn_exp2f(v)
  #define GAPB(MF,X,B) do{ MF; X[B]=EX(X[B]); X[B+1]=EX(X[B+1]); X[B+2]=EX(X[B+2]); X[B+3]=EX(X[B+3]); PIN(X); SBAR(); }while(0)
  #define VRD(i) do{ vlo[i]=vtr(vp_+(((i)>>2)*4096+((i)&3)*1024)); vhi[i]=vtr(vp_+(((i)>>2)*4096+((i)&3)*1024+512)); }while(0)
  #define KRD(G,j) do{ if(G){ kload2(kf,kp0+sl_next,j); SBAR(); } }while(0)
  #define STEP(C0,C1,P0,P1,t,GK,GV,GL) do{ SBAR(); BIAS(C0,C1,t); SBAR(); \
    const lds_cptr vp_=vp0+sl_prev; \
    VRD(0); SBAR(); float sacc=(P0[0]+P0[1]); \
    GAPA(C0=__builtin_amdgcn_mfma_f32_32x32x16_bf16(kf[0],qr[0],C0,0,0,0), P0[2],P0[3],P0[4],P0[5],     pw0[0]=PKW(P0,0), pw0[1]=PKW(P0,2), pw0); \
    VRD(4); SBAR(); GAPA(C1=__builtin_amdgcn_mfma_f32_32x32x16_bf16(kf[1],qr[0],C1,0,0,0), P0[6],P0[7],P0[8],P0[9],     pw0[2]=PKW(P0,4), pw0[3]=PKW(P0,6), pw0); \
    VRD(1); SBAR(); GAPA(C0=__builtin_amdgcn_mfma_f32_32x32x16_bf16(kf[2],qr[1],C0,0,0,0),   P0[10],P0[11],P0[12],P0[13], pw1[0]=PKW(P0,8), pw1[1]=PKW(P0,10), pw1); \
    VRD(5); SBAR(); GAPA(C1=__builtin_amdgcn_mfma_f32_32x32x16_bf16(kf[3],qr[1],C1,0,0,0),   P0[14],P0[15],P1[0],P1[1],   pw1[2]=PKW(P0,12),pw1[3]=PKW(P0,14), pw1); \
    VRD(2); SBAR(); GAPA(C0=__builtin_amdgcn_mfma_f32_32x32x16_bf16(kf[4],qr[2],C0,0,0,0),   P1[2],P1[3],P1[4],P1[5],     pw2[0]=PKW(P1,0), pw2[1]=PKW(P1,2), pw2); \
    VRD(6); SBAR(); GAPA(C1=__builtin_amdgcn_mfma_f32_32x32x16_bf16(kf[5],qr[2],C1,0,0,0),   P1[6],P1[7],P1[8],P1[9],     pw2[2]=PKW(P1,4), pw2[3]=PKW(P1,6), pw2); \
    VRD(3); SBAR(); GAPA(C0=__builtin_amdgcn_mfma_f32_32x32x16_bf16(kf[6],qr[3],C0,0,0,0),   P1[10],P1[11],P1[12],P1[13], pw3[0]=PKW(P1,8), pw3[1]=PKW(P1,10), pw3); \
    VRD(7); SBAR(); GAPA(C1=__builtin_amdgcn_mfma_f32_32x32x16_bf16(kf[7],qr[3],C1,0,0,0),   P1[14],P1[15],0.f,0.f,       pw3[2]=PKW(P1,12),pw3[3]=PKW(P1,14), pw3); \
    l_reg+=sacc; \
    if(GK){DMA_K((t)+3,sl_cur);} if(GV){DMA_V((t)+1,sl_next);} \
    CMASK(C0,C1,t); \
    { float a=MX3(C0[0],C0[1],C1[0]),b=MX3(C0[2],C0[3],C1[1]); a=MX3(a,C1[2],C1[3]); \
      _Pragma("unroll") for(int r=4;r<16;r+=4){a=MX3(a,C0[r],C0[r+1]);b=MX3(b,C0[r+2],C0[r+3]);a=MX3(a,C1[r],C1[r+1]);b=MX3(b,C1[r+2],C1[r+3]);} \
      float rm=__builtin_fmaxf(a,b); { auto rr=__builtin_amdgcn_permlane32_swap(__float_as_uint(rm),__float_as_uint(rm),false,false); rm=__builtin_fmaxf(__uint_as_float(rr[0]),__uint_as_float(rr[1])); } \
      resc=false; \
      if(__builtin_expect(__any(rm>(float)THRL),0)){ const float dl=__builtin_fmaxf(rm,0.f); mhat+=dl; \
        _Pragma("unroll") for(int r=0;r<16;++r){C0[r]-=dl;C1[r]-=dl;} \
        const float f=__builtin_amdgcn_exp2f(-dl); l_reg*=f; if(hi==0)wsf[r32]=f; resc=true; } } \
    SBAR(); \
    GAPB(o[0]=__builtin_amdgcn_mfma_f32_32x32x16_bf16(PAF(0),VFR(0),o[0],0,0,0), C0,0); \
    GAPB(o[1]=__builtin_amdgcn_mfma_f32_32x32x16_bf16(PAF(0),VFR(4),o[1],0,0,0), C0,4); \
    KRD(GL,0); GAPB(o[0]=__builtin_amdgcn_mfma_f32_32x32x16_bf16(PAF(1),VFR(1),o[0],0,0,0), C0,8); \
    KRD(GL,1); GAPB(o[1]=__builtin_amdgcn_mfma_f32_32x32x16_bf16(PAF(1),VFR(5),o[1],0,0,0), C0,12); \
    KRD(GL,2); GAPB(o[0]=__builtin_amdgcn_mfma_f32_32x32x16_bf16(PAF(2),VFR(2),o[0],0,0,0), C1,0); \
    KRD(GL,3); GAPB(o[1]=__builtin_amdgcn_mfma_f32_32x32x16_bf16(PAF(2),VFR(6),o[1],0,0,0), C1,4); \
    GAPB(o[0]=__builtin_amdgcn_mfma_f32_32x32x16_bf16(PAF(3),VFR(3),o[0],0,0,0), C1,8); \
    GAPB(o[1]=__builtin_amdgcn_mfma_f32_32x32x16_bf16(PAF(3),VFR(7),o[1],0,0,0), C1,12); \
    }while(0)
  int t=1;
  #undef CMASK
  #define CMASK(P0,P1,t) do{}while(0)
  for(;t+5<NT;t+=2){
    STEP(pB0,pB1,pA0,pA1,t,true,true,true);     WAIT_BAR(2); RESC(); ROT();
    STEP(pA0,pA1,pB0,pB1,t+1,true,true,true);   WAIT_BAR(2); RESC(); ROT();
  }
  #undef CMASK
  #define CMASK(P0,P1,t) do{int jb_=(t)-(NT-4); if(jb_>=0)cmask(P0,P1,jb_,qrel,hi);}while(0)
  #define ENDW(tt) do{ if((tt)+3<NT){WAIT_BAR(2);} else if((tt)+2<NT){WAIT_BAR(1);} else {WAIT_BAR(0);} }while(0)
  for(;t+1<NT;t+=2){
    STEP(pB0,pB1,pA0,pA1,t,(t+3<NT),(t+1<NT),(t+1<NT));       ENDW(t);   RESC(); ROT();
    STEP(pA0,pA1,pB0,pB1,t+1,(t+4<NT),(t+2<NT),(t+2<NT));     ENDW(t+1); RESC(); ROT();
  }
  STEP(pB0,pB1,pA0,pA1,NT-1,false,false,false); RESC();
  { float sacc=pB0[0]+pB0[1]; _Pragma("unroll") for(int r=2;r<16;++r)sacc+=pB0[r]; _Pragma("unroll") for(int r=0;r<16;++r)sacc+=pB1[r]; l_reg+=sacc;
    pw0=(u32x4){PKW(pB0,0),PKW(pB0,2),PKW(pB0,4),PKW(pB0,6)};pw1=(u32x4){PKW(pB0,8),PKW(pB0,10),PKW(pB0,12),PKW(pB0,14)};pw2=(u32x4){PKW(pB1,0),PKW(pB1,2),PKW(pB1,4),PKW(pB1,6)};pw3=(u32x4){PKW(pB1,8),PKW(pB1,10),PKW(pB1,12),PKW(pB1,14)};
    SBAR(); pv(o,vb0+sl_cur,PAF(0),PAF(1),PAF(2),PAF(3)); }
  #undef PKW
  #undef PAF
  #undef VFR
  #undef PIN
  #undef MX3
  #undef GAPA
  #undef GAPB
  #undef EX
  #undef VRD
  #undef KRD
  #undef STEP
  #undef ENDW
  {auto rr=__builtin_amdgcn_permlane32_swap(__float_as_uint(l_reg),__float_as_uint(l_reg),false,false);l_reg=__uint_as_float(rr[0])+__uint_as_float(rr[1]);}
  if(hi==0)wsf[32+r32]=l_reg;asm volatile("s_waitcnt lgkmcnt(0)":::"memory");
  float rli[16];
  #pragma unroll
  for(int r=0;r<16;++r)rli[r]=__builtin_amdgcn_rcpf(wsf[32+crow(r,hi)]);
  bf16*Ow=O+(rowbase+q0+wid*QBLK)*POUT+h*D; const bf16*Gw=OG+(rowbase+q0+wid*QBLK)*PIN+h*D;
  { bf16*stg=(bf16*)(shm+LDS_OST)+wid*2048;
    #pragma unroll
    for(int r=0;r<16;++r){const int orow=crow(r,hi);
      #pragma unroll
      for(int d0=0;d0<2;++d0)stg[orow*64+d0*32+r32]=__float2bfloat16(o[d0][r]*rli[r]);}
    asm volatile("s_waitcnt lgkmcnt(0)":::"memory");
    #pragma unroll
    for(int i=0;i<4;++i){const int row=i*8+(lane>>3),ch=lane&7; const u32x4 v=*(const u32x4*)(stg+row*64+ch*8); const u32x4 g=*(const u32x4*)(Gw+(long)row*PIN+ch*8); u32x4 w;
      _Pragma("unroll") for(int q_=0;q_<4;++q_){ const float gl=__uint_as_float(g[q_]<<16),gh=__uint_as_float(g[q_]&0xffff0000u),vl=__uint_as_float(v[q_]<<16),vh=__uint_as_float(v[q_]&0xffff0000u);
        w[q_]=cvtpk_s(vl*__builtin_amdgcn_rcpf(1.f+__builtin_amdgcn_exp2f(-1.4426950408889634f*gl)),vh*__builtin_amdgcn_rcpf(1.f+__builtin_amdgcn_exp2f(-1.4426950408889634f*gh))); }
      ATTN_STORE16(Ow+(long)row*POUT+ch*8,w);} }
  asm volatile("s_waitcnt lgkmcnt(0)\n\ts_barrier":::"memory");
  #undef DMA_K
  #undef DMA_V
  #undef CMASK
  #undef START
  #undef RESC
  #undef ROT
  #undef BIAS
}
constexpr int ATTN_LDS_BYTES=LDS_BYTES;
struct AttnTensors { const bf16* Q; const bf16* K; const bf16* V; const bf16* OG; const float* DC; bf16* O; };
struct AttnUnit { int bh; int qb; };
struct StaticOrder {
  int vcu;
  __device__ __forceinline__ explicit StaticOrder(int grid,int block):vcu((block%8)*(grid/8)+block/8){}
  __device__ __forceinline__ bool next(int i,AttnUnit&u)const{ if(i>=4)return false; const int s=vcu&3; u.bh=vcu>>2; u.qb=(i==0)?s:(i==1)?7-s:(i==2)?8+s:15-s; return true; }
  __device__ __forceinline__ void a_ready(const AttnUnit&)const{}
  __device__ __forceinline__ void done(const AttnUnit&)const{}
};
template<class Sched,int THRL=8> __device__ __forceinline__ void attn_phase(char*lds,const AttnTensors&T,const Sched&S){
  AttnUnit u;
  int last_bh=-1;
  for(int i=0;S.next(i,u);++i){ S.a_ready(u); attn_unit<THRL>(u.bh/NHEAD,u.bh%NHEAD,u.qb,T.Q,T.K,T.V,T.OG,T.DC,T.O,lds,u.bh!=last_bh); last_bh=u.bh; S.done(u); }
}
#undef SBAR
#undef WAIT_BAR
}

__device__ __forceinline__ void moe_tables(const Params& P, LAS unsigned char* lds, int l) {
    LAS int* ts = (LAS int*)(lds + L_TS); LAS int* lc = (LAS int*)(lds + L_CNT);
    const unsigned* cnt = (const unsigned*)(P.ws + WS_CTL) + CW_CNT + 64 * l;
    if (threadIdx.x < 64) { const int ln = (int)threadIdx.x; const int c = ln < 32 ? (int)__hip_atomic_load(cnt + (ln & 31), RLX_AGENT) : 0; const int t = (c + 255) >> 8; int inc = t;
#pragma unroll
        for (int o = 1; o < 32; o <<= 1) { const int nb = __shfl_up(inc, o); if (ln >= o) inc += nb; }
        if (ln < 32) { lc[ln] = c; ts[ln] = inc - t; if (ln == 31) ts[32] = inc; } }
    __syncthreads();
}
__device__ __forceinline__ int moe_units(LAS unsigned char* lds, int NT, int vcu, const int* elist, const float* ewt, const float* bias) {
    const LAS int* ts = (const LAS int*)(lds + L_TS); LAS unsigned* ul = (LAS unsigned*)(lds + L_ULIST); LAS int* nu = (LAS int*)(lds + L_NU);
    { const int G = gridDim.x, total = ts[32] * NT, i = (int)threadIdx.x;
      if (i < 64) { const int L = i * G + vcu;
          if (L < total) { int e = 0;
#pragma unroll 1
              for (int q = 16; q >= 1; q >>= 1) if (ts[e + q] * NT <= L) e += q;
              const int up = L - ts[e] * NT, te = ts[e + 1] - ts[e]; const int nt = up / te, rt = up % te; ul[i] = (unsigned)(ts[e] + rt) | ((unsigned)(e * NT + nt) << 16); } }
      if (i == 0) nu[0] = vcu < total ? (total - vcu + G - 1) / G : 0; }
    __syncthreads();
    const LAS int* lc = (const LAS int*)(lds + L_CNT); const int n = nu[0];
    if (NT == 8) {
        LAS unsigned* tab = (LAS unsigned*)(lds + L_VEC); LAS float* bt = (LAS float*)(lds + L_VEC + 10240);
#pragma unroll 5
        for (int i = threadIdx.x; i < n * 256; i += 512) { const unsigned uw = ul[i >> 8]; const int pm = (int)(uw & 0xffffu), pn = (int)(uw >> 16), e = pn / NT; const int p = (pm - ts[e]) * 256 + (i & 255);
            tab[i] = (p < lc[e]) ? (unsigned)(elist[(size_t)e * T + p] >> 2) * 1024u : 0u; bt[i] = 32.0f * bias[(size_t)pn * 256 + (i & 255)] + ((i & 128) ? 32.0f : 0.0f); }
    } else {
        LAS unsigned* tab = (LAS unsigned*)(lds + L_VEC); LAS float* bt = (LAS float*)(lds + L_VEC + 10240);
#pragma unroll 3
        for (int i = threadIdx.x; i < n * 256; i += 512) { const unsigned uw = ul[i >> 8]; const int pm = (int)(uw & 0xffffu), pn = (int)(uw >> 16), e = pn / NT; const int p = (pm - ts[e]) * 256 + (i & 255);
            int info = -1; float w = 0.f; if (p < lc[e]) { info = elist[(size_t)e * T + p]; w = ewt[(size_t)e * T + p] * 0.25f; }
            tab[2 * i] = (unsigned)info; tab[2 * i + 1] = __float_as_uint(w); bt[i] = 64.0f * bias[(size_t)pn * 256 + (i & 255)]; }
    }
    __syncthreads();
    return nu[0];
}

constexpr int NPH = 46;
__host__ __device__ inline bool phase_active(int ph) { if (ph < 2) return true; const int s = (ph - 2) % 11, kind = ((ph - 2) / 11) % 3; if (s == 1) return kind != 2; if (s == 2) return kind != 0; if (s == 3) return kind != 2; if (s == 4) return kind == 1; if (s == 7) return false; return true; }


#ifndef ONLY
#define ONLY -1
#endif
#ifndef DUP_SEL
#define DUP_SEL 0
#endif
#ifndef PHMASK
#define PHMASK 0xffffffffu
#endif
#define PHM(x) ((ONLY < 0 || ONLY == (x)) && ((PHMASK >> (x)) & 1))
#define IN(k) (PHM(k) && lo <= (k) && (k) < hi)
#define INL(s) (PHM(2 + (s)) && lo <= (base + (s)) && (base + (s)) < hi)
#define SEAM(k) do { if ((k) + 1 < hi && P.use_bar) { xcd_barrier(bar); if (DUP_SEL == 9) xcd_barrier(bar); } } while (0)
#define TOKDUP(NCV, A) do { if (DUP_SEL == 6) { TokA A2 = A; unsigned char* dz = ws + WS_ACT; if (A2.xout) A2.xout = (float*)dz; if (A2.hout) A2.hout = (bf16*)(dz + 64 * MiB); A2.small_out = (float*)(dz + 96 * MiB); A2.tk_e = (int*)(dz + 100 * MiB); A2.tk_p = nullptr; A2.tk_w = (float*)(dz + 104 * MiB); A2.cnt = (int*)(ctl + 65536);     tok_phase<NCV>(A2, lds); __syncthreads(); } tok_phase<NCV>(A, lds); } while (0)
#define NREP(sel) ((DUP_SEL == (sel)) ? 2 : 1)
template <int l>
__device__ __forceinline__ void layer_body(const Params& P, LAS unsigned char* lds, const XcdBarrier& bar, const int vcu) {
    constexpr int kind = l % 3, j = l / 3, base = 2 + 11 * l;
    const int lo = P.ph_lo, hi = P.ph_hi; const int G = gridDim.x, bx = blockIdx.x;
    unsigned char* ws = P.ws; unsigned* ctl = (unsigned*)(ws + WS_CTL);
    float* X = (float*)(ws + WS_X); bf16* Hb = (bf16*)(ws + WS_H); float* Y = (float*)(ws + WS_Y); bf16* proj = (bf16*)(ws + WS_PROJ); bf16* core = (bf16*)(ws + WS_CORE);
    const float* mod = (const float*)(ws + WS_MOD); float* small = (float*)(ws + WS_SMALL);
    int* tke = (int*)(ws + WS_TKE); int* tkp = (int*)(ws + WS_TKP); float* tkw = (float*)(ws + WS_TKW);

        const float* modl = mod + (size_t)l * NB * 6144;
        if (INL(0)) {
            pg8::Gemm g{}; pg8::EpiBf16Plain E{};
            g.A = Hb; g.M = T; g.K = 1024; g.lda = 1024; g.a_pn_stride = 0; E.O = proj;
            if (kind == 0) { g.Bt = (const bf16*)(ws + WT_GLA_IN) + (size_t)j * 3072 * 1024; g.N = 3072; E.ldc = 3072; E.gelu_pn_lt = 0; }
            else if (kind == 1) { g.Bt = (const bf16*)(ws + WT_RG_IN); g.N = 2560; E.ldc = 2560; E.gelu_pn_lt = 5; }
            else { g.Bt = (const bf16*)(ws + WT_FOX_IN); g.N = 4096; E.ldc = 4096; E.gelu_pn_lt = 0; }
            pg8::StaticOrder S; S.init(T, g.N, G, bx);
            if (kind == 2) fox_dcum(P, lds);
            for (int rep = 0; rep < NREP(3); ++rep) pg8::gemm_phase<pg8::EpiBf16Plain, pg8::StaticOrder, true, true>(lds, g, S, E);
            if (kind == 2) {
                __builtin_amdgcn_fence(__ATOMIC_ACQUIRE, "agent"); asm volatile("s_waitcnt vmcnt(0)" ::: "memory");
                pg8::Unit uu; for (int i = 0; S.next(i, uu); ++i) if (uu.pn < 8) fox_norm_tile(P, uu.pm, uu.pn); }
            SEAM(base + 0);
        }
        if (INL(1) && kind != 2) {
            if (kind == 0) { for (int rep = 0; rep < NREP(1); ++rep) gla_g1(P, lds, j); } else if (kind == 1) { for (int rep = 0; rep < NREP(4); ++rep) rg_conv(P); }
            SEAM(base + 1);
        }
        if (INL(2) && kind != 0) {
            if (kind == 1) {
                pg8::Gemm g{}; g.A = (const bf16*)(ws + WS_Y); g.Bt = (const bf16*)(ws + WT_RG_G); g.M = T; g.N = 2560; { int kq = 256; asm volatile("" : "+s"(kq)); g.K = kq; }     g.lda = 1280; g.a_pn_stride = 256;
                pg8::EpiRgGate E{(unsigned*)(ws + WS_MIX), (const bf16*)(ws + WS_Y), kin(I_RG_BRG), kin(I_RG_BIG), kin(I_RG_LAM)};
                pg8::StaticOrder S; S.init(T, 2560, G, bx);
                for (int rep = 0; rep < NREP(4); ++rep) pg8::gemm_phase<pg8::EpiRgGate, pg8::StaticOrder, true, true>(lds, g, S, E);
            } else { const attn_body::AttnTensors AT{(const attn_body::bf16*)proj, (const attn_body::bf16*)(proj + 1024), (const attn_body::bf16*)(proj + 2048), (const attn_body::bf16*)(proj + 3072), (const float*)(ws + WS_DCUM), (attn_body::bf16*)core};
                const attn_body::StaticOrder S(G, bx);
                for (int rep = 0; rep < NREP(2); ++rep) attn_body::attn_phase<attn_body::StaticOrder>((char*)lds, AT, S); }
            SEAM(base + 2);
        }
        if (INL(3) && kind != 2) { if (kind == 0) { for (int rep = 0; rep < NREP(11); ++rep) gla_g3(P, lds, j); } else { for (int rep = 0; rep < NREP(4); ++rep) rg_scan1(P); } SEAM(base + 3); }
        if (INL(4) && kind == 1) { for (int rep = 0; rep < NREP(4); ++rep) rg_scan2(P); SEAM(base + 4); }
        if (INL(5)) {
            pg8::Gemm g{}; g.A = core; g.M = T; g.N = 1024; g.a_pn_stride = 0;
            if (kind == 0) { g.Bt = (const bf16*)(ws + WT_GLA_OUT) + (size_t)j * 1024 * 1024; g.K = 1024; }
            else if (kind == 1) { g.Bt = (const bf16*)(ws + WT_RG_OUT); g.K = 1280; }
            else { g.Bt = (const bf16*)(ws + WT_FOX_OUT); g.K = 1024; }
            g.lda = g.K;
            pg8::EpiBf16Plain E{(bf16*)Y, 1024, 0}; pg8::StaticOrder S; S.init(T, 1024, G, bx);
            for (int rep = 0; rep < NREP(3); ++rep) pg8::gemm_phase<pg8::EpiBf16Plain, pg8::StaticOrder, true, true>(lds, g, S, E);
            SEAM(base + 5);
        }
        if (INL(6)) {
            TokA A{}; A.xin = (l == 0) ? kin(I_X) : X; A.xin_bf = (l != 0); A.xout_bf = 1; A.ymode = 1; A.y = Y; A.gvec = modl + 2048; A.gamma = kin(I_LN_G) + (size_t)(l * 2) * D; A.beta = kin(I_LN_B) + (size_t)(l * 2) * D; A.xout = X;
            A.scvec = modl + 4096; A.shvec = modl + 3072; A.hout = Hb; A.h_fp8 = 1; A.W = kin(I_MOE_WR) + (size_t)l * D * 32; A.ldw = 32; A.bias = kin(I_MOE_BR) + l * 32;
            A.cnt = (int*)(ctl + CW_CNT + 64 * l); A.tk_e = (int*)(ws + WS_ELIST); A.tk_p = nullptr; A.tk_w = (float*)(ws + WS_EWT);
            TOKDUP(32, A); SEAM(base + 6);
        }
        if (INL(8)) {
            moe_tables(P, lds, l); const int n = moe_units(lds, 8, vcu, (const int*)(ws + WS_ELIST), nullptr, (const float*)(ws + WS_BGUP) + (size_t)l * 32 * 2048);
            pg8::Gemm g{}; g.A = Hb; g.Bt = (const bf16*)(ws + WT_GU + (size_t)l * 32 * 2048 * 1024); g.M = NPAD_MAX; g.N = 32 * 2048; { int kq = 512; asm volatile("" : "+s"(kq)); g.K = kq; } g.lda = 512; g.a_pn_stride = 0; g.wscale = 0x7a7a7a7a;
            pg8::EpiSwiglu E{(bf16*)(ws + WS_ACT), (const LAS float*)(lds + L_VEC + 10240)};
            pg8::ListOrder S{(const LAS unsigned*)(lds + L_ULIST), n};
            for (int rep = 0; rep < NREP(3); ++rep) pg8::gemm_phase<pg8::EpiSwiglu, pg8::ListOrder, true, true, true, true>(lds, g, S, E, (const LAS unsigned*)(lds + L_VEC));
            SEAM(base + 8);
        }
        if (INL(9)) {
            if (P.ph_lo > base + 8) moe_tables(P, lds, l);
            const int n = moe_units(lds, 4, vcu, (const int*)(ws + WS_ELIST), (const float*)(ws + WS_EWT), kin(I_MOE_BDN) + (size_t)l * 32 * 1024);
            pg8::Gemm g{}; g.A = (const bf16*)(ws + WS_ACT); g.Bt = (const bf16*)(ws + WT_DN + (size_t)l * 32 * 1024 * 1024); g.M = NPAD_MAX; g.N = 32 * 1024; { int kq = 512; asm volatile("" : "+s"(kq)); g.K = kq; } g.lda = 512; g.a_pn_stride = 0; g.wscale = 0x79797979;
            pg8::EpiDown E{(bf16*)(ws + WS_YB), (const LAS unsigned*)(lds + L_VEC), (const LAS float*)(lds + L_VEC + 10240)};
            pg8::ListOrder S{(const LAS unsigned*)(lds + L_ULIST), n};
            for (int rep = 0; rep < NREP(3); ++rep) pg8::gemm_phase<pg8::EpiDown, pg8::ListOrder, true, true, false, true>(lds, g, S, E);
            SEAM(base + 9);
        }
        if (INL(10)) {
            TokA A{}; A.xin = X; A.xin_bf = 1; A.xout_bf = (l != 3); A.ymode = 2; A.yb = (const bf16*)(ws + WS_YB); A.gvec = modl + 5120; A.gamma = kin(I_LN_G) + (size_t)(l * 2 + 1) * D; A.beta = kin(I_LN_B) + (size_t)(l * 2 + 1) * D;
            A.xout = (l == 3) ? P.out : X;
            if (l < 3) { const float* modn = mod + (size_t)(l + 1) * NB * 6144; A.scvec = modn + 1024; A.shvec = modn; A.hout = Hb; A.small_out = small;
                const int nk = (l + 1) % 3;
                if (nk == 0) { A.W = kin(I_GLA_WIN) + (size_t)((l + 1) / 3) * 1024 * 3088 + 3072; A.ldw = 3088; TOKDUP(16, A); }
                else if (nk == 2) { A.W = kin(I_FOX_WIN) + 3072; A.ldw = 4112; TOKDUP(16, A); }
                else TOKDUP(0, A);
            } else TOKDUP(0, A);
            SEAM(base + 10);
        }
    }

__global__ void __launch_bounds__(512, 2) mega_fwd(Params P) {
    extern __shared__ __attribute__((aligned(16))) unsigned char lds_raw[];
    LAS unsigned char* lds = (LAS unsigned char*)lds_raw;
    const int tid = my_tid(), G = gridDim.x, bx = blockIdx.x;
    for (int i = tid; i < (LDS_BYTES - CTRL_OFF) / 4; i += 512) ((LAS unsigned*)(lds + CTRL_OFF))[i] = 0u;
    __syncthreads();
    unsigned char* ws = P.ws;
    unsigned* ctl = (unsigned*)(ws + WS_CTL);
    XcdBarrier bar; bar.bar = ctl + CW_BAR; bar.x = 0; bar.st = nullptr;
    if (P.use_bar) bar = xcd_barrier_post(ctl + CW_BAR, (volatile LAS unsigned*)(lds + L_MISC));
    const int vcu = (G % 8 == 0) ? (bx % 8) * (G / 8) + bx / 8 : bx;
    const int lo = P.ph_lo, hi = P.ph_hi;
    float* X = (float*)(ws + WS_X); bf16* Hb = (bf16*)(ws + WS_H); float* Y = (float*)(ws + WS_Y); bf16* proj = (bf16*)(ws + WS_PROJ); bf16* core = (bf16*)(ws + WS_CORE);
    const float* mod = (const float*)(ws + WS_MOD); float* small = (float*)(ws + WS_SMALL);
    int* tke = (int*)(ws + WS_TKE); int* tkp = (int*)(ws + WS_TKP); float* tkw = (float*)(ws + WS_TKW);

    if (IN(0)) { p0_adaln(P, lds); SEAM(0); }
    if (IN(1)) {
        TokA A{}; A.xin = kin(I_X); A.ymode = 0; A.scvec = mod + 1024; A.shvec = mod; A.hout = Hb; A.W = kin(I_GLA_WIN) + 3072; A.ldw = 3088; A.small_out = small;
        tok_phase<16>(A, lds); __syncthreads();
        for (int rep = 0; rep < NREP(5); ++rep) { p0_convert(P, lds); __syncthreads(); }
        SEAM(1);
    }
    layer_body<0>(P, lds, bar, vcu); layer_body<1>(P, lds, bar, vcu); layer_body<2>(P, lds, bar, vcu); layer_body<3>(P, lds, bar, vcu);
#undef IN
#undef INL
#undef SEAM
}

#ifndef MK_ONE_LAUNCH
#define MK_ONE_LAUNCH 1
#endif
extern "C" void kernel_launch(void* const* d_in, const int* in_sizes, int n_in, void* d_out, int out_size, void* d_ws, size_t ws_size, hipStream_t stream) {
    static int grid = 0;
    if (grid == 0) {
        if (n_in != 31 || out_size != T * D || ws_size < WS_END) { fprintf(stderr, "kernel_launch: unexpected shapes (n_in %d out %d ws %zu need %zu)\n", n_in, out_size, ws_size, (size_t)WS_END); grid = -1; return; }
        int dev = 0, cus = 0;
        if (hipGetDevice(&dev) != hipSuccess || hipDeviceGetAttribute(&cus, hipDeviceAttributeMultiprocessorCount, dev) != hipSuccess) { grid = -1; return; }
        if (hipFuncSetAttribute((const void*)mega_fwd, hipFuncAttributeMaxDynamicSharedMemorySize, LDS_BYTES) != hipSuccess) { fprintf(stderr, "kernel_launch: hipFuncSetAttribute failed\n"); grid = -1; return; }
        int per_cu = 0; (void)hipOccupancyMaxActiveBlocksPerMultiprocessor(&per_cu, (const void*)mega_fwd, 512, LDS_BYTES); (void)hipGetLastError();
        if (per_cu < 1) fprintf(stderr, "kernel_launch: occupancy query says %d\n", per_cu);
        grid = 256;
        if (cus != 256) fprintf(stderr, "kernel_launch: built for 256 CUs, device reports %d\n", cus);
    }
    if (grid < 0) return;
    (void)hipMemsetAsync((char*)d_ws + WS_CTL, 0, CTL_ZERO_BYTES, stream);
    Params p{};
    for (int i = 0; i < 31; ++i) p.in[i] = (const float*)d_in[i];
    p.out = (float*)d_out; p.ws = (unsigned char*)d_ws; p.pad = 0;
#if MK_ONE_LAUNCH
    p.ph_lo = 0; p.ph_hi = NPH; p.use_bar = 1;
    hipLaunchKernelGGL(mega_fwd, dim3(grid), dim3(512), LDS_BYTES, stream, p);
#else
    for (int ph = 0; ph < NPH; ++ph) { if (!phase_active(ph)) continue; p.ph_lo = ph; p.ph_hi = ph + 1; p.use_bar = 0;
        hipLaunchKernelGGL(mega_fwd, dim3(grid), dim3(512), LDS_BYTES, stream, p); }
#endif
}
```

```cpp
#include <hip/hip_runtime.h>
#include <cstdio>
#include <cstdint>
__device__ __forceinline__ int my_tid() { int t = (int)threadIdx.x; asm volatile("" : "+v"(t)); return t; }
namespace pg8 {
#define PG8_LAS __attribute__((address_space(3)))
typedef unsigned short bf16_t;
typedef short bf16x8 __attribute__((ext_vector_type(8)));
typedef float f32x4 __attribute__((ext_vector_type(4)));
typedef unsigned u32x4 __attribute__((ext_vector_type(4)));
constexpr int BM = 256, BK = 64, HALF = 128, HTB = HALF * BK * 2  , STAGE_BYTES = 8 * HTB, NXCD = 8, WGM = 8;
__host__ __device__ __forceinline__ int lds_byte(int r, int c) { const int st = (r >> 4) * 2 + (c >> 5), rr = r & 15, cc = c & 31, ob = rr * 64 + cc * 2; return st * 1024 + (ob ^ (((ob >> 9) & 1) << 5)); }
__host__ __device__ __forceinline__ void stage_rc(int b, int& R, int& C) { const int st = b / 1024, sb = b % 1024, swz = sb ^ (((sb >> 9) & 1) << 5); R = (st >> 1) * 16 + swz / 64; C = (st & 1) * 32 + (swz % 64) / 2; }
__host__ __device__ __forceinline__ int perm32(int rho) { const int n = rho >> 4, i = rho & 15; return 8 * (i >> 2) + 4 * n + (i & 3); }

struct Unit { int pm, pn, ui; };
struct Gemm { const bf16_t* A; const bf16_t* Bt; int M, N, K; int lda; size_t a_pn_stride; int wscale; };

struct StaticOrder {
    int nM, nN, nwg, G, c;
    __host__ __device__ void init(int M, int N, int G_, int c_) { nM = M / BM; nN = N / BM; nwg = nM * nN; G = G_; c = c_; }
    __host__ __device__ bool next(int i, Unit& u) const {
        const long L = (long)i * G + c; if (L >= nwg) return false;
        int wgid = (int)L; { const int q = nwg / NXCD, r = nwg % NXCD, xcd = wgid % NXCD, off = wgid / NXCD; wgid = (xcd < r ? xcd * (q + 1) : r * (q + 1) + (xcd - r) * q) + off; }
        const int nig = WGM * nN, gid = wgid / nig, fm = gid * WGM, gsz = (nM - fm) < WGM ? (nM - fm) : WGM;
        u.pm = fm + ((wgid % nig) % gsz); u.pn = (wgid % nig) / gsz; return true;
    }
    __device__ __forceinline__ void a_ready(const Unit&) const {}
    __device__ __forceinline__ void done(const Unit&) const {}
};

__device__ __forceinline__ unsigned cvt_pk_bf16(float lo, float hi) { unsigned r; asm volatile("v_cvt_pk_bf16_f32 %0, %1, %2" : "=v"(r) : "v"(lo), "v"(hi)); return r; }
typedef float f32x2 __attribute__((ext_vector_type(2)));

__device__ __forceinline__ float fast_sigmoid(float x) { return __builtin_amdgcn_rcpf(1.0f + __builtin_amdgcn_exp2f(-1.4426950408889634f * x)); }
__device__ __forceinline__ float gelu_tanh(float x) { const float u = 0.7978845608028654f * (x + 0.044715f * x * x * x); return x * fast_sigmoid(2.0f * u); }
struct EpiBf16Plain {
    static constexpr bool PERM = true, AFTER_DRAIN = false, BIAS_INIT = false;
    bf16_t* O; int ldc; int gelu_pn_lt; float oscale;
    __device__ __forceinline__ void operator()(const f32x4 (&acc)[2][2][4][2], const Unit& u, int wr, int wc, int fr, int fq) const {
        const int row0 = u.pm * BM + wr * 64 + fr, col0 = u.pn * BM + wc * 32 + 8 * fq; const bool g = u.pn < gelu_pn_lt;
#pragma unroll
        for (int ai = 0; ai < 2; ++ai)
#pragma unroll
            for (int m = 0; m < 4; ++m) { bf16_t* rowp = O + (size_t)(row0 + ai * HALF + m * 16) * ldc + col0;
#pragma unroll
                for (int bj = 0; bj < 2; ++bj) { f32x4 v0 = acc[ai][bj][m][0] * oscale, v1 = acc[ai][bj][m][1] * oscale;
                    if (g) {
#pragma unroll
                        for (int q = 0; q < 4; ++q) { v0[q] = gelu_tanh(v0[q]); v1[q] = gelu_tanh(v1[q]); } }
                    u32x4 w; w.x = cvt_pk_bf16(v0[0], v0[1]); w.y = cvt_pk_bf16(v0[2], v0[3]); w.z = cvt_pk_bf16(v1[0], v1[1]); w.w = cvt_pk_bf16(v1[2], v1[3]);
                    *(u32x4*)(rowp + bj * HALF) = w; } }
    }
};
struct EpiSwiglu {
    static constexpr bool PERM = true, AFTER_DRAIN = false, BIAS_INIT = true;
    bf16_t* act; const PG8_LAS float* bl;
    __device__ __forceinline__ void bias_init(f32x4 (&b)[2][2], const Unit& u, int wc, int fq) const { const PG8_LAS float* bp = bl + u.ui * 256 + wc * 32 + 8 * fq;
#pragma unroll
        for (int bj = 0; bj < 2; ++bj)
#pragma unroll
            for (int n = 0; n < 2; ++n) b[bj][n] = *(const PG8_LAS f32x4*)(bp + bj * HALF + 4 * n); }
    __device__ __forceinline__ void operator()(const f32x4 (&acc)[2][2][4][2], const Unit& u, int wr, int wc, int fr, int fq) const {
        const int nt = u.pn & 7; const int row0 = u.pm * BM + wr * 64 + fr, cl = wc * 32 + 8 * fq, colo = nt * 128 + cl;
#pragma unroll
        for (int ai = 0; ai < 2; ++ai)
#pragma unroll
            for (int m = 0; m < 4; ++m) { unsigned char* rowp = (unsigned char*)act + (size_t)(row0 + ai * HALF + m * 16) * 1024 + colo;
                float o[8];
#pragma unroll
                for (int n = 0; n < 2; ++n) { const f32x4 G = acc[ai][0][m][n], U = acc[ai][1][m][n]; f32x4 gc, uc, ex, r;
#pragma unroll
                    for (int q = 0; q < 4; ++q) { gc[q] = __builtin_amdgcn_fmed3f(G[q], -3.0e38f, 224.0f); uc[q] = __builtin_amdgcn_fmed3f(U[q], -192.0f, 256.0f); }
                    const f32x4 ea = gc * -0.07673331611f + 10.0f;
#pragma unroll
                    for (int q = 0; q < 4; ++q) ex[q] = __builtin_amdgcn_exp2f(ea[q]);
                    const f32x4 den = ex + 1024.0f;
#pragma unroll
                    for (int q = 0; q < 4; ++q) r[q] = __builtin_amdgcn_rcpf(den[q]);
                    const f32x4 o4 = uc * gc * r;
#pragma unroll
                    for (int q = 0; q < 4; ++q) o[n * 4 + q] = o4[q]; }
                int p0 = 0, p1 = 0; p0 = __builtin_amdgcn_cvt_pk_fp8_f32(o[0], o[1], p0, false); p0 = __builtin_amdgcn_cvt_pk_fp8_f32(o[2], o[3], p0, true); p1 = __builtin_amdgcn_cvt_pk_fp8_f32(o[4], o[5], p1, false); p1 = __builtin_amdgcn_cvt_pk_fp8_f32(o[6], o[7], p1, true);
                typedef unsigned u32x2_ __attribute__((ext_vector_type(2))); *(u32x2_*)rowp = (u32x2_){(unsigned)p0, (unsigned)p1}; }
    }
};
struct EpiDown {
    static constexpr bool PERM = true, AFTER_DRAIN = false, BIAS_INIT = true;
    bf16_t* yb; const PG8_LAS unsigned* rt; const PG8_LAS float* bl;
    __device__ __forceinline__ void bias_init(f32x4 (&b)[2][2], const Unit& u, int wc, int fq) const { const PG8_LAS float* bp = bl + u.ui * 256 + wc * 32 + 8 * fq;
#pragma unroll
        for (int bj = 0; bj < 2; ++bj)
#pragma unroll
            for (int n = 0; n < 2; ++n) b[bj][n] = *(const PG8_LAS f32x4*)(bp + bj * HALF + 4 * n); }
    __device__ __forceinline__ void operator()(const f32x4 (&acc)[2][2][4][2], const Unit& u, int wr, int wc, int fr, int fq) const {
        const int nt = u.pn & 3; const int cl = wc * 32 + 8 * fq, col0 = nt * 256 + cl;
        typedef unsigned u32x2_ __attribute__((ext_vector_type(2)));
        const PG8_LAS unsigned* rp = rt + (u.ui * 256 + wr * 64 + fr) * 2;
#pragma unroll
        for (int ai = 0; ai < 2; ++ai)
#pragma unroll
            for (int m = 0; m < 4; ++m) { const u32x2_ iw = *(const PG8_LAS u32x2_*)(rp + (ai * HALF + m * 16) * 2); const int info = (int)iw.x; const float w = __uint_as_float(iw.y);
                if (info >= 0) { unsigned char* rowp = (unsigned char*)yb + (size_t)info * 1024 + col0;
#pragma unroll
                    for (int bj = 0; bj < 2; ++bj) {
                        const f32x4 v0 = acc[ai][bj][m][0] * w, v1 = acc[ai][bj][m][1] * w;
                        f32x4 c0, c1;
#pragma unroll
                        for (int q_ = 0; q_ < 4; ++q_) { c0[q_] = __builtin_amdgcn_fmed3f(v0[q_], -440.f, 440.f); c1[q_] = __builtin_amdgcn_fmed3f(v1[q_], -440.f, 440.f); }
                        int q0 = 0, q1 = 0; q0 = __builtin_amdgcn_cvt_pk_fp8_f32(c0[0], c0[1], q0, false); q0 = __builtin_amdgcn_cvt_pk_fp8_f32(c0[2], c0[3], q0, true); q1 = __builtin_amdgcn_cvt_pk_fp8_f32(c1[0], c1[1], q1, false); q1 = __builtin_amdgcn_cvt_pk_fp8_f32(c1[2], c1[3], q1, true);
                        *(u32x2_*)(rowp + bj * HALF) = (u32x2_){(unsigned)q0, (unsigned)q1}; } } }
    }
};
struct EpiRgGate {
    static constexpr bool PERM = false, AFTER_DRAIN = false, BIAS_INIT = false;
    unsigned* AU; const bf16_t* xc; const float* brg; const float* big; const float* lam;
    __device__ __forceinline__ void operator()(const f32x4 (&acc)[2][2][4][2], const Unit& u, int wr, int wc, int fr, int fq) const {
        const int row0 = u.pm * BM + wr * 64 + fr, ch0 = u.pn * 128 + wc * 32 + 4 * fq;
        unsigned long long xw[2][2][4];
#pragma unroll
        for (int n = 0; n < 2; ++n)
#pragma unroll
            for (int ai = 0; ai < 2; ++ai)
#pragma unroll
                for (int m = 0; m < 4; ++m) xw[n][ai][m] = *(const unsigned long long*)(xc + (size_t)(row0 + ai * HALF + m * 16) * 1280 + ch0 + 16 * n);
#pragma unroll
        for (int n = 0; n < 2; ++n) { const int ch = ch0 + 16 * n;
            const f32x4 br = *(const f32x4*)(brg + ch), bi = *(const f32x4*)(big + ch), lm = *(const f32x4*)(lam + ch); f32x4 sp;
#pragma unroll
            for (int q = 0; q < 4; ++q) sp[q] = lm[q] < -20.f ? -lm[q] : log1pf(__expf(-lm[q]));
#pragma unroll
            for (int ai = 0; ai < 2; ++ai)
#pragma unroll
                for (int m = 0; m < 4; ++m) { const size_t row = (size_t)(row0 + ai * HALF + m * 16);
                    const unsigned long long xq = xw[n][ai][m];
                    const float xv[4] = {__uint_as_float((unsigned)xq << 16), __uint_as_float((unsigned)xq & 0xffff0000u), __uint_as_float((unsigned)(xq >> 32) << 16), __uint_as_float((unsigned)(xq >> 32) & 0xffff0000u)};
                    u32x4 au;
#pragma unroll
                    for (int q = 0; q < 4; ++q) { const float rr = fast_sigmoid(acc[ai][0][m][n][q] + br[q]), ii = fast_sigmoid(acc[ai][1][m][n][q] + bi[q]); const float la = -8.0f * rr * sp[q];
                        const float x2 = 2.0f * la; const float om = x2 > -0.01f ? -x2 * (1.0f + x2 * (0.5f + x2 * 0.16666667f)) : 1.0f - __expf(x2);
                        au[q] = cvt_pk_bf16(la, __builtin_amdgcn_sqrtf(om) * (ii * xv[q])); }
                    *(u32x4*)(AU + row * 1280 + ch) = au; } }
    }
};
struct ListOrder {
    const PG8_LAS unsigned* list; int n;
    __device__ __forceinline__ bool next(int i, Unit& u) const { if (i >= n) return false; const unsigned v = (unsigned)__builtin_amdgcn_readfirstlane((int)list[i]); u.pm = (int)(v & 0xffffu); u.pn = (int)(v >> 16); u.ui = i; return true; }
    __device__ __forceinline__ void a_ready(const Unit&) const {}
    __device__ __forceinline__ void done(const Unit&) const {}
};
template <class Epi, class Sched, bool ALIGN_EPI = false, bool SP2 = false, bool GATHER = false, bool FP8 = false>
__device__ __forceinline__ void gemm_phase(PG8_LAS unsigned char* lds, const Gemm g, const Sched& S, const Epi& E, const PG8_LAS unsigned* gtab = nullptr) {
    const int tid = my_tid(), wid = __builtin_amdgcn_readfirstlane(tid >> 6), lane = tid & 63, wr = wid >> 2, wc = wid & 3, fr = lane & 15, fq = lane >> 4;
    const int K = g.K, nt = K / BK;
    unsigned voffA[2], voffB[2];
#pragma unroll
    for (int i = 0; i < 2; ++i) { int R, C; stage_rc(tid * 16 + i * 8192, R, C); const int Rb = Epi::PERM ? ((R & ~31) + perm32(R & 31)) : R;
        voffA[i] = (unsigned)(R * g.lda + C) * 2u; voffB[i] = (unsigned)(Rb * K + C) * 2u; }
    const size_t kstep = (size_t)(BK * 2);
    const size_t hstepA = (size_t)HALF * g.lda * 2, hstepB = (size_t)HALF * K * 2;
    const size_t tstepA = 2 * hstepA, tstepB = 2 * hstepB;
    const unsigned ldsw = (unsigned)wid * 1024u;
    const int aoff = lds_byte(wr * 64 + fr, fq * 8), boff = lds_byte(wc * 32 + fr, fq * 8);
#define PG8_SA(b, h) (((b) * 2 + (h)) * HTB)
#define PG8_SB(b, h) ((4 + (b) * 2 + (h)) * HTB)
#define PG8_STAGE(bufoff, gbase, voff) do { _Pragma("unroll") for (int _i = 0; _i < 2; ++_i) { unsigned o_ = (voff)[_i]; asm volatile("" : "+v"(o_));     \
        __builtin_amdgcn_global_load_lds((const unsigned*)((const char*)(gbase) + o_), (PG8_LAS unsigned*)(lds + (bufoff) + ldsw + _i * 8192), 16, 0, 0); } } while (0)
#define PG8_LDA(dst, b, h) do { _Pragma("unroll") for (int m = 0; m < 4; ++m) { dst[m].lo = *(const PG8_LAS bf16x8*)(lds + PG8_SA(b, h) + aoff + m * 2048); dst[m].hi = *(const PG8_LAS bf16x8*)(lds + PG8_SA(b, h) + aoff + m * 2048 + 1024); } } while (0)
#define PG8_LDB(dst, b, h) do { _Pragma("unroll") for (int n = 0; n < 2; ++n) { dst[n].lo = *(const PG8_LAS bf16x8*)(lds + PG8_SB(b, h) + boff + n * 2048); dst[n].hi = *(const PG8_LAS bf16x8*)(lds + PG8_SB(b, h) + boff + n * 2048 + 1024); } } while (0)
#define PG8_MMA(ai, bj, At, Bt) do { __builtin_amdgcn_s_setprio(1); \
        if constexpr (FP8) { typedef int v8i_ __attribute__((ext_vector_type(8))); \
            _Pragma("unroll") for (int m = 0; m < 4; ++m) _Pragma("unroll") for (int n = 0; n < 2; ++n) \
                acc[ai][bj][m][n] = __builtin_amdgcn_mfma_scale_f32_16x16x128_f8f6f4(__builtin_bit_cast(v8i_, Bt[n]), __builtin_bit_cast(v8i_, At[m]), acc[ai][bj][m][n], 0, 0, 0, 0, 0, 0);     \
        } else { _Pragma("unroll") for (int m = 0; m < 4; ++m) _Pragma("unroll") for (int n = 0; n < 2; ++n) { \
            acc[ai][bj][m][n] = __builtin_amdgcn_mfma_f32_16x16x32_bf16(Bt[n].lo, At[m].lo, acc[ai][bj][m][n], 0, 0, 0); \
            acc[ai][bj][m][n] = __builtin_amdgcn_mfma_f32_16x16x32_bf16(Bt[n].hi, At[m].hi, acc[ai][bj][m][n], 0, 0, 0); } } __builtin_amdgcn_s_setprio(0); } while (0)
#define PG8_WAIT_V(n) asm volatile("s_waitcnt vmcnt(" #n ")" ::: "memory")
#define PG8_WAIT_L(n) asm volatile("s_waitcnt lgkmcnt(" #n ")" ::: "memory")
#define PG8_BAR __builtin_amdgcn_s_barrier()
#define PG8_SCHED __builtin_amdgcn_sched_barrier(0)
    Unit cur, nxt; int ui = 0;
    if (!S.next(0, cur)) return;
    f32x4 acc[2][2][4][2];
#define PG8_ACC_INIT(unit_) do { f32x4 i_[2][2]; if constexpr (Epi::BIAS_INIT) { int t3_ = (int)threadIdx.x; asm volatile("" : "+v"(t3_)); E.bias_init(i_, unit_, wc, (t3_ & 63) >> 4); } \
        else { _Pragma("unroll") for (int b = 0; b < 2; ++b) _Pragma("unroll") for (int n = 0; n < 2; ++n) i_[b][n] = (f32x4){0.f, 0.f, 0.f, 0.f}; } \
        _Pragma("unroll") for (int a = 0; a < 2; ++a) _Pragma("unroll") for (int b = 0; b < 2; ++b) _Pragma("unroll") for (int m = 0; m < 4; ++m) _Pragma("unroll") for (int n = 0; n < 2; ++n) acc[a][b][m][n] = i_[b][n]; } while (0)
    PG8_ACC_INIT(cur);
    typedef short bf16x16 __attribute__((ext_vector_type(16)));
    bf16x16 At[4], B0[2], B1[2];
    const char* cA = GATHER ? (const char*)g.A : (const char*)g.A + (size_t)cur.pm * tstepA + (size_t)cur.pn * g.a_pn_stride;
    unsigned gvc[2][2];
#define PG8_GLOAD(dst, ui_) do { int t_ = (int)threadIdx.x; asm volatile("" : "+v"(t_));     \
        _Pragma("unroll") for (int i_ = 0; i_ < 2; ++i_) { int R_, C_; stage_rc(t_ * 16 + i_ * 8192, R_, C_); \
            _Pragma("unroll") for (int h_ = 0; h_ < 2; ++h_) dst[h_][i_] = gtab[(ui_) * 256 + h_ * HALF + R_] + (unsigned)C_ * 2u; } } while (0)
#define PG8_AH(p, h) (GATHER ? (p) : (p) + (h) * hstepA)
    if constexpr (GATHER) { PG8_GLOAD(gvc, 0); }
    else { _Pragma("unroll") for (int h_ = 0; h_ < 2; ++h_) _Pragma("unroll") for (int i_ = 0; i_ < 2; ++i_) gvc[h_][i_] = voffA[i_]; }
    const char* cB = (const char*)g.Bt + (size_t)cur.pn * tstepB;
    S.a_ready(cur);
    if constexpr (SP2) {
        PG8_STAGE(PG8_SB(0, 0), cB, voffB); PG8_STAGE(PG8_SB(0, 1), cB + hstepB, voffB); PG8_STAGE(PG8_SA(0, 0), cA, gvc[0]); PG8_STAGE(PG8_SA(0, 1), PG8_AH(cA, 1), gvc[1]);
        if (wr == 1) PG8_BAR;
        PG8_WAIT_V(2); PG8_BAR;
        PG8_STAGE(PG8_SB(1, 0), cB + kstep, voffB); PG8_STAGE(PG8_SA(1, 0), cA + kstep, gvc[0]); PG8_STAGE(PG8_SB(1, 1), cB + hstepB + kstep, voffB);
        PG8_WAIT_V(6); PG8_BAR;
    } else {
        PG8_STAGE(PG8_SB(0, 0), cB, voffB); PG8_STAGE(PG8_SA(0, 0), cA, gvc[0]); PG8_STAGE(PG8_SB(0, 1), cB + hstepB, voffB); PG8_STAGE(PG8_SA(0, 1), PG8_AH(cA, 1), gvc[1]);
        if (wr == 1) PG8_BAR;
        PG8_WAIT_V(4); PG8_BAR;
        PG8_STAGE(PG8_SB(1, 0), cB + kstep, voffB); PG8_STAGE(PG8_SA(1, 0), cA + kstep, gvc[0]); PG8_STAGE(PG8_SB(1, 1), cB + hstepB + kstep, voffB);
        PG8_WAIT_V(6); PG8_BAR;
    }
    for (;;) {
        const bool has_next = S.next(ui + 1, nxt);
        const char* nA = GATHER ? cA : (has_next ? (const char*)g.A + (size_t)nxt.pm * tstepA + (size_t)nxt.pn * g.a_pn_stride : cA);
        const char* nB = has_next ? (const char*)g.Bt + (size_t)nxt.pn * tstepB : cB;
        for (int t = 0; t < nt; t += 2) {
            const bool last = (t == nt - 2);
            const char* a1 = cA + (size_t)(t + 1) * kstep;
            const char* a2 = last ? (GATHER ? (const char*)g.A : nA) : cA + (size_t)(t + 2) * kstep; const char* b2 = last ? nB : cB + (size_t)(t + 2) * kstep;
            const char* a3 = a2 + kstep; const char* b3 = b2 + kstep;
            if (last && has_next) S.a_ready(nxt);
            if constexpr (SP2) {
            PG8_LDB(B0, 0, 0); PG8_LDB(B1, 0, 1); PG8_SCHED; PG8_LDA(At, 0, 0); PG8_STAGE(PG8_SA(1, 1), PG8_AH(a1, 1), gvc[1]); if constexpr (GATHER) { if (last && has_next) PG8_GLOAD(gvc, ui + 1); }
            PG8_WAIT_V(8); PG8_WAIT_L(0); PG8_BAR; PG8_MMA(0, 0, At, B0); PG8_MMA(0, 1, At, B1); PG8_BAR; PG8_SCHED;
            PG8_LDA(At, 0, 1); PG8_STAGE(PG8_SB(0, 0), b2, voffB); PG8_STAGE(PG8_SB(0, 1), b2 + hstepB, voffB); PG8_STAGE(PG8_SA(0, 0), a2, gvc[0]);
            PG8_WAIT_V(8); PG8_WAIT_L(0); PG8_BAR; PG8_MMA(1, 0, At, B0); PG8_MMA(1, 1, At, B1); PG8_BAR; PG8_SCHED;
            PG8_LDB(B0, 1, 0); PG8_LDB(B1, 1, 1); PG8_SCHED; PG8_LDA(At, 1, 0); PG8_STAGE(PG8_SA(0, 1), PG8_AH(a2, 1), gvc[1]);
            PG8_WAIT_V(8); PG8_WAIT_L(0); PG8_BAR; PG8_MMA(0, 0, At, B0); PG8_MMA(0, 1, At, B1); PG8_BAR; PG8_SCHED;
            PG8_LDA(At, 1, 1); PG8_STAGE(PG8_SB(1, 0), b3, voffB); PG8_STAGE(PG8_SB(1, 1), b3 + hstepB, voffB); PG8_STAGE(PG8_SA(1, 0), a3, gvc[0]);
            PG8_WAIT_V(8); PG8_WAIT_L(0); PG8_BAR; PG8_MMA(1, 0, At, B0); PG8_MMA(1, 1, At, B1); PG8_BAR; PG8_SCHED;
            } else {
            PG8_LDB(B0, 0, 0); PG8_SCHED; PG8_LDA(At, 0, 0); PG8_STAGE(PG8_SA(1, 1), PG8_AH(a1, 1), gvc[1]); if constexpr (GATHER) { if (last && has_next) PG8_GLOAD(gvc, ui + 1); }
            PG8_WAIT_L(8); PG8_BAR; PG8_WAIT_L(0); PG8_MMA(0, 0, At, B0); PG8_BAR; PG8_SCHED;
            PG8_LDB(B1, 0, 1); PG8_STAGE(PG8_SB(0, 0), b2, voffB);
            PG8_BAR; PG8_WAIT_L(0); PG8_MMA(0, 1, At, B1); PG8_BAR;
            PG8_LDA(At, 0, 1); PG8_STAGE(PG8_SA(0, 0), a2, gvc[0]);
            PG8_BAR; PG8_WAIT_L(0); PG8_MMA(1, 0, At, B0); PG8_BAR; PG8_SCHED;
            PG8_STAGE(PG8_SB(0, 1), b2 + hstepB, voffB);
            PG8_WAIT_V(6); PG8_BAR; PG8_MMA(1, 1, At, B1); PG8_BAR;
            PG8_LDB(B0, 1, 0); PG8_SCHED; PG8_LDA(At, 1, 0); PG8_STAGE(PG8_SA(0, 1), PG8_AH(a2, 1), gvc[1]);
            PG8_WAIT_L(8); PG8_BAR; PG8_WAIT_L(0); PG8_MMA(0, 0, At, B0); PG8_BAR; PG8_SCHED;
            PG8_LDB(B1, 1, 1); PG8_STAGE(PG8_SB(1, 0), b3, voffB);
            PG8_BAR; PG8_WAIT_L(0); PG8_MMA(0, 1, At, B1); PG8_BAR;
            PG8_LDA(At, 1, 1); PG8_STAGE(PG8_SA(1, 0), a3, gvc[0]);
            PG8_BAR; PG8_WAIT_L(0); PG8_MMA(1, 0, At, B0); PG8_BAR; PG8_SCHED;
            PG8_STAGE(PG8_SB(1, 1), b3 + hstepB, voffB);
            PG8_WAIT_V(6); PG8_BAR; PG8_MMA(1, 1, At, B1); PG8_BAR;
            }
        }
        if constexpr (ALIGN_EPI) { if (wr == 0) PG8_BAR; }
        if constexpr (!Epi::AFTER_DRAIN) { int t2_ = (int)threadIdx.x; asm volatile("" : "+v"(t2_));
            const int l2_ = t2_ & 63; E(acc, cur, wr, wc, l2_ & 15, l2_ >> 4); S.done(cur); }
        if (!has_next) break;
        cur = nxt; cA = nA; cB = nB; ++ui;
        PG8_ACC_INIT(cur);

        if constexpr (ALIGN_EPI) { if (wr == 1) PG8_BAR; }
    }
    PG8_WAIT_V(0);
    if constexpr (!ALIGN_EPI) { if (wr == 0) PG8_BAR; }
    PG8_BAR;
    if constexpr (Epi::AFTER_DRAIN) { E.fused(acc, cur, wr, wc, fr, fq, lds, wid, lane); S.done(cur); }
#undef PG8_GLOAD
#undef PG8_ACC_INIT
#undef PG8_AH
#undef PG8_SA
#undef PG8_SB
#undef PG8_STAGE
#undef PG8_LDA
#undef PG8_LDB
#undef PG8_MMA
#undef PG8_WAIT_V
#undef PG8_WAIT_L
#undef PG8_BAR
#undef PG8_SCHED
}
}

constexpr int NB = 4, SEQ = 4096, D = 1024, T = NB * SEQ;
constexpr float ALPHA = 1.681792830507429f;
constexpr float LN_EPS = 1e-5f;
constexpr int NE = 32;
constexpr int NPAD_MAX = T * 4 + NE * 256;
constexpr float LOG2E = 1.4426950408889634f;
constexpr float FOX_C2 = 0.125f * LOG2E;

constexpr size_t KiB = 1024, MiB = 1u << 20;
constexpr size_t WS_CTL = 0, CTL_ZERO_BYTES = 320 * KiB;
constexpr size_t WS_MOD = 1 * MiB;
constexpr size_t WS_SMALL = 2 * MiB;
constexpr size_t WS_TKE = 3 * MiB, WS_TKP = 3 * MiB + 256 * KiB, WS_TKW = 3 * MiB + 512 * KiB;
constexpr size_t WS_ROWINFO = 4 * MiB, WS_ROWW = 4 * MiB + 512 * KiB;
constexpr size_t WS_BGUP = 5 * MiB;
constexpr size_t WS_DCUM = 6 * MiB;
constexpr size_t WS_SCAN = 7 * MiB;
constexpr size_t WS_ELIST = 10 * MiB, WS_EWT = 12 * MiB;
constexpr size_t WS_X = 16 * MiB;
constexpr size_t WS_H = 80 * MiB;
constexpr size_t WS_Y = 112 * MiB;
constexpr size_t WS_PROJ = 176 * MiB;
constexpr size_t WS_CORE = 304 * MiB;
constexpr size_t WS_MIX = 352 * MiB;
constexpr size_t WS_XG = 512 * MiB;
constexpr size_t WS_ACT = 656 * MiB;
constexpr size_t WS_YB = 800 * MiB;
constexpr size_t WS_WT = 1024 * MiB;
constexpr size_t WT_GLA_IN = WS_WT, WT_GLA_OUT = WT_GLA_IN + 12 * MiB, WT_RG_IN = WT_GLA_OUT + 4 * MiB, WT_RG_OUT = WT_RG_IN + 5 * MiB,
                 WT_FOX_IN = WT_RG_OUT + 3 * MiB, WT_FOX_OUT = WT_FOX_IN + 8 * MiB, WT_RG_G = WT_FOX_OUT + 2 * MiB, WT_GU = WT_RG_G + 2 * MiB, WT_DN = WT_GU + 512 * MiB, WS_END = WT_DN + 256 * MiB;
constexpr int CW_TMO = 0, CW_BAR = 4096, CW_CNT = 16384, CW_GLA = 20480;

constexpr int RING_BYTES = 131072, CTRL_OFF = 135168, LDS_BYTES = 163840;
constexpr int L_MISC = CTRL_OFF, L_TS = CTRL_OFF + 64, L_CNT = CTRL_OFF + 256, L_ULIST = CTRL_OFF + 512, L_NU = CTRL_OFF + 1024, L_VEC = CTRL_OFF + 2048, L_RLIST = CTRL_OFF + 2048 + 20480;

#define GAS __attribute__((address_space(1)))
#define LAS __attribute__((address_space(3)))
typedef unsigned short bf16;
typedef unsigned v4u __attribute__((ext_vector_type(4)));
typedef unsigned v2u __attribute__((ext_vector_type(2)));
typedef float f32x4 __attribute__((ext_vector_type(4)));
typedef float f32x2 __attribute__((ext_vector_type(2)));
typedef __bf16 bf16x2_t __attribute__((ext_vector_type(2)));
#define LDS_WAIT() asm volatile("s_waitcnt lgkmcnt(0)" ::: "memory")
#define LDS_BARRIER() asm volatile("s_waitcnt lgkmcnt(0)\n\ts_barrier" ::: "memory")
#define VM_WAIT() asm volatile("s_waitcnt vmcnt(0)" ::: "memory")
#define RLX_AGENT __ATOMIC_RELAXED, __HIP_MEMORY_SCOPE_AGENT
__device__ __forceinline__ float bf2f(bf16 v) { return __uint_as_float((unsigned)v << 16); }
__device__ __forceinline__ float bflo(unsigned w) { return __uint_as_float(w << 16); }
__device__ __forceinline__ float bfhi(unsigned w) { return __uint_as_float(w & 0xffff0000u); }
__device__ __forceinline__ unsigned pk2(float lo, float hi) { f32x2 v = {lo, hi}; bf16x2_t b = __builtin_convertvector(v, bf16x2_t); return __builtin_bit_cast(unsigned, b); }
__device__ __forceinline__ unsigned pk4_fp8(float a, float b, float c, float d) { int p = 0; p = __builtin_amdgcn_cvt_pk_fp8_f32(a, b, p, false); p = __builtin_amdgcn_cvt_pk_fp8_f32(c, d, p, true); return (unsigned)p; }
__device__ __forceinline__ bf16 f2bf(float f) { return (bf16)(pk2(f, 0.f) & 0xffffu); }
template <int CTRL> __device__ __forceinline__ float dpp_f(float v) { return __builtin_bit_cast(float, __builtin_amdgcn_update_dpp(0, __builtin_bit_cast(int, v), CTRL, 0xf, 0xf, true)); }
__device__ __forceinline__ float wave_sum(float v) {
    v += dpp_f<0xB1>(v); v += dpp_f<0x4E>(v); v += dpp_f<0x141>(v); v += dpp_f<0x140>(v);
    const float s0 = __builtin_bit_cast(float, __builtin_amdgcn_readlane(__builtin_bit_cast(int, v), 0)), s1 = __builtin_bit_cast(float, __builtin_amdgcn_readlane(__builtin_bit_cast(int, v), 16)),
                s2 = __builtin_bit_cast(float, __builtin_amdgcn_readlane(__builtin_bit_cast(int, v), 32)), s3 = __builtin_bit_cast(float, __builtin_amdgcn_readlane(__builtin_bit_cast(int, v), 48));
    return (s0 + s1) + (s2 + s3);
}
__device__ __forceinline__ float sigmoidf_(float x) { return __builtin_amdgcn_rcpf(1.0f + __expf(-x)); }
__device__ __forceinline__ float logsigmoidf_(float x) { return fminf(x, 0.f) - log1pf(__expf(-fabsf(x))); }

#define XB_TMO      128
#define XB_XCNT(j)  (256  + 64 * (j))
#define XB_XSUB(j)  (1280 + 64 * (j))
#define XB_XGEN(j)  (2304 + 64 * (j))
#define XB_TOP      3328
#define XB_TOPGEN   3392
#define XCD_BAR_WORDS 3456
#define XB_SPIN_CAP (1u << 18)

__device__ __forceinline__ unsigned xb_ld(unsigned* p)              { return __hip_atomic_load(p, __ATOMIC_RELAXED, __HIP_MEMORY_SCOPE_AGENT); }
__device__ __forceinline__ unsigned xb_add(unsigned* p, unsigned v) { return __hip_atomic_fetch_add(p, v, __ATOMIC_RELAXED, __HIP_MEMORY_SCOPE_AGENT); }
__device__ __forceinline__ unsigned xb_xcc_id() { return (unsigned)__builtin_amdgcn_s_getreg((3 << 11) | 20) & 0xFu; }
#define XB_SPIN(cond, bar) do { unsigned _sp = 0; while (cond) { __builtin_amdgcn_s_sleep(1); \
    if ((++_sp & 255u) == 0u) { if (xb_ld(&(bar)[XB_TMO])) break; if (_sp > XB_SPIN_CAP) { atomicAdd(&(bar)[XB_TMO], 1u); break; } } } } while (0)

struct XcdBarrier {
    unsigned* bar; unsigned x;
    volatile LAS unsigned* st;
};

__device__ __forceinline__ XcdBarrier xcd_barrier_post(unsigned* bar, volatile LAS unsigned* st) {
    XcdBarrier b; b.bar = bar; b.x = xb_xcc_id(); b.st = st;
    if (threadIdx.x == 0) (void)xb_add(&bar[XB_XCNT(b.x)], 1u);
    return b;
}
__device__ __forceinline__ void xcd_barrier_complete(unsigned* bar, unsigned x, unsigned& nloc, unsigned& nx) {
    const unsigned G = gridDim.x * gridDim.y * gridDim.z;
    unsigned sum, cnt, mine, sp = 0u;
    for (;;) {
        sum = 0u; cnt = 0u; mine = 0u;
#pragma unroll
        for (unsigned j = 0; j < 16; ++j) { const unsigned c = xb_ld(&bar[XB_XCNT(j)]); sum += c; cnt += (c > 0u) ? 1u : 0u; mine = (j == x) ? c : mine; }
        if (sum == G) break;
        __builtin_amdgcn_s_sleep(1);
        if ((++sp & 255u) == 0u) { if (xb_ld(&bar[XB_TMO])) break; if (sp > XB_SPIN_CAP) { atomicAdd(&bar[XB_TMO], 1u); break; } }
    }
    nloc = mine > 0u ? mine : 1u; nx = cnt > 0u ? cnt : 1u;
}

__device__ __forceinline__ void xcd_barrier(const XcdBarrier& b) {
    asm volatile("s_waitcnt vmcnt(0)" ::: "memory");
    __syncthreads();
    if (threadIdx.x == 0) {
        unsigned* bar = b.bar;
        __builtin_amdgcn_s_waitcnt(0);
        unsigned nloc = b.st[0], nx = b.st[1];
        if (nloc == 0u) { xcd_barrier_complete(bar, b.x, nloc, nx); b.st[0] = nloc; b.st[1] = nx; }
        const unsigned old = xb_add(&bar[XB_XSUB(b.x)], 1u);
        const unsigned gen = old / nloc;
        if (old + 1u == (gen + 1u) * nloc) {
            __builtin_amdgcn_fence(__ATOMIC_RELEASE, "agent");
            asm volatile("s_waitcnt vmcnt(0)" ::: "memory");
            const unsigned og = xb_add(&bar[XB_TOP], 1u);
            const unsigned tg = og / nx;
            if (og + 1u == (tg + 1u) * nx) xb_add(&bar[XB_TOPGEN], 1u);
            else XB_SPIN(xb_ld(&bar[XB_TOPGEN]) == tg, bar);
            __builtin_amdgcn_fence(__ATOMIC_ACQUIRE, "agent");
            xb_add(&bar[XB_XGEN(b.x)], 1u);
            asm volatile("s_waitcnt vmcnt(0)" ::: "memory");
        } else {
            XB_SPIN(xb_ld(&bar[XB_XGEN(b.x)]) == gen, bar);
            __builtin_amdgcn_fence(__ATOMIC_ACQUIRE, "agent");
            asm volatile("s_waitcnt vmcnt(0)" ::: "memory");
        }
    }
    __syncthreads();
}

struct Params { const float* in[31]; float* out; unsigned char* ws; int ph_lo, ph_hi, use_bar, pad; };
enum { I_X = 0, I_C, I_ADA_W, I_ADA_B, I_LN_G, I_LN_B, I_GLA_WIN, I_GLA_WGU, I_GLA_BG, I_GLA_NG, I_GLA_WOUT, I_RG_WIN, I_RG_CW, I_RG_CB, I_RG_WRG, I_RG_BRG,
       I_RG_WIG, I_RG_BIG, I_RG_LAM, I_RG_WOUT, I_FOX_WIN, I_FOX_BF, I_FOX_QG, I_FOX_KG, I_FOX_WOUT, I_MOE_WR, I_MOE_BR, I_MOE_WGU, I_MOE_BGU, I_MOE_WDN, I_MOE_BDN };

__device__ __forceinline__ const float* kin(int i) {
    const char __attribute__((address_space(4)))* ka = (const char __attribute__((address_space(4)))*)__builtin_amdgcn_kernarg_segment_ptr();
    int off = i * 8; asm volatile("" : "+s"(off));
    return *(const float* const __attribute__((address_space(4)))*)(ka + off);
}
__device__ __forceinline__ void tr_item(const float* W, int ldw, int c0, int k0, bf16* WT, int ldt, int mode, LAS float* scr, int lane) {
#pragma unroll
    for (int i4 = 0; i4 < 16; ++i4) { const int kk = 4 * i4 + (lane >> 4);
        __builtin_amdgcn_global_load_lds((const unsigned*)(W + (size_t)(k0 + kk) * ldw + c0 + 4 * ((lane & 15) ^ ((kk >> 3) & 7))), (LAS unsigned*)(scr + i4 * 256), 16, 0, 2); }
    asm volatile("s_waitcnt vmcnt(0)" ::: "memory");
    const int c8 = lane & 7;
#pragma unroll
    for (int jj = 0; jj < 8; ++jj) { const int n = (lane >> 3) + 8 * jj, c = c0 + n;
        const int drow = mode == 0 ? c : (mode == 1 ? ((c >> 8) * 256 + (c & 1) * 128 + ((c >> 1) & 127)) : (c < 3072 ? c : c - 16));
        const LAS float* src = scr + (8 * c8) * 64 + 4 * ((n >> 2) ^ c8) + (n & 3);
        float f[8];
#pragma unroll
        for (int i = 0; i < 8; ++i) f[i] = src[i * 64];
        v4u o; o.x = pk2(f[0], f[1]); o.y = pk2(f[2], f[3]); o.z = pk2(f[4], f[5]); o.w = pk2(f[6], f[7]);
        *(v4u*)(WT + (size_t)drow * ldt + k0 + 8 * c8) = o; }
    LDS_WAIT(); asm volatile("" ::: "memory");
}
__device__ __forceinline__ void tr_item8(const float* W, int ldw, int c0, int k0, unsigned char* WT8, int ldt, int mode, float sc, LAS float* scr, int lane) {
#pragma unroll
    for (int i8 = 0; i8 < 16; ++i8) { const int kk = 8 * i8 + (lane >> 3);
        __builtin_amdgcn_global_load_lds((const unsigned*)(W + (size_t)(k0 + kk) * ldw + c0 + 4 * ((lane & 7) ^ ((kk >> 4) & 7))), (LAS unsigned*)(scr + i8 * 256), 16, 0, 2); }
    asm volatile("s_waitcnt vmcnt(0)" ::: "memory");
    const int c16 = lane & 7;
#pragma unroll
    for (int jj = 0; jj < 4; ++jj) { const int n = (lane >> 3) + 8 * jj, c = c0 + n;
        const int drow = mode == 0 ? c : ((c >> 8) * 256 + (c & 1) * 128 + ((c >> 1) & 127));
        const LAS float* src = scr + (16 * c16) * 32 + 4 * ((n >> 2) ^ c16) + (n & 3);
        float f[16];
#pragma unroll
        for (int i = 0; i < 16; ++i) f[i] = src[i * 32] * sc;
        v4u o; o.x = pk4_fp8(f[0], f[1], f[2], f[3]); o.y = pk4_fp8(f[4], f[5], f[6], f[7]); o.z = pk4_fp8(f[8], f[9], f[10], f[11]); o.w = pk4_fp8(f[12], f[13], f[14], f[15]);
        *(v4u*)(WT8 + (size_t)drow * ldt + k0 + 16 * c16) = o; }
    LDS_WAIT(); asm volatile("" ::: "memory");
}
__device__ __forceinline__ void p0_adaln(const Params& P, LAS unsigned char* lds) {
    const int tid = my_tid(), lane = tid & 63, wave = __builtin_amdgcn_readfirstlane(tid >> 6), G = gridDim.x;
    unsigned char* ws = P.ws;
    { LAS float* csil = (LAS float*)lds; LAS float* red = (LAS float*)(lds + 16384);
      for (int i = tid; i < NB * D; i += 512) { const float c = kin(I_C)[i]; csil[i] = c * sigmoidf_(c); }
      __syncthreads();
      float* mod = (float*)(ws + WS_MOD);
      for (int u = blockIdx.x; u < 4 * 48; u += G) { const int l = u / 48, cg = u % 48, col = cg * 128 + 2 * lane;
          const float* w = kin(I_ADA_W) + (size_t)l * D * 6144 + col; f32x2 a0 = {0.f, 0.f}, a1 = a0, a2 = a0, a3 = a0;
#pragma unroll 16
          for (int kk = 0; kk < 128; ++kk) { const int k = wave * 128 + kk; const f32x2 wv = *(const f32x2*)(w + (size_t)k * 6144);
              a0 += wv * csil[k]; a1 += wv * csil[D + k]; a2 += wv * csil[2 * D + k]; a3 += wv * csil[3 * D + k]; }
          LAS f32x2* red2 = (LAS f32x2*)red;
          red2[(wave * 4 + 0) * 64 + lane] = a0; red2[(wave * 4 + 1) * 64 + lane] = a1; red2[(wave * 4 + 2) * 64 + lane] = a2; red2[(wave * 4 + 3) * 64 + lane] = a3;
          __syncthreads();
          { const int b = tid >> 7, c = tid & 127; float s = kin(I_ADA_B)[l * 6144 + cg * 128 + c];
#pragma unroll
              for (int w8 = 0; w8 < 8; ++w8) s += red[((w8 * 4 + b) * 64) * 2 + c];
              mod[((size_t)l * NB + b) * 6144 + cg * 128 + c] = s; }
          __syncthreads(); }
    }
}
__device__ __forceinline__ void p0_convert(const Params& P, LAS unsigned char* lds) {
    const int tid = my_tid(), lane = tid & 63, wave = __builtin_amdgcn_readfirstlane(tid >> 6), G = gridDim.x;
    unsigned char* ws = P.ws;
    { float* bp = (float*)(ws + WS_BGUP); const float* bs = kin(I_MOE_BGU);
      for (int i = blockIdx.x * 512 + tid; i < 4 * 32 * 2048; i += G * 512) { const int le = i >> 11, r = i & 2047, nt = r >> 8, half = (r >> 7) & 1, j = r & 127;
          bp[i] = bs[(size_t)le * 2048 + 2 * (nt * 128 + j) + half]; } }
    { bf16* wg = (bf16*)(ws + WT_RG_G);
      for (int i = blockIdx.x * 512 + tid; i < 2560 * 16; i += G * 512) { const int rw = i >> 4, c = i & 15; *(v4u*)(wg + (size_t)rw * 256 + 128 + c * 8) = (v4u){0u, 0u, 0u, 0u}; } }
    LAS float* scr = (LAS float*)(lds + wave * 16384);
    const int gw = blockIdx.x * 8 + wave, NGW = G * 8;
    constexpr int N_SMALL = 4288 + 80, N_GU = 128 * 512, N_DN = 128 * 256, N_ITEMS = N_SMALL + N_GU + N_DN;
    for (int it = gw; it < N_ITEMS; it += NGW) {
        int r = it;
        if (r >= N_SMALL + N_GU) { r -= N_SMALL + N_GU; const int le = r >> 8, q = r & 255, kb = q >> 5, cb = q & 31;
            tr_item8(kin(I_MOE_WDN) + (size_t)le * 1024 * 1024, 1024, cb * 32, kb * 128, ws + WT_DN + (size_t)le * 1024 * 1024, 1024, 0, 64.0f, scr, lane); continue; }
        if (r >= N_SMALL) { r -= N_SMALL; const int le = r >> 9, q = r & 511, kb = q >> 6, cb = q & 63;
            tr_item8(kin(I_MOE_WGU) + (size_t)le * 1024 * 2048, 2048, cb * 32, kb * 128, ws + WT_GU + (size_t)le * 2048 * 1024, 1024, 1, 32.0f, scr, lane); continue; }
        if (r < 1536) { const int j = r / 768, q = r % 768, kb = q / 48, cb = q % 48;
            tr_item(kin(I_GLA_WIN) + (size_t)j * 1024 * 3088, 3088, cb * 64, kb * 64, (bf16*)(ws + WT_GLA_IN) + (size_t)j * 3072 * 1024, 1024, 0, scr, lane); continue; } r -= 1536;
        if (r < 512) { const int j = r >> 8, q = r & 255, kb = q >> 5, cb = q & 31;
            tr_item8(kin(I_GLA_WOUT) + (size_t)j * 1024 * 1024, 1024, cb * 32, kb * 128, ws + WT_GLA_OUT + (size_t)j * 1024 * 1024, 1024, 0, 64.0f, scr, lane); continue; } r -= 512;
        if (r < 640) { const int kb = r / 40, cb = r % 40;
            tr_item(kin(I_RG_WIN), 2560, cb * 64, kb * 64, (bf16*)(ws + WT_RG_IN), 1024, 0, scr, lane); continue; } r -= 640;
        if (r < 320) { const int kb = r >> 5, cb = r & 31;
            tr_item8(kin(I_RG_WOUT), 1024, cb * 32, kb * 128, ws + WT_RG_OUT, 1280, 0, 64.0f, scr, lane); continue; } r -= 320;
        if (r < 1024) { const int kb = r >> 6, cb = r & 63; const int c0 = cb < 48 ? cb * 64 : 3088 + (cb - 48) * 64;
            tr_item(kin(I_FOX_WIN), 4112, c0, kb * 64, (bf16*)(ws + WT_FOX_IN), 1024, 2, scr, lane); continue; } r -= 1024;
        if (r < 256) { const int kb = r >> 5, cb = r & 31;
            tr_item8(kin(I_FOX_WOUT), 1024, cb * 32, kb * 128, ws + WT_FOX_OUT, 1024, 0, 64.0f, scr, lane); continue; } r -= 256;
        { const int blk = r >> 3, g = (r >> 2) & 1, kb = (r >> 1) & 1, cb = r & 1;
            tr_item(kin(g ? I_RG_WIG : I_RG_WRG) + (size_t)blk * 128 * 128, 128, cb * 64, kb * 64, (bf16*)(ws + WT_RG_G) + (size_t)(blk * 256 + g * 128) * 256, 256, 0, scr, lane); }
    }
}

struct TokA {
    const float* xin; int xin_bf, xout_bf; int ymode;
    const float* y; const bf16* yb;
    const float* gvec; const float* gamma; const float* beta; float* xout;
    const float* scvec; const float* shvec; bf16* hout; int h_fp8;
    const float* W; int ldw; const float* bias; float* small_out;
    int* cnt; int* tk_e; int* tk_p; float* tk_w;
};
template <int NC>
__device__ __forceinline__ void tok_phase(const TokA& A, LAS unsigned char* lds) {
    const int tid = my_tid(), lane = tid & 63, wave = __builtin_amdgcn_readfirstlane(tid >> 6), G = gridDim.x;
    const int rows_wg = T / G, b = (blockIdx.x * rows_wg) / SEQ;
    const int rpw = rows_wg / 8;
    v4u nx[4]; v2u ny[4]; unsigned nyb[4][4];
#define TOK_LOAD(row_) do { \
        if (A.xin_bf) { _Pragma("unroll") for (int j = 0; j < 4; ++j) { const v2u w_ = ((const v2u*)((const bf16*)A.xin + (row_) * D))[64 * j + lane]; nx[j] = (v4u){w_.x, w_.y, 0u, 0u}; } } \
        else { _Pragma("unroll") for (int j = 0; j < 4; ++j) nx[j] = ((const v4u*)(A.xin + (row_) * D))[64 * j + lane]; } \
        if (A.ymode == 1) { _Pragma("unroll") for (int j = 0; j < 4; ++j) ny[j] = ((const v2u*)((const bf16*)A.y + (row_) * D))[64 * j + lane]; } \
        else if (A.ymode == 2) { _Pragma("unroll") for (int j = 0; j < 4; ++j) _Pragma("unroll") for (int k = 0; k < 4; ++k) nyb[j][k] = ((const unsigned*)((const unsigned char*)A.yb + ((row_) * 4 + k) * D))[64 * j + lane]; } } while (0)
    { const size_t r0 = (size_t)blockIdx.x * rows_wg + wave * rpw; TOK_LOAD(r0); }
    LAS float* wl = (LAS float*)lds;
    if constexpr (NC > 0) {
        constexpr int CH = NC / 4;
#pragma unroll 8
        for (int idx = tid; idx < 1024 * CH; idx += 512) { const int k = idx / CH, c = idx % CH; const f32x4 v = *(const f32x4*)(A.W + (size_t)k * A.ldw + 4 * c);
            const int s = (((k >> 8) * 4 + (k & 3)) * 64) + ((k >> 2) & 63);
            *(LAS f32x4*)(wl + (c * 1024 + s) * 4) = v; }
    }
    LAS f32x4* vec = (LAS f32x4*)(lds + L_VEC);
    if constexpr (NC == 32) { if (tid < 32) ((LAS unsigned*)(lds + L_CNT))[tid] = 0u; }
    if (tid < 256) {
        if (A.ymode) { vec[tid] = ((const f32x4*)(A.gvec + (size_t)b * 6144))[tid] + 1.0f; vec[256 + tid] = ((const f32x4*)A.gamma)[tid]; vec[512 + tid] = ((const f32x4*)A.beta)[tid]; }
        if (A.hout) { vec[768 + tid] = ((const f32x4*)(A.scvec + (size_t)b * 6144))[tid] + 1.0f; vec[1024 + tid] = ((const f32x4*)(A.shvec + (size_t)b * 6144))[tid]; } }
    __syncthreads();
    if (wave >= 4) __builtin_amdgcn_s_setprio(1);
#pragma unroll 2
    for (int ir = 0; ir < rpw; ++ir) {
        const size_t row = (size_t)blockIdx.x * rows_wg + wave * rpw + ir;
        asm volatile("" ::: "memory");
        float hv[16];
        {
            f32x4 v[4];
#pragma unroll
            for (int j = 0; j < 4; ++j) { if (A.xin_bf) v[j] = (f32x4){bflo(nx[j].x), bfhi(nx[j].x), bflo(nx[j].y), bfhi(nx[j].y)}; else v[j] = __builtin_bit_cast(f32x4, nx[j]); }
            f32x4 yv[4];
            if (A.ymode == 1) {
#pragma unroll
                for (int j = 0; j < 4; ++j) yv[j] = (f32x4){bflo(ny[j].x), bfhi(ny[j].x), bflo(ny[j].y), bfhi(ny[j].y)};
            } else if (A.ymode == 2) {
#pragma unroll
                for (int j = 0; j < 4; ++j) { f32x4 s = {0.f, 0.f, 0.f, 0.f};
#pragma unroll
                    for (int k = 0; k < 4; ++k) { const int w = (int)nyb[j][k]; const f32x2 lo = __builtin_amdgcn_cvt_pk_f32_fp8(w, false), hi = __builtin_amdgcn_cvt_pk_f32_fp8(w, true); s += (f32x4){lo.x, lo.y, hi.x, hi.y}; }
                    yv[j] = s * 0.0625f; }
            }
            if (ir + 1 < rpw) { const size_t rn = row + 1; TOK_LOAD(rn); }
            if (A.ymode) {
                float s = 0.f;
#pragma unroll
                for (int j = 0; j < 4; ++j) { v[j] = v[j] * ALPHA + vec[64 * j + lane] * yv[j]; s += (v[j].x + v[j].y) + (v[j].z + v[j].w); }
                const float mean = wave_sum(s) * (1.0f / D); float s2 = 0.f;
#pragma unroll
                for (int j = 0; j < 4; ++j) { v[j] = v[j] - mean; s2 += (v[j].x * v[j].x + v[j].y * v[j].y) + (v[j].z * v[j].z + v[j].w * v[j].w); }
                const float rstd = 1.0f / sqrtf(wave_sum(s2) * (1.0f / D) + LN_EPS);
#pragma unroll
                for (int j = 0; j < 4; ++j) { v[j] = v[j] * rstd * vec[256 + 64 * j + lane] + vec[512 + 64 * j + lane];
                    if (A.xout_bf) { v2u w; w.x = pk2(v[j].x, v[j].y); w.y = pk2(v[j].z, v[j].w); ((v2u*)((bf16*)A.xout + row * D))[64 * j + lane] = w; } else ((f32x4*)(A.xout + row * D))[64 * j + lane] = v[j]; }
            }
            if (A.hout) {
#pragma unroll
                for (int j = 0; j < 4; ++j) { const f32x4 h = v[j] * vec[768 + 64 * j + lane] + vec[1024 + 64 * j + lane]; hv[4 * j + 0] = h.x; hv[4 * j + 1] = h.y; hv[4 * j + 2] = h.z; hv[4 * j + 3] = h.w;
                    if (A.h_fp8) ((unsigned*)((unsigned char*)A.hout + row * D))[64 * j + lane] = pk4_fp8(h.x, h.y, h.z, h.w);
                    else { v2u w; w.x = pk2(h.x, h.y); w.y = pk2(h.z, h.w); ((v2u*)(A.hout + row * D))[64 * j + lane] = w; } }
            }
        }
        asm volatile("" ::: "memory");
        if constexpr (NC > 0) {
            constexpr int CH = NC / 4, LOGN = (NC == 32) ? 5 : 4;
            float acc[NC]; const LAS float* wlane = wl + lane * 4;
#pragma unroll
            for (int q = 0; q < NC; ++q) acc[q] = 0.f;
#pragma unroll
            for (int e = 0; e < 16; ++e) {
                if ((e & 1) == 0) asm volatile("" ::: "memory");
#pragma unroll
                for (int c = 0; c < CH; ++c) { const f32x4 wv = *(const LAS f32x4*)(wlane + (c * 1024 + e * 64) * 4);
#pragma unroll
                    for (int q = 0; q < 4; ++q) acc[4 * c + q] += hv[e] * wv[q]; } }
#pragma unroll
            for (int i = 0; i < NC / 2; ++i) { const auto rr = __builtin_amdgcn_permlane32_swap(__float_as_uint(acc[i]), __float_as_uint(acc[i + NC / 2]), false, false); acc[i] = __uint_as_float(rr[0]) + __uint_as_float(rr[1]); }
            { const bool up = (lane & 16) != 0;
#pragma unroll
              for (int i = 0; i < NC / 4; ++i) { const float keep = up ? acc[i + NC / 4] : acc[i], send = up ? acc[i] : acc[i + NC / 4]; acc[i] = keep + __shfl_xor(send, 16); } }
            { const bool up = (lane & 8) != 0;
#pragma unroll
              for (int i = 0; i < NC / 8; ++i) { const float keep = up ? acc[i + NC / 8] : acc[i], send = up ? acc[i] : acc[i + NC / 8]; acc[i] = keep + dpp_f<0x128>(send); } }
            { const bool up = (lane & 4) != 0;
#pragma unroll
              for (int i = 0; i < NC / 16; ++i) { const float keep = up ? acc[i + NC / 16] : acc[i], send = up ? acc[i] : acc[i + NC / 16]; acc[i] = keep + dpp_f<0x141>(send); } }
            float val;
            if constexpr (NC == 16) { val = acc[0]; val += dpp_f<0x4E>(val); val += dpp_f<0xB1>(val);
                const int col = ((lane >> 5) & 1) * 8 + ((lane >> 4) & 1) * 4 + ((lane >> 3) & 1) * 2 + ((lane >> 2) & 1);
                if ((lane & 3) == 0) A.small_out[row * 16 + col] = val;
            } else { { const bool up = (lane & 2) != 0; const float keep = up ? acc[1] : acc[0], send = up ? acc[0] : acc[1]; val = keep + dpp_f<0x4E>(send); }
                val += dpp_f<0xB1>(val);
                const int col = ((lane >> 5) & 1) * 16 + ((lane >> 4) & 1) * 8 + ((lane >> 3) & 1) * 4 + ((lane >> 2) & 1) * 2 + ((lane >> 1) & 1);
                val += A.bias[col];
                LAS float* lg = (LAS float*)(lds + L_RLIST + 2048) + wave * 48;
                if ((lane & 1) == 0) lg[col] = val;
                f32x4 o[8];
#pragma unroll
                for (int c4 = 0; c4 < 8; ++c4) o[c4] = *(const LAS f32x4*)(lg + 4 * c4);
                int gt = 0, ge = 0;
#pragma unroll
                for (int c4 = 0; c4 < 8; ++c4)
#pragma unroll
                    for (int q = 0; q < 4; ++q) { gt += (o[c4][q] > val) ? 1 : 0; ge += (o[c4][q] >= val) ? 1 : 0; }
                int rank = gt;
                if (__builtin_amdgcn_ballot_w64(ge - gt != 1) != 0ull) {
                    int colx = col; asm volatile("" : "+v"(colx));
                    rank = 0;
#pragma unroll
                    for (int c4 = 0; c4 < 8; ++c4)
#pragma unroll
                        for (int q = 0; q < 4; ++q) rank += ((o[c4][q] > val) | ((o[c4][q] == val) & ((4 * c4 + q) < colx))) ? 1 : 0; }
                if (rank < 4 && (lane & 1) == 0) { lg[32 + rank] = val; ((LAS int*)lg)[36 + rank] = col; }
                if (lane < 4) { const f32x4 tv = *(const LAS f32x4*)(lg + 32); const int ek = ((const LAS int*)lg)[36 + lane];
                    const float e1 = __expf(tv[1] - tv[0]), e2 = __expf(tv[2] - tv[0]), e3 = __expf(tv[3] - tv[0]); const float inv = 1.0f / (1.0f + e1 + e2 + e3);
                    const float wk = (lane == 0 ? 1.0f : lane == 1 ? e1 : lane == 2 ? e2 : e3) * inv;
                    const unsigned lp = __hip_atomic_fetch_add((LAS unsigned*)(lds + L_CNT) + ek, 1u, __ATOMIC_RELAXED, __HIP_MEMORY_SCOPE_WORKGROUP);
                    const int li = (wave * rpw + ir) * 4 + lane; LAS unsigned* rl = (LAS unsigned*)(lds + L_RLIST);
                    rl[li] = (unsigned)ek | (lp << 8); rl[256 + li] = __float_as_uint(wk); }
            }
        }
    }
    __builtin_amdgcn_s_setprio(0);
    if constexpr (NC == 32) {
        __syncthreads();
        LAS unsigned* hist = (LAS unsigned*)(lds + L_CNT); LAS unsigned* gb = (LAS unsigned*)(lds + L_TS); LAS unsigned* rl = (LAS unsigned*)(lds + L_RLIST);
        if (tid < 32) gb[tid] = __hip_atomic_fetch_add((unsigned*)A.cnt + tid, hist[tid], RLX_AGENT);
        __syncthreads();
        if (tid < rows_wg * 4) { const unsigned v = rl[tid]; const int ek = (int)(v & 0xffu); const size_t gi = (size_t)blockIdx.x * rows_wg * 4 + tid;
            const size_t q = (size_t)ek * T + (gb[ek] + (v >> 8)); A.tk_e[q] = (int)gi; A.tk_w[q] = __uint_as_float(rl[256 + tid]); }
        __syncthreads();
    }
}

typedef float f32x16 __attribute__((ext_vector_type(16)));
typedef short s16x8 __attribute__((ext_vector_type(8)));
typedef short s16x4 __attribute__((ext_vector_type(4)));
constexpr size_t GLA_QD = 0, GLA_KI = 16 * MiB, GLA_KE = 32 * MiB, GLA_DEC = 48 * MiB, GLA_DSEG = 49 * MiB, GLA_SLOC = 50 * MiB;
constexpr int GP = 272, GPV = 528;
__device__ __forceinline__ int crow16(int i, int h) { return (i & 3) + 8 * (i >> 2) + 4 * h; }
__device__ __forceinline__ s16x4 vtr4(const LAS unsigned char* p) { return __builtin_bit_cast(s16x4, __builtin_amdgcn_ds_read_tr16_b64_v4i16((LAS s16x4*)p)); }
__device__ __forceinline__ s16x8 tr_frag(const LAS unsigned char* img, int pitch, int row_lo, int row_hi, int col0, int lane) {
    const int i16 = lane & 15, q = i16 >> 2, p = i16 & 3, blk = (lane >> 4) & 1; const int cb = (col0 + 16 * blk + 4 * p) * 2;
    const s16x4 lo = vtr4(img + (row_lo + q) * pitch + cb), hi = vtr4(img + (row_hi + q) * pitch + cb);
    return (s16x8){lo[0], lo[1], lo[2], lo[3], hi[0], hi[1], hi[2], hi[3]};
}
__device__ __forceinline__ s16x8 tr_frag_b(const LAS unsigned char* base, int off_lo, int off_hi) {
    const s16x4 lo = vtr4(base + off_lo), hi = vtr4(base + off_hi);
    return (s16x8){lo[0], lo[1], lo[2], lo[3], hi[0], hi[1], hi[2], hi[3]};
}
__device__ __forceinline__ s16x8 pack8(const f32x16& x, int s) {
    v4u p; p.x = pk2(x[8 * s], x[8 * s + 1]); p.y = pk2(x[8 * s + 2], x[8 * s + 3]); p.z = pk2(x[8 * s + 4], x[8 * s + 5]); p.w = pk2(x[8 * s + 6], x[8 * s + 7]);
    return __builtin_bit_cast(s16x8, p);
}
#define MFMA32(a, b, c) __builtin_amdgcn_mfma_f32_32x32x16_bf16((a), (b), (c), 0, 0, 0)
__device__ __forceinline__ void gla_state_update(f32x16 (&S)[4], const LAS unsigned char* keL, const LAS unsigned char* vL, const LAS float* decL, int wave, int lane) {
    const int h = lane >> 5;
    const int i16_ = lane & 15, q_ = i16_ >> 2, p_ = i16_ & 3, blk_ = (lane >> 4) & 1;
    const LAS unsigned char* kb = keL + (q_ + 8 * h) * GP + (16 * blk_ + 4 * p_) * 2;
    const LAS unsigned char* vb = vL + (q_ + 8 * h) * GPV + (32 * wave + 16 * blk_ + 4 * p_) * 2;
#pragma unroll
    for (int dt = 0; dt < 4; ++dt)
#pragma unroll
        for (int g4 = 0; g4 < 4; ++g4) { const f32x4 dv = *(const LAS f32x4*)(decL + 32 * dt + 8 * g4 + 4 * h);
#pragma unroll
            for (int q = 0; q < 4; ++q) S[dt][4 * g4 + q] *= dv[q]; }
    s16x8 bv[2], ak[2][4];
#pragma unroll
    for (int s = 0; s < 2; ++s) { bv[s] = tr_frag_b(vb, 16 * s * GPV, (16 * s + 4) * GPV);
#pragma unroll
        for (int dt = 0; dt < 4; ++dt) ak[s][dt] = tr_frag_b(kb, 16 * s * GP + 64 * dt, (16 * s + 4) * GP + 64 * dt); }
#pragma unroll
    for (int s = 0; s < 2; ++s)
#pragma unroll
        for (int dt = 0; dt < 4; ++dt) S[dt] = MFMA32(ak[s][dt], bv[s], S[dt]);
}
__device__ __forceinline__ void gla_g1(const Params& P, LAS unsigned char* lds, int j) {
    const int tid = my_tid(), lane = tid & 63, wave = __builtin_amdgcn_readfirstlane(tid >> 6), G = gridDim.x;
    const bf16* proj = (const bf16*)(P.ws + WS_PROJ); const float* glr = (const float*)(P.ws + WS_SMALL);
    bf16* qdG = (bf16*)(P.ws + WS_MIX + GLA_QD); bf16* kiG = (bf16*)(P.ws + WS_MIX + GLA_KI); bf16* keG = (bf16*)(P.ws + WS_MIX + GLA_KE);
    float* decG = (float*)(P.ws + WS_MIX + GLA_DEC); float* dsegG = (float*)(P.ws + WS_MIX + GLA_DSEG); float* slocG = (float*)(P.ws + WS_MIX + GLA_SLOC);
    const float* wgu = kin(I_GLA_WGU) + (size_t)j * 16 * 512; const float* bg = kin(I_GLA_BG) + (size_t)j * 512;
    LAS float* glrL = (LAS float*)lds;
    LAS float* decL = (LAS float*)(lds + 16384);
    LAS float* blL = (LAS float*)(lds + 16384 + 4096);
    LAS unsigned char* keL = lds + 24576;
    LAS unsigned char* vL = lds + 24576 + 4 * 32 * GP;
    for (int u = blockIdx.x; u < 256; u += G) {
        const int bh = u >> 4, seg = u & 15, b = bh >> 2, hh = bh & 3; const size_t rowS = (size_t)b * SEQ + seg * 256;
        for (int i = tid; i < 1024; i += 512) ((LAS f32x4*)glrL)[i] = ((const f32x4*)(glr + rowS * 16))[i];
        f32x16 S[4];
#pragma unroll
        for (int dt = 0; dt < 4; ++dt)
#pragma unroll
            for (int i = 0; i < 16; ++i) S[dt][i] = 0.f;
        const int d = tid & 127, g = tid >> 7;
        float w[16];
#pragma unroll
        for (int r = 0; r < 16; ++r) w[r] = wgu[r * 512 + hh * 128 + d];
        const float bias = bg[hh * 128 + d];
        __syncthreads();
        for (int rd = 0; rd < 2; ++rd) {
            const int c = rd * 4 + g; const size_t row0 = rowS + c * 32;
            for (int i = tid; i < 4 * 32 * 32; i += 512) { const int cc = i >> 10, t = (i >> 5) & 31, c16 = i & 31;
                *(LAS v4u*)(vL + (cc * 32 + t) * GPV + c16 * 16) = *(const v4u*)(proj + (rowS + (rd * 4 + cc) * 32 + t) * 3072 + 1024 + hh * 256 + c16 * 8); }
            float la[32]; float tot = 0.f;
#pragma unroll
            for (int t = 0; t < 32; ++t) { float lg = bias;
#pragma unroll
                for (int r4 = 0; r4 < 4; ++r4) { const f32x4 gv = *(const LAS f32x4*)(glrL + (c * 32 + t) * 16 + 4 * r4); lg += gv.x * w[4 * r4] + gv.y * w[4 * r4 + 1] + gv.z * w[4 * r4 + 2] + gv.w * w[4 * r4 + 3]; }
                la[t] = (fminf(lg, 0.f) - __logf(1.0f + __expf(-fabsf(lg)))) * (1.0f / 16.0f); tot += la[t]; }
            float cum = 0.f; const float dc0 = __expf(tot);
#pragma unroll
            for (int t = 0; t < 32; ++t) { cum += la[t]; const size_t row = row0 + t;
                const float qv = bf2f(proj[row * 3072 + hh * 128 + d]) * 0.08838834764831845f, kv = bf2f(proj[row * 3072 + 512 + hh * 128 + d]);
                const float ec = __expf(cum), en = __builtin_amdgcn_rcpf(ec), ee = dc0 * en;
                const bf16 kev = f2bf(kv * ee);
                qdG[row * 512 + hh * 128 + d] = f2bf(qv * ec); kiG[row * 512 + hh * 128 + d] = f2bf(kv * en); keG[row * 512 + hh * 128 + d] = kev;
                *(LAS bf16*)(keL + (g * 32 + t) * GP + d * 2) = kev; }
            const float dc = dc0;
            decL[c * 128 + d] = dc; blL[c * 128 + d] = tot; decG[((size_t)(bh * 128 + seg * 8 + c)) * 128 + d] = dc;
            LDS_BARRIER();
#pragma unroll 1
            for (int cc = 0; cc < 4; ++cc) gla_state_update(S, keL + cc * 32 * GP, vL + cc * 32 * GPV, decL + (rd * 4 + cc) * 128, wave, lane);
            LDS_BARRIER();
        }
        if (tid < 128) { float s = 0.f;
#pragma unroll
            for (int c = 0; c < 8; ++c) s += blL[c * 128 + tid];
            __hip_atomic_store(dsegG + (size_t)u * 128 + tid, __expf(s), RLX_AGENT); }
        { const int h = lane >> 5, r = lane & 31; float* sp = slocG + (size_t)u * 128 * 256;
#pragma unroll
          for (int dt = 0; dt < 4; ++dt)
#pragma unroll
              for (int i = 0; i < 16; ++i) __hip_atomic_store(sp + (size_t)(32 * dt + crow16(i, h)) * 256 + 32 * wave + r, S[dt][i], RLX_AGENT); }
        unsigned* cntw = (unsigned*)(P.ws + WS_CTL) + CW_GLA + (j * 16 + bh) * 64;
        asm volatile("s_waitcnt vmcnt(0)" ::: "memory");
        if (lane == 0) __hip_atomic_fetch_add(cntw, 1u, RLX_AGENT);
        if (wave == 0) { unsigned sp_ = 0;
            while ((unsigned)__builtin_amdgcn_readfirstlane((int)__hip_atomic_load(cntw, RLX_AGENT)) < 128u) { __builtin_amdgcn_s_sleep(2); if (++sp_ > (1u << 22)) break; }
            __builtin_amdgcn_fence(__ATOMIC_ACQUIRE, "agent"); asm volatile("s_waitcnt vmcnt(0)" ::: "memory"); }
        __syncthreads();
        { const int dd = seg * 8 + (tid >> 6), e4 = tid & 63; f32x4 run = {0.f, 0.f, 0.f, 0.f};
#pragma unroll 4
          for (int sg = 0; sg < 16; ++sg) { f32x4* p = (f32x4*)(slocG + ((size_t)(bh * 16 + sg) * 128 + dd) * 256) + e4; const f32x4 loc = *p; *p = run;
              run = run * dsegG[(size_t)(bh * 16 + sg) * 128 + dd] + loc; } }
        __syncthreads();
    }
}
__device__ __forceinline__ void gla_g3(const Params& P, LAS unsigned char* lds, int j) {
    const int tid = my_tid(), lane = tid & 63, wave = __builtin_amdgcn_readfirstlane(tid >> 6), G = gridDim.x;
    const int h = lane >> 5, r = lane & 31;
    const bf16* proj = (const bf16*)(P.ws + WS_PROJ); bf16* core = (bf16*)(P.ws + WS_CORE);
    const bf16* qdG = (const bf16*)(P.ws + WS_MIX + GLA_QD); const bf16* kiG = (const bf16*)(P.ws + WS_MIX + GLA_KI); const bf16* keG = (const bf16*)(P.ws + WS_MIX + GLA_KE);
    const float* decG = (const float*)(P.ws + WS_MIX + GLA_DEC); const float* slocG = (const float*)(P.ws + WS_MIX + GLA_SLOC);
    const float* ng = kin(I_GLA_NG) + (size_t)j * 1024;
    LAS unsigned char* qdL = lds; LAS unsigned char* kiL = lds + 32 * GP; LAS unsigned char* keL = lds + 64 * GP; LAS unsigned char* vL = lds + 96 * GP;
    LAS float* decL = (LAS float*)(lds + 96 * GP + 32 * GPV);
    LAS float* ssqL = decL + 128;
    LAS unsigned char* oL = (LAS unsigned char*)(ssqL + 256);
    const LAS unsigned char* vkb = vL + (((lane & 15) >> 2) + 4 * h) * GPV + (32 * wave + 16 * ((lane >> 4) & 1) + 4 * (lane & 3)) * 2;
    for (int u = blockIdx.x; u < 256; u += G) {
        const int bh = u >> 4, seg = u & 15, b = bh >> 2, hh = bh & 3; const size_t rowS = (size_t)b * SEQ + seg * 256;
        f32x16 S[4];
        { const float* sp = slocG + (size_t)u * 128 * 256;
#pragma unroll
          for (int dt = 0; dt < 4; ++dt)
#pragma unroll
              for (int i = 0; i < 16; ++i) S[dt][i] = sp[(size_t)(32 * dt + crow16(i, h)) * 256 + 32 * wave + r]; }
        v4u pq, pk, pe, pv[2], prg[2]; float pd = 0.f;
#define G3_LOAD(c_) do { const size_t r0_ = rowS + (c_) * 32; const int t_ = tid >> 4, c16_ = tid & 15; const size_t go_ = (r0_ + t_) * 512 + hh * 128 + c16_ * 8; \
            pq = *(const v4u*)(qdG + go_); pk = *(const v4u*)(kiG + go_); pe = *(const v4u*)(keG + go_); \
            _Pragma("unroll") for (int k2 = 0; k2 < 2; ++k2) { const int i_ = tid + 512 * k2, tv_ = i_ >> 5, cv_ = i_ & 31; \
                pv[k2] = *(const v4u*)(proj + (r0_ + tv_) * 3072 + 1024 + hh * 256 + cv_ * 8); prg[k2] = *(const v4u*)(proj + (r0_ + tv_) * 3072 + 2048 + hh * 256 + cv_ * 8); } \
            if (tid < 128) pd = decG[((size_t)(bh * 128 + seg * 8 + (c_))) * 128 + tid]; } while (0)
        G3_LOAD(0);
        if (wave >= 4) __builtin_amdgcn_s_setprio(1);
#pragma unroll 1
        for (int c = 0; c < 8; ++c) {
            const size_t row0 = rowS + c * 32;
            { const int t = tid >> 4, c16 = tid & 15;
              *(LAS v4u*)(qdL + t * GP + c16 * 16) = pq; *(LAS v4u*)(kiL + t * GP + c16 * 16) = pk; *(LAS v4u*)(keL + t * GP + c16 * 16) = pe;
#pragma unroll
              for (int k2 = 0; k2 < 2; ++k2) { const int i = tid + 512 * k2, tv = i >> 5, cv = i & 31; *(LAS v4u*)(vL + tv * GPV + cv * 16) = pv[k2]; }
              if (tid < 128) decL[tid] = pd; }
            const v4u rg0 = prg[0], rg1 = prg[1];
            LDS_BARRIER();
            if (c + 1 < 8) G3_LOAD(c + 1);
            f32x16 pt, pt2;
#pragma unroll
            for (int i = 0; i < 16; ++i) { pt[i] = 0.f; pt2[i] = 0.f; }
#pragma unroll
            for (int hb = 0; hb < 2; ++hb) { s16x8 fa[4], fb[4];
#pragma unroll
                for (int q4 = 0; q4 < 4; ++q4) { const int s8 = 4 * hb + q4; fa[q4] = *(const LAS s16x8*)(kiL + r * GP + (16 * s8 + 8 * h) * 2); fb[q4] = *(const LAS s16x8*)(qdL + r * GP + (16 * s8 + 8 * h) * 2); }
                pt = MFMA32(fa[0], fb[0], pt); pt2 = MFMA32(fa[1], fb[1], pt2); pt = MFMA32(fa[2], fb[2], pt); pt2 = MFMA32(fa[3], fb[3], pt2);
                asm volatile("" ::: "memory"); }
            pt = pt + pt2;
#pragma unroll
            for (int i = 0; i < 16; ++i) if (crow16(i, h) > r) pt[i] = 0.f;
            f32x16 o, o2;
#pragma unroll
            for (int i = 0; i < 16; ++i) { o[i] = 0.f; o2[i] = 0.f; }
            { s16x8 av[2], bq[4][2];
#pragma unroll
              for (int s = 0; s < 2; ++s) av[s] = tr_frag_b(vkb, 16 * s * GPV, (16 * s + 8) * GPV);
#pragma unroll
              for (int dt = 0; dt < 4; ++dt)
#pragma unroll
                  for (int s = 0; s < 2; ++s) { const s16x4 lo = *(const LAS s16x4*)(qdL + r * GP + (32 * dt + 16 * s + 4 * h) * 2), hi = *(const LAS s16x4*)(qdL + r * GP + (32 * dt + 16 * s + 8 + 4 * h) * 2);
                      bq[dt][s] = (s16x8){lo[0], lo[1], lo[2], lo[3], hi[0], hi[1], hi[2], hi[3]}; }
              o = MFMA32(av[0], pack8(pt, 0), o); o2 = MFMA32(av[1], pack8(pt, 1), o2);
#pragma unroll
              for (int dt = 0; dt < 4; ++dt) { o = MFMA32(pack8(S[dt], 0), bq[dt][0], o); o2 = MFMA32(pack8(S[dt], 1), bq[dt][1], o2); }
              o = o + o2; }
            gla_state_update(S, keL, vL, decL, wave, lane);
            float ss = 0.f;
#pragma unroll
            for (int i = 0; i < 16; ++i) ss += o[i] * o[i];
            { const auto rr = __builtin_amdgcn_permlane32_swap(__float_as_uint(ss), __float_as_uint(ss), false, false); ss = __uint_as_float(rr[0]) + __uint_as_float(rr[1]); }
            if (h == 0) ssqL[wave * 32 + r] = ss;
            LDS_BARRIER();
            float tot = 0.f;
#pragma unroll
            for (int w8 = 0; w8 < 8; ++w8) tot += ssqL[w8 * 32 + r];
            const float rs = __builtin_amdgcn_rsqf(tot * (1.0f / 256.0f) + LN_EPS);
#pragma unroll
            for (int i = 0; i < 16; ++i) *(LAS bf16*)(oL + r * GPV + (32 * wave + crow16(i, h)) * 2) = f2bf(o[i] * rs);
            LDS_BARRIER();
#pragma unroll
            for (int k2 = 0; k2 < 2; ++k2) { const int i = tid + 512 * k2, t = i >> 5, c8 = i & 31; const size_t row = row0 + t;
                const v4u ov = *(const LAS v4u*)(oL + t * GPV + c8 * 16); const v4u rv = k2 ? rg1 : rg0;
                const f32x4 g0 = *(const f32x4*)(ng + hh * 256 + c8 * 8), g1 = *(const f32x4*)(ng + hh * 256 + c8 * 8 + 4);
                const unsigned ow[4] = {ov.x, ov.y, ov.z, ov.w}, rw[4] = {rv.x, rv.y, rv.z, rv.w}; const float gg[8] = {g0.x, g0.y, g0.z, g0.w, g1.x, g1.y, g1.z, g1.w};
                float rf[8];
#pragma unroll
                for (int q = 0; q < 4; ++q) { const float r0 = bflo(rw[q]), r1 = bfhi(rw[q]); rf[2 * q] = bflo(ow[q]) * gg[2 * q] * (r0 * sigmoidf_(r0)); rf[2 * q + 1] = bfhi(ow[q]) * gg[2 * q + 1] * (r1 * sigmoidf_(r1)); }
                *(v2u*)((unsigned char*)core + row * 1024 + hh * 256 + c8 * 8) = (v2u){pk4_fp8(rf[0], rf[1], rf[2], rf[3]), pk4_fp8(rf[4], rf[5], rf[6], rf[7])}; }
            LDS_BARRIER();
        }
        __builtin_amdgcn_s_setprio(0);
    }
}

__device__ __forceinline__ void rg_conv(const Params& P) {
    const int tid = my_tid(), G = gridDim.x;
    const bf16* proj = (const bf16*)(P.ws + WS_PROJ); bf16* xc = (bf16*)(P.ws + WS_Y);
    const float* cw = kin(I_RG_CW); const float* cb = kin(I_RG_CB);
    for (int i = blockIdx.x * 512 + tid; i < (T + 1) * 160; i += G * 512) { const int row = i / 160, c8 = (i % 160) * 8;
        v4u o = {0u, 0u, 0u, 0u};
        if (row < T) { const int t = row % SEQ; float acc[8];
            { const f32x4 b0 = *(const f32x4*)(cb + c8), b1 = *(const f32x4*)(cb + c8 + 4); acc[0] = b0.x; acc[1] = b0.y; acc[2] = b0.z; acc[3] = b0.w; acc[4] = b1.x; acc[5] = b1.y; acc[6] = b1.z; acc[7] = b1.w; }
#pragma unroll
            for (int jx = 0; jx < 4; ++jx) if (t - 3 + jx >= 0) { const v4u xv = *(const v4u*)(proj + (size_t)(row - 3 + jx) * 2560 + 1280 + c8);
                const f32x4 w0 = *(const f32x4*)(cw + jx * 1280 + c8), w1 = *(const f32x4*)(cw + jx * 1280 + c8 + 4);
                acc[0] += w0.x * bflo(xv.x); acc[1] += w0.y * bfhi(xv.x); acc[2] += w0.z * bflo(xv.y); acc[3] += w0.w * bfhi(xv.y);
                acc[4] += w1.x * bflo(xv.z); acc[5] += w1.y * bfhi(xv.z); acc[6] += w1.z * bflo(xv.w); acc[7] += w1.w * bfhi(xv.w); }
            o.x = pk2(acc[0], acc[1]); o.y = pk2(acc[2], acc[3]); o.z = pk2(acc[4], acc[5]); o.w = pk2(acc[6], acc[7]); }
        *(v4u*)(xc + (size_t)row * 1280 + c8) = o; }
}
constexpr int RG_SEG = 128, RG_NSEG = SEQ / RG_SEG;
__device__ __forceinline__ void rg_scan1(const Params& P) {
    const unsigned* AU = (const unsigned*)(P.ws + WS_MIX); float* cP = (float*)(P.ws + WS_SCAN); float* cH = cP + NB * RG_NSEG * 1280;
    for (int idx = blockIdx.x * 512 + threadIdx.x; idx < NB * RG_NSEG * 640; idx += gridDim.x * 512) { const int cp = idx % 640, bs = idx / 640; const size_t row0 = (size_t)bs * RG_SEG;
        float ls0 = 0.f, h0 = 0.f, ls1 = 0.f, h1 = 0.f;
#pragma unroll 16
        for (int t = 0; t < RG_SEG; ++t) { const v2u w = *(const v2u*)(AU + (row0 + t) * 1280 + 2 * cp); const float la0 = bflo(w.x), la1 = bflo(w.y);
            h0 = __expf(la0) * h0 + bfhi(w.x); ls0 += la0; h1 = __expf(la1) * h1 + bfhi(w.y); ls1 += la1; }
        *(f32x2*)(cP + (size_t)bs * 1280 + 2 * cp) = (f32x2){__expf(ls0), __expf(ls1)}; *(f32x2*)(cH + (size_t)bs * 1280 + 2 * cp) = (f32x2){h0, h1}; }
}
__device__ __forceinline__ void rg_scan2(const Params& P) {
    const unsigned* AU = (const unsigned*)(P.ws + WS_MIX); const float* cP = (const float*)(P.ws + WS_SCAN); const float* cH = cP + NB * RG_NSEG * 1280;
    const bf16* proj = (const bf16*)(P.ws + WS_PROJ); bf16* core = (bf16*)(P.ws + WS_CORE);
    for (int idx = blockIdx.x * 512 + threadIdx.x; idx < NB * RG_NSEG * 640; idx += gridDim.x * 512) { const int cp = idx % 640, bs = idx / 640, b = bs / RG_NSEG, sg = bs % RG_NSEG; const size_t row0 = (size_t)bs * RG_SEG;
        float h0 = 0.f, h1 = 0.f;
#pragma unroll 8
        for (int s2 = 0; s2 < sg; ++s2) { const size_t q = (size_t)(b * RG_NSEG + s2) * 1280 + 2 * cp; const f32x2 p2 = *(const f32x2*)(cP + q), c2 = *(const f32x2*)(cH + q); h0 = p2.x * h0 + c2.x; h1 = p2.y * h1 + c2.y; }
#pragma unroll 16
        for (int t = 0; t < RG_SEG; ++t) { const v2u w = *(const v2u*)(AU + (row0 + t) * 1280 + 2 * cp); h0 = __expf(bflo(w.x)) * h0 + bfhi(w.x); h1 = __expf(bflo(w.y)) * h1 + bfhi(w.y);
            const unsigned yb2 = *(const unsigned*)(proj + (row0 + t) * 2560 + 2 * cp);
            *(unsigned short*)((unsigned char*)core + (row0 + t) * 1280 + 2 * cp) = (unsigned short)(pk4_fp8(h0 * bflo(yb2), h1 * bfhi(yb2), 0.f, 0.f) & 0xffffu); } }
}

__device__ __forceinline__ void fox_dcum(const Params& P, LAS unsigned char* lds) {
    const int tid = my_tid(), lane = tid & 63, wave = __builtin_amdgcn_readfirstlane(tid >> 6), G = gridDim.x;
    const float* flog = (const float*)(P.ws + WS_SMALL); float* dcum = (float*)(P.ws + WS_DCUM);
    LAS float* sc = (LAS float*)lds;
    for (int u = blockIdx.x; u < 64; u += G) { const int b = u >> 4, h = u & 15; const float bf = kin(I_FOX_BF)[h];
        float loc[8]; float run = 0.f;
#pragma unroll
        for (int i = 0; i < 8; ++i) { run += logsigmoidf_(flog[((size_t)b * SEQ + tid * 8 + i) * 16 + h] + bf); loc[i] = run; }
        float inc = run;
#pragma unroll
        for (int o = 1; o < 64; o <<= 1) { const float nb = __shfl_up(inc, o); if (lane >= o) inc += nb; }
        if (lane == 63) sc[wave] = inc;
        __syncthreads();
        float wbase = 0.f;
#pragma unroll
        for (int w8 = 0; w8 < 8; ++w8) if (w8 < wave) wbase += sc[w8];
        const float base = wbase + inc - run;
#pragma unroll
        for (int i = 0; i < 8; ++i) dcum[(size_t)u * SEQ + tid * 8 + i] = (base + loc[i]) * LOG2E;
        __syncthreads(); }
}
__device__ __forceinline__ void fox_norm_tile(const Params& P, int pm, int pn) {
    const int tid = my_tid(), lane = tid & 63, wave = __builtin_amdgcn_readfirstlane(tid >> 6);
    bf16* proj = (bf16*)(P.ws + WS_PROJ); const int which = pn >> 2; const int d0 = (lane & 3) * 16; const float* gn = kin(which ? I_FOX_KG : I_FOX_QG) + d0;
#pragma unroll 2
    for (int st = 0; st < 8; ++st) { const int row = pm * 256 + st * 32 + wave * 4 + (lane >> 4); bf16* p = proj + (size_t)row * 4096 + pn * 256 + (lane & 15) * 16;
        const v4u w0 = *(const v4u*)p, w1 = *(const v4u*)(p + 8); float f[16];
        f[0] = bflo(w0.x); f[1] = bfhi(w0.x); f[2] = bflo(w0.y); f[3] = bfhi(w0.y); f[4] = bflo(w0.z); f[5] = bfhi(w0.z); f[6] = bflo(w0.w); f[7] = bfhi(w0.w);
        f[8] = bflo(w1.x); f[9] = bfhi(w1.x); f[10] = bflo(w1.y); f[11] = bfhi(w1.y); f[12] = bflo(w1.z); f[13] = bfhi(w1.z); f[14] = bflo(w1.w); f[15] = bfhi(w1.w);
        float ss = 0.f;
#pragma unroll
        for (int i = 0; i < 16; ++i) ss += f[i] * f[i];
        ss += dpp_f<0xB1>(ss); ss += dpp_f<0x4E>(ss);
        const float rs = __builtin_amdgcn_rsqf(ss * (1.0f / 64.0f) + LN_EPS) * (which ? 1.0f : FOX_C2);
        v4u o0, o1; o0.x = pk2(f[0] * rs * gn[0], f[1] * rs * gn[1]); o0.y = pk2(f[2] * rs * gn[2], f[3] * rs * gn[3]); o0.z = pk2(f[4] * rs * gn[4], f[5] * rs * gn[5]); o0.w = pk2(f[6] * rs * gn[6], f[7] * rs * gn[7]);
        o1.x = pk2(f[8] * rs * gn[8], f[9] * rs * gn[9]); o1.y = pk2(f[10] * rs * gn[10], f[11] * rs * gn[11]); o1.z = pk2(f[12] * rs * gn[12], f[13] * rs * gn[13]); o1.w = pk2(f[14] * rs * gn[14], f[15] * rs * gn[15]);
        *(v4u*)p = o0; *(v4u*)(p + 8) = o1; }
}
#include <hip/hip_bf16.h>
#include <cmath>
namespace attn_body {
using bf16=__hip_bfloat16;
using bf16x8=__attribute__((ext_vector_type(8)))short;
using s16x4=__attribute__((ext_vector_type(4)))short;
using f32x16=__attribute__((ext_vector_type(16)))float;
using u32x4=__attribute__((ext_vector_type(4)))unsigned;
constexpr int BATCH=4,NHEAD=16,SEQ=4096,D=64,PIN=4096,POUT=1024;
constexpr int NW=8,QBLK=32,QB=QBLK*NW,KVBLK=64,NQB=SEQ/QB;
constexpr int ATTN_UNIT_ROWS=QB; constexpr int LDS_DTAB=90112;
__device__ __forceinline__ int crow(int r,int hi){return (r&3)+8*(r>>2)+4*hi;}
#define SBAR() __builtin_amdgcn_sched_barrier(0)
__device__ __forceinline__ void cmask(f32x16&p0,f32x16&p1,int jb,int qrel,int hi){
  const float NEG=-INFINITY; int kb=64*jb+4*hi;
  #pragma unroll
  for(int r=0;r<16;++r){int kv=kb+(r&3)+8*(r>>2); if(kv>qrel)p0[r]=NEG; if(kv+32>qrel)p1[r]=NEG;}
}

constexpr int NSLOT=3, SLOTB=8192;
constexpr int LDS_K=0, LDS_V=NSLOT*SLOTB, LDS_WS=2*NSLOT*SLOTB, LDS_OST=LDS_WS+NW*64*4, LDS_BYTES=LDS_OST+NW*4096;
constexpr float C2=0.125f*1.4426950408889634f;
__device__ __forceinline__ void glds16(const void*gsrc,unsigned lds_dst){unsigned keep;
  asm volatile("s_mov_b32 %0, m0\n\ts_mov_b32 m0, %2\n\ts_nop 0\n\tglobal_load_lds_dwordx4 %1, off\n\ts_mov_b32 m0, %0":"=&s"(keep):"v"(gsrc),"s"(lds_dst):"memory");}
__device__ __forceinline__ float max3f(float a,float b,float c){float r;asm("v_max3_f32 %0, %1, %2, %3":"=v"(r):"v"(a),"v"(b),"v"(c));return r;}
__device__ __forceinline__ float max2f(float a,float b){float r;asm("v_max_f32_e32 %0, %1, %2":"=v"(r):"v"(a),"v"(b));return r;}
__device__ __forceinline__ float fadd_s(float a,float b){float r;asm("v_add_f32_e32 %0, %1, %2":"=v"(r):"v"(a),"v"(b));return r;}
__device__ __forceinline__ float fsub_s(float a,float b){float r;asm("v_sub_f32_e32 %0, %1, %2":"=v"(r):"v"(a),"v"(b));return r;}
typedef float f32x2_t __attribute__((ext_vector_type(2))); typedef __bf16 bf16x2_t __attribute__((ext_vector_type(2)));
__device__ __forceinline__ unsigned cvtpk_s(float lo,float hi){f32x2_t v={lo,hi};bf16x2_t b=__builtin_convertvector(v,bf16x2_t);return __builtin_bit_cast(unsigned,b);}
#define WAIT_BAR(N) asm volatile("s_waitcnt vmcnt(" #N ") lgkmcnt(0)\n\ts_barrier":::"memory")

__device__ __forceinline__ void qkt(f32x16&p0,f32x16&p1,const char*Kslot,const bf16x8*qr,int r32,int hi){
  const char*kb=Kslot+hi*1024+r32*16;
  #pragma unroll
  for(int d0=0;d0<4;++d0){
    const bf16x8 b0=*reinterpret_cast<const bf16x8*>(kb+d0*2048);
    const bf16x8 b1=*reinterpret_cast<const bf16x8*>(kb+d0*2048+512);
    p0=__builtin_amdgcn_mfma_f32_32x32x16_bf16(b0,qr[d0],p0,0,0,0);p1=__builtin_amdgcn_mfma_f32_32x32x16_bf16(b1,qr[d0],p1,0,0,0);}
}
typedef __attribute__((address_space(3))) const char* lds_cptr;
typedef __attribute__((address_space(3))) const float* lds_fptr; typedef float f32x4g __attribute__((ext_vector_type(4)));
typedef short v4i16_t __attribute__((ext_vector_type(4)));
__device__ __forceinline__ void kload8(bf16x8*kf,lds_cptr kp){
  kf[0]=*(const __attribute__((address_space(3))) bf16x8*)(kp);      kf[1]=*(const __attribute__((address_space(3))) bf16x8*)(kp+512);
  kf[2]=*(const __attribute__((address_space(3))) bf16x8*)(kp+2048); kf[3]=*(const __attribute__((address_space(3))) bf16x8*)(kp+2560);
  kf[4]=*(const __attribute__((address_space(3))) bf16x8*)(kp+4096); kf[5]=*(const __attribute__((address_space(3))) bf16x8*)(kp+4608);
  kf[6]=*(const __attribute__((address_space(3))) bf16x8*)(kp+6144); kf[7]=*(const __attribute__((address_space(3))) bf16x8*)(kp+6656);
}
__device__ __forceinline__ void kload2(bf16x8*kf,lds_cptr kp,int j){ kf[2*j]=*(const __attribute__((address_space(3))) bf16x8*)(kp+j*2048); kf[2*j+1]=*(const __attribute__((address_space(3))) bf16x8*)(kp+j*2048+512); }
__device__ __forceinline__ s16x4 vtr(lds_cptr p){ return __builtin_bit_cast(s16x4,__builtin_amdgcn_ds_read_tr16_b64_v4i16((__attribute__((address_space(3))) v4i16_t*)p)); }
__device__ __forceinline__ float rowmax(const f32x16&p0,const f32x16&p1){
  float a=max3f(p0[0],p0[1],p1[0]),b=max3f(p0[2],p0[3],p1[1]);a=max3f(a,p1[2],p1[3]);
  #pragma unroll
  for(int r=4;r<16;r+=4){a=max3f(a,p0[r],p0[r+1]);b=max3f(b,p0[r+2],p0[r+3]);a=max3f(a,p1[r],p1[r+1]);b=max3f(b,p1[r+2],p1[r+3]);}
  const float m=max2f(a,b);
  auto rr=__builtin_amdgcn_permlane32_swap(__float_as_uint(m),__float_as_uint(m),false,false);
  return max2f(__uint_as_float(rr[0]),__uint_as_float(rr[1]));
}
__device__ __forceinline__ void pv(f32x16*o,int vb,bf16x8 pa0,bf16x8 pa1,bf16x8 pa2,bf16x8 pa3){
  #pragma unroll
  for(int d0=0;d0<2;++d0){s16x4 lo[4],hi[4];
    #pragma unroll
    for(int ks=0;ks<4;++ks){
      asm volatile("ds_read_b64_tr_b16 %0,%1 offset:%c2":"=&v"(lo[ks]):"v"(vb),"i"(d0*4096+ks*1024):"memory");
      asm volatile("ds_read_b64_tr_b16 %0,%1 offset:%c2":"=&v"(hi[ks]):"v"(vb),"i"(d0*4096+ks*1024+512):"memory");}
    asm volatile("s_waitcnt lgkmcnt(0)":::"memory");SBAR();
    #define PK(k) (bf16x8){lo[k][0],lo[k][1],lo[k][2],lo[k][3],hi[k][0],hi[k][1],hi[k][2],hi[k][3]}
    o[d0]=__builtin_amdgcn_mfma_f32_32x32x16_bf16(pa0,PK(0),o[d0],0,0,0);
    o[d0]=__builtin_amdgcn_mfma_f32_32x32x16_bf16(pa1,PK(1),o[d0],0,0,0);
    o[d0]=__builtin_amdgcn_mfma_f32_32x32x16_bf16(pa2,PK(2),o[d0],0,0,0);
    o[d0]=__builtin_amdgcn_mfma_f32_32x32x16_bf16(pa3,PK(3),o[d0],0,0,0);
    #undef PK
  }
}

#ifndef ATTN_STORE16
#define ATTN_STORE16(p,v) (*(u32x4*)(p)=(v))
#endif
template<int THRL> __device__ __forceinline__ void attn_unit(int b,int h,int qb,const bf16*Q,const bf16* K,const bf16* V,const bf16*OG,const float*DC,bf16*O,char*shm,bool fill){
  const int tid=threadIdx.x,lane=tid&63,r32=lane&31,hi=lane>>5; const int wid=__builtin_amdgcn_readfirstlane(tid>>6);
  const long rowbase=(long)b*SEQ; const int q0=qb*QB;
  const bf16*Qw=Q+(rowbase+q0+wid*QBLK)*PIN+h*D;
  const bf16*Kh=K+rowbase*PIN+h*D,*Vh=V+rowbase*PIN+h*D;
  const unsigned lds0=(unsigned)(uintptr_t)shm;
  float*wsf=(float*)(shm+LDS_WS)+wid*64;
  const bf16*ksrc=Kh+(long)lane*PIN+wid*8;
  const bf16*vsrc=Vh+(long)(16*(wid&3)+(lane>>2))*PIN+(wid>>2)*32+(lane&3)*8;
  const unsigned kdst=lds0+LDS_K+wid*1024, vdst=lds0+LDS_V+wid*1024;
  #define DMA_K(t,slot) glds16(ksrc+(long)(t)*KVBLK*PIN,(unsigned)__builtin_amdgcn_readfirstlane(kdst+(slot)))
  #define DMA_V(t,slot) glds16(vsrc+(long)(t)*KVBLK*PIN,(unsigned)__builtin_amdgcn_readfirstlane(vdst+(slot)))
  const int vb0=(int)(lds0+LDS_V)+((lane>>4)&1)*32+(lane&3)*8+(4*hi+((lane&15)>>2))*64;
  const char*Kbase=shm+LDS_K; bf16x8 kf[8];
  const lds_cptr shm3=(lds_cptr)shm; const lds_cptr kp0=shm3+LDS_K+hi*1024+r32*16; const lds_cptr vp0=shm3+LDS_V+((lane>>4)&1)*32+(lane&3)*8+(4*hi+((lane&15)>>2))*64;
  const int NT=(q0+QB)/KVBLK;
  const lds_fptr dtab=(lds_fptr)(shm3+LDS_DTAB);
  if(fill){ const f32x4g*src=(const f32x4g*)(DC+(long)(b*NHEAD+h)*SEQ); for(int i=tid;i<SEQ/4;i+=NW*64) ((__attribute__((address_space(3))) f32x4g*)dtab)[i]=src[i]; }
  DMA_K(0,0);DMA_V(0,0);DMA_K(1,SLOTB);
  bf16x8 qr[4];
  #pragma unroll
  for(int d0=0;d0<4;++d0)qr[d0]=*reinterpret_cast<const bf16x8*>(&Qw[(long)r32*PIN+d0*16+hi*8]);
  float mhat=0.f,l_reg=0.f;f32x16 o[2];o[0]=f32x16{};o[1]=f32x16{}; float dq=0.f;
  #define BIAS(C0,C1,t) do{ const float base_=dq-mhat; const lds_fptr dk_=dtab+(t)*KVBLK+4*hi; \
    _Pragma("unroll") for(int g_=0;g_<4;++g_){ const f32x4g a_=*(const __attribute__((address_space(3))) f32x4g*)(dk_+8*g_), b_=*(const __attribute__((address_space(3))) f32x4g*)(dk_+32+8*g_); \
      _Pragma("unroll") for(int q_=0;q_<4;++q_){ C0[4*g_+q_]=base_-a_[q_]; C1[4*g_+q_]=base_-b_[q_]; } } }while(0)
  const int qrel=wid*QBLK+r32;
  #define CMASK(P0,P1,t) do{int jb_=(t)-(NT-4); if(jb_>=0)cmask(P0,P1,jb_,qrel,hi);}while(0)
  bool resc=false;
  #define START(P0,P1) do{ const float rm=rowmax(P0,P1); resc=false; \
    { const float dl=rm; mhat=fadd_s(mhat,dl); \
      _Pragma("unroll") for(int r=0;r<16;++r){P0[r]=fsub_s(P0[r],dl);P1[r]=fsub_s(P1[r],dl);} \
      } \
    _Pragma("unroll") for(int r=0;r<16;++r)P0[r]=__builtin_amdgcn_exp2f(P0[r]); }while(0)
  #define RESC() do{ if(resc){ asm volatile("s_waitcnt lgkmcnt(0)":::"memory"); \
      _Pragma("unroll") for(int d_=0;d_<2;++d_) _Pragma("unroll") for(int r=0;r<16;++r)o[d_][r]*=wsf[crow(r,hi)]; } }while(0)
  f32x16 pA0,pA1,pB0,pB1;
  int sl_prev=0,sl_cur=0,sl_next=SLOTB;
  #define ROT() do{sl_prev=sl_cur;sl_cur=sl_next;sl_next=(sl_next==(NSLOT-1)*SLOTB)?0:sl_next+SLOTB;}while(0)
  DMA_K(2,2*SLOTB);
  WAIT_BAR(3);
  dq=dtab[q0+wid*QBLK+r32];
  BIAS(pA0,pA1,0); qkt(pA0,pA1,Kbase,qr,r32,hi);asm volatile("s_nop 15\n\ts_nop 7":"+v"(pA0),"+v"(pA1));CMASK(pA0,pA1,0);
  START(pA0,pA1);
  _Pragma("unroll") for(int r=0;r<16;++r)pA1[r]=__builtin_amdgcn_exp2f(pA1[r]);
  WAIT_BAR(0);
  DMA_K(3,0);DMA_V(1,SLOTB);
  ROT();
  kload8(kf,kp0+sl_cur);
  WAIT_BAR(2);
  s16x4 vlo[8],vhi[8]; u32x4 pw0,pw1,pw2,pw3;
  #define PKW(P,B) cvtpk_s(P[B],P[B+1])
  #define PAF(k) __builtin_bit_cast(bf16x8,pw##k)
  #define VFR(i) (bf16x8){vlo[i][0],vlo[i][1],vlo[i][2],vlo[i][3],vhi[i][0],vhi[i][1],vhi[i][2],vhi[i][3]}
  #define PIN(x) asm volatile("":"+v"(x))
  #define MX3(a,b,c) __builtin_fmaxf(__builtin_fmaxf((a),(b)),(c))
  #define GAPA(MF,A0,A1,A2,A3,W0,W1,PW) do{ MF; sacc+=A0; sacc+=A1; sacc+=A2; sacc+=A3; PIN(sacc); W0; W1; PIN(PW); SBAR(); }while(0)
  #define EX(v) __builtin_amdgcn_exp2f(v)
  #define GAPB(MF,X,B) do{ MF; X[B]=EX(X[B]); X[B+1]=EX(X[B+1]); X[B+2]=EX(X[B+2]); X[B+3]=EX(X[B+3]); PIN(X); SBAR(); }while(0)
  #define VRD(i) do{ vlo[i]=vtr(vp_+(((i)>>2)*4096+((i)&3)*1024)); vhi[i]=vtr(vp_+(((i)>>2)*4096+((i)&3)*1024+512)); }while(0)
  #define KRD(G,j) do{ if(G){ kload2(kf,kp0+sl_next,j); SBAR(); } }while(0)
  #define STEP(C0,C1,P0,P1,t,GK,GV,GL) do{ SBAR(); BIAS(C0,C1,t); SBAR(); \
    const lds_cptr vp_=vp0+sl_prev; \
    VRD(0); SBAR(); float sacc=(P0[0]+P0[1]); \
    GAPA(C0=__builtin_amdgcn_mfma_f32_32x32x16_bf16(kf[0],qr[0],C0,0,0,0), P0[2],P0[3],P0[4],P0[5],     pw0[0]=PKW(P0,0), pw0[1]=PKW(P0,2), pw0); \
    VRD(4); SBAR(); GAPA(C1=__builtin_amdgcn_mfma_f32_32x32x16_bf16(kf[1],qr[0],C1,0,0,0), P0[6],P0[7],P0[8],P0[9],     pw0[2]=PKW(P0,4), pw0[3]=PKW(P0,6), pw0); \
    VRD(1); SBAR(); GAPA(C0=__builtin_amdgcn_mfma_f32_32x32x16_bf16(kf[2],qr[1],C0,0,0,0),   P0[10],P0[11],P0[12],P0[13], pw1[0]=PKW(P0,8), pw1[1]=PKW(P0,10), pw1); \
    VRD(5); SBAR(); GAPA(C1=__builtin_amdgcn_mfma_f32_32x32x16_bf16(kf[3],qr[1],C1,0,0,0),   P0[14],P0[15],P1[0],P1[1],   pw1[2]=PKW(P0,12),pw1[3]=PKW(P0,14), pw1); \
    VRD(2); SBAR(); GAPA(C0=__builtin_amdgcn_mfma_f32_32x32x16_bf16(kf[4],qr[2],C0,0,0,0),   P1[2],P1[3],P1[4],P1[5],     pw2[0]=PKW(P1,0), pw2[1]=PKW(P1,2), pw2); \
    VRD(6); SBAR(); GAPA(C1=__builtin_amdgcn_mfma_f32_32x32x16_bf16(kf[5],qr[2],C1,0,0,0),   P1[6],P1[7],P1[8],P1[9],     pw2[2]=PKW(P1,4), pw2[3]=PKW(P1,6), pw2); \
    VRD(3); SBAR(); GAPA(C0=__builtin_amdgcn_mfma_f32_32x32x16_bf16(kf[6],qr[3],C0,0,0,0),   P1[10],P1[11],P1[12],P1[13], pw3[0]=PKW(P1,8), pw3[1]=PKW(P1,10), pw3); \
    VRD(7); SBAR(); GAPA(C1=__builtin_amdgcn_mfma_f32_32x32x16_bf16(kf[7],qr[3],C1,0,0,0),   P1[14],P1[15],0.f,0.f,       pw3[2]=PKW(P1,12),pw3[3]=PKW(P1,14), pw3); \
    l_reg+=sacc; \
    if(GK){DMA_K((t)+3,sl_cur);} if(GV){DMA_V((t)+1,sl_next);} \
    CMASK(C0,C1,t); \
    { float a=MX3(C0[0],C0[1],C1[0]),b=MX3(C0[2],C0[3],C1[1]); a=MX3(a,C1[2],C1[3]); \
      _Pragma("unroll") for(int r=4;r<16;r+=4){a=MX3(a,C0[r],C0[r+1]);b=MX3(b,C0[r+2],C0[r+3]);a=MX3(a,C1[r],C1[r+1]);b=MX3(b,C1[r+2],C1[r+3]);} \
      float rm=__builtin_fmaxf(a,b); { auto rr=__builtin_amdgcn_permlane32_swap(__float_as_uint(rm),__float_as_uint(rm),false,false); rm=__builtin_fmaxf(__uint_as_float(rr[0]),__uint_as_float(rr[1])); } \
      resc=false; \
      if(__builtin_expect(__any(rm>(float)THRL),0)){ const float dl=__builtin_fmaxf(rm,0.f); mhat+=dl; \
        _Pragma("unroll") for(int r=0;r<16;++r){C0[r]-=dl;C1[r]-=dl;} \
        const float f=__builtin_amdgcn_exp2f(-dl); l_reg*=f; if(hi==0)wsf[r32]=f; resc=true; } } \
    SBAR(); \
    GAPB(o[0]=__builtin_amdgcn_mfma_f32_32x32x16_bf16(PAF(0),VFR(0),o[0],0,0,0), C0,0); \
    GAPB(o[1]=__builtin_amdgcn_mfma_f32_32x32x16_bf16(PAF(0),VFR(4),o[1],0,0,0), C0,4); \
    KRD(GL,0); GAPB(o[0]=__builtin_amdgcn_mfma_f32_32x32x16_bf16(PAF(1),VFR(1),o[0],0,0,0), C0,8); \
    KRD(GL,1); GAPB(o[1]=__builtin_amdgcn_mfma_f32_32x32x16_bf16(PAF(1),VFR(5),o[1],0,0,0), C0,12); \
    KRD(GL,2); GAPB(o[0]=__builtin_amdgcn_mfma_f32_32x32x16_bf16(PAF(2),VFR(2),o[0],0,0,0), C1,0); \
    KRD(GL,3); GAPB(o[1]=__builtin_amdgcn_mfma_f32_32x32x16_bf16(PAF(2),VFR(6),o[1],0,0,0), C1,4); \
    GAPB(o[0]=__builtin_amdgcn_mfma_f32_32x32x16_bf16(PAF(3),VFR(3),o[0],0,0,0), C1,8); \
    GAPB(o[1]=__builtin_amdgcn_mfma_f32_32x32x16_bf16(PAF(3),VFR(7),o[1],0,0,0), C1,12); \
    }while(0)
  int t=1;
  #undef CMASK
  #define CMASK(P0,P1,t) do{}while(0)
  for(;t+5<NT;t+=2){
    STEP(pB0,pB1,pA0,pA1,t,true,true,true);     WAIT_BAR(2); RESC(); ROT();
    STEP(pA0,pA1,pB0,pB1,t+1,true,true,true);   WAIT_BAR(2); RESC(); ROT();
  }
  #undef CMASK
  #define CMASK(P0,P1,t) do{int jb_=(t)-(NT-4); if(jb_>=0)cmask(P0,P1,jb_,qrel,hi);}while(0)
  #define ENDW(tt) do{ if((tt)+3<NT){WAIT_BAR(2);} else if((tt)+2<NT){WAIT_BAR(1);} else {WAIT_BAR(0);} }while(0)
  for(;t+1<NT;t+=2){
    STEP(pB0,pB1,pA0,pA1,t,(t+3<NT),(t+1<NT),(t+1<NT));       ENDW(t);   RESC(); ROT();
    STEP(pA0,pA1,pB0,pB1,t+1,(t+4<NT),(t+2<NT),(t+2<NT));     ENDW(t+1); RESC(); ROT();
  }
  STEP(pB0,pB1,pA0,pA1,NT-1,false,false,false); RESC();
  { float sacc=pB0[0]+pB0[1]; _Pragma("unroll") for(int r=2;r<16;++r)sacc+=pB0[r]; _Pragma("unroll") for(int r=0;r<16;++r)sacc+=pB1[r]; l_reg+=sacc;
    pw0=(u32x4){PKW(pB0,0),PKW(pB0,2),PKW(pB0,4),PKW(pB0,6)};pw1=(u32x4){PKW(pB0,8),PKW(pB0,10),PKW(pB0,12),PKW(pB0,14)};pw2=(u32x4){PKW(pB1,0),PKW(pB1,2),PKW(pB1,4),PKW(pB1,6)};pw3=(u32x4){PKW(pB1,8),PKW(pB1,10),PKW(pB1,12),PKW(pB1,14)};
    SBAR(); pv(o,vb0+sl_cur,PAF(0),PAF(1),PAF(2),PAF(3)); }
  #undef PKW
  #undef PAF
  #undef VFR
  #undef PIN
  #undef MX3
  #undef GAPA
  #undef GAPB
  #undef EX
  #undef VRD
  #undef KRD
  #undef STEP
  #undef ENDW
  {auto rr=__builtin_amdgcn_permlane32_swap(__float_as_uint(l_reg),__float_as_uint(l_reg),false,false);l_reg=__uint_as_float(rr[0])+__uint_as_float(rr[1]);}
  if(hi==0)wsf[32+r32]=l_reg;asm volatile("s_waitcnt lgkmcnt(0)":::"memory");
  float rli[16];
  #pragma unroll
  for(int r=0;r<16;++r)rli[r]=__builtin_amdgcn_rcpf(wsf[32+crow(r,hi)]);
  unsigned char*Ow=(unsigned char*)O+(rowbase+q0+wid*QBLK)*POUT+h*D; const bf16*Gw=OG+(rowbase+q0+wid*QBLK)*PIN+h*D;
  { bf16*stg=(bf16*)(shm+LDS_OST)+wid*2048;
    #pragma unroll
    for(int r=0;r<16;++r){const int orow=crow(r,hi);
      #pragma unroll
      for(int d0=0;d0<2;++d0)stg[orow*64+d0*32+r32]=__float2bfloat16(o[d0][r]*rli[r]);}
    asm volatile("s_waitcnt lgkmcnt(0)":::"memory");
    #pragma unroll
    for(int i=0;i<4;++i){const int row=i*8+(lane>>3),ch=lane&7; const u32x4 v=*(const u32x4*)(stg+row*64+ch*8); const u32x4 g=*(const u32x4*)(Gw+(long)row*PIN+ch*8); float wf[8];
      _Pragma("unroll") for(int q_=0;q_<4;++q_){ const float gl=__uint_as_float(g[q_]<<16),gh=__uint_as_float(g[q_]&0xffff0000u),vl=__uint_as_float(v[q_]<<16),vh=__uint_as_float(v[q_]&0xffff0000u);
        wf[2*q_]=vl*__builtin_amdgcn_rcpf(1.f+__builtin_amdgcn_exp2f(-1.4426950408889634f*gl)); wf[2*q_+1]=vh*__builtin_amdgcn_rcpf(1.f+__builtin_amdgcn_exp2f(-1.4426950408889634f*gh)); }
      int p0_=0,p1_=0; p0_=__builtin_amdgcn_cvt_pk_fp8_f32(wf[0],wf[1],p0_,false); p0_=__builtin_amdgcn_cvt_pk_fp8_f32(wf[2],wf[3],p0_,true); p1_=__builtin_amdgcn_cvt_pk_fp8_f32(wf[4],wf[5],p1_,false); p1_=__builtin_amdgcn_cvt_pk_fp8_f32(wf[6],wf[7],p1_,true);
      typedef unsigned u32x2_ __attribute__((ext_vector_type(2))); *(u32x2_*)(Ow+(long)row*POUT+ch*8)=(u32x2_){(unsigned)p0_,(unsigned)p1_};} }
  asm volatile("s_waitcnt lgkmcnt(0)\n\ts_barrier":::"memory");
  #undef DMA_K
  #undef DMA_V
  #undef CMASK
  #undef START
  #undef RESC
  #undef ROT
  #undef BIAS
}
constexpr int ATTN_LDS_BYTES=LDS_BYTES;
struct AttnTensors { const bf16* Q; const bf16* K; const bf16* V; const bf16* OG; const float* DC; bf16* O; };
struct AttnUnit { int bh; int qb; };
struct StaticOrder {
  int vcu;
  __device__ __forceinline__ explicit StaticOrder(int grid,int block):vcu((block%8)*(grid/8)+block/8){}
  __device__ __forceinline__ bool next(int i,AttnUnit&u)const{ if(i>=4)return false; const int s=vcu&3; u.bh=vcu>>2; u.qb=(i==0)?s:(i==1)?7-s:(i==2)?8+s:15-s; return true; }
  __device__ __forceinline__ void a_ready(const AttnUnit&)const{}
  __device__ __forceinline__ void done(const AttnUnit&)const{}
};
template<class Sched,int THRL=8> __device__ __forceinline__ void attn_phase(char*lds,const AttnTensors&T,const Sched&S){
  AttnUnit u;
  int last_bh=-1;
  for(int i=0;S.next(i,u);++i){ S.a_ready(u); attn_unit<THRL>(u.bh/NHEAD,u.bh%NHEAD,u.qb,T.Q,T.K,T.V,T.OG,T.DC,T.O,lds,u.bh!=last_bh); last_bh=u.bh; S.done(u); }
}
#undef SBAR
#undef WAIT_BAR
}

__device__ __forceinline__ void moe_tables(const Params& P, LAS unsigned char* lds, int l) {
    LAS int* ts = (LAS int*)(lds + L_TS); LAS int* lc = (LAS int*)(lds + L_CNT);
    const unsigned* cnt = (const unsigned*)(P.ws + WS_CTL) + CW_CNT + 64 * l;
    if (threadIdx.x < 64) { const int ln = (int)threadIdx.x; const int c = ln < 32 ? (int)__hip_atomic_load(cnt + (ln & 31), RLX_AGENT) : 0; const int t = (c + 255) >> 8; int inc = t;
#pragma unroll
        for (int o = 1; o < 32; o <<= 1) { const int nb = __shfl_up(inc, o); if (ln >= o) inc += nb; }
        if (ln < 32) { lc[ln] = c; ts[ln] = inc - t; if (ln == 31) ts[32] = inc; } }
    __syncthreads();
}
__device__ __forceinline__ int moe_units(LAS unsigned char* lds, int NT, int vcu, const int* elist, const float* ewt, const float* bias) {
    const LAS int* ts = (const LAS int*)(lds + L_TS); LAS unsigned* ul = (LAS unsigned*)(lds + L_ULIST); LAS int* nu = (LAS int*)(lds + L_NU);
    { const int G = gridDim.x, total = ts[32] * NT, i = (int)threadIdx.x;
      if (i < 64) { const int L = i * G + vcu;
          if (L < total) { int e = 0;
#pragma unroll 1
              for (int q = 16; q >= 1; q >>= 1) if (ts[e + q] * NT <= L) e += q;
              const int up = L - ts[e] * NT, te = ts[e + 1] - ts[e]; const int nt = up / te, rt = up % te; ul[i] = (unsigned)(ts[e] + rt) | ((unsigned)(e * NT + nt) << 16); } }
      if (i == 0) nu[0] = vcu < total ? (total - vcu + G - 1) / G : 0; }
    __syncthreads();
    const LAS int* lc = (const LAS int*)(lds + L_CNT); const int n = nu[0];
    if (NT == 8) {
        LAS unsigned* tab = (LAS unsigned*)(lds + L_VEC); LAS float* bt = (LAS float*)(lds + L_VEC + 10240);
#pragma unroll 5
        for (int i = threadIdx.x; i < n * 256; i += 512) { const unsigned uw = ul[i >> 8]; const int pm = (int)(uw & 0xffffu), pn = (int)(uw >> 16), e = pn / NT; const int p = (pm - ts[e]) * 256 + (i & 255);
            tab[i] = (p < lc[e]) ? (unsigned)(elist[(size_t)e * T + p] >> 2) * 1024u : 0u; bt[i] = 32.0f * bias[(size_t)pn * 256 + (i & 255)] + ((i & 128) ? 32.0f : 0.0f); }
    } else {
        LAS unsigned* tab = (LAS unsigned*)(lds + L_VEC); LAS float* bt = (LAS float*)(lds + L_VEC + 10240);
#pragma unroll 3
        for (int i = threadIdx.x; i < n * 256; i += 512) { const unsigned uw = ul[i >> 8]; const int pm = (int)(uw & 0xffffu), pn = (int)(uw >> 16), e = pn / NT; const int p = (pm - ts[e]) * 256 + (i & 255);
            int info = -1; float w = 0.f; if (p < lc[e]) { info = elist[(size_t)e * T + p]; w = ewt[(size_t)e * T + p] * 0.25f; }
            tab[2 * i] = (unsigned)info; tab[2 * i + 1] = __float_as_uint(w); bt[i] = 64.0f * bias[(size_t)pn * 256 + (i & 255)]; }
    }
    __syncthreads();
    return nu[0];
}

constexpr int NPH = 46;
__host__ __device__ inline bool phase_active(int ph) { if (ph < 2) return true; const int s = (ph - 2) % 11, kind = ((ph - 2) / 11) % 3; if (s == 1) return kind != 2; if (s == 2) return kind != 0; if (s == 3) return kind != 2; if (s == 4) return kind == 1; if (s == 7) return false; return true; }


#ifndef ONLY
#define ONLY -1
#endif
#ifndef DUP_SEL
#define DUP_SEL 0
#endif
#ifndef PHMASK
#define PHMASK 0xffffffffu
#endif
#define PHM(x) ((ONLY < 0 || ONLY == (x)) && ((PHMASK >> (x)) & 1))
#define IN(k) (PHM(k) && lo <= (k) && (k) < hi)
#define INL(s) (PHM(2 + (s)) && lo <= (base + (s)) && (base + (s)) < hi)
#define SEAM(k) do { if ((k) + 1 < hi && P.use_bar) { xcd_barrier(bar); if (DUP_SEL == 9) xcd_barrier(bar); } } while (0)
#define TOKDUP(NCV, A) do { if (DUP_SEL == 6) { TokA A2 = A; unsigned char* dz = ws + WS_ACT; if (A2.xout) A2.xout = (float*)dz; if (A2.hout) A2.hout = (bf16*)(dz + 64 * MiB); A2.small_out = (float*)(dz + 96 * MiB); A2.tk_e = (int*)(dz + 100 * MiB); A2.tk_p = nullptr; A2.tk_w = (float*)(dz + 104 * MiB); A2.cnt = (int*)(ctl + 65536);     tok_phase<NCV>(A2, lds); __syncthreads(); } tok_phase<NCV>(A, lds); } while (0)
#define NREP(sel) ((DUP_SEL == (sel)) ? 2 : 1)
template <int l>
__device__ __forceinline__ void layer_body(const Params& P, LAS unsigned char* lds, const XcdBarrier& bar, const int vcu) {
    constexpr int kind = l % 3, j = l / 3, base = 2 + 11 * l;
    const int lo = P.ph_lo, hi = P.ph_hi; const int G = gridDim.x, bx = blockIdx.x;
    unsigned char* ws = P.ws; unsigned* ctl = (unsigned*)(ws + WS_CTL);
    float* X = (float*)(ws + WS_X); bf16* Hb = (bf16*)(ws + WS_H); float* Y = (float*)(ws + WS_Y); bf16* proj = (bf16*)(ws + WS_PROJ); bf16* core = (bf16*)(ws + WS_CORE);
    const float* mod = (const float*)(ws + WS_MOD); float* small = (float*)(ws + WS_SMALL);
    int* tke = (int*)(ws + WS_TKE); int* tkp = (int*)(ws + WS_TKP); float* tkw = (float*)(ws + WS_TKW);

        const float* modl = mod + (size_t)l * NB * 6144;
        if (INL(0)) {
            pg8::Gemm g{}; pg8::EpiBf16Plain E{};
            g.A = Hb; g.M = T; g.K = 1024; g.lda = 1024; g.a_pn_stride = 0; E.O = proj; E.oscale = 1.0f;
            if (kind == 0) { g.Bt = (const bf16*)(ws + WT_GLA_IN) + (size_t)j * 3072 * 1024; g.N = 3072; E.ldc = 3072; E.gelu_pn_lt = 0; }
            else if (kind == 1) { g.Bt = (const bf16*)(ws + WT_RG_IN); g.N = 2560; E.ldc = 2560; E.gelu_pn_lt = 5; }
            else { g.Bt = (const bf16*)(ws + WT_FOX_IN); g.N = 4096; E.ldc = 4096; E.gelu_pn_lt = 0; }
            pg8::StaticOrder S; S.init(T, g.N, G, bx);
            if (kind == 2) fox_dcum(P, lds);
            for (int rep = 0; rep < NREP(3); ++rep) pg8::gemm_phase<pg8::EpiBf16Plain, pg8::StaticOrder, true, true>(lds, g, S, E);
            if (kind == 2) {
                __builtin_amdgcn_fence(__ATOMIC_ACQUIRE, "agent"); asm volatile("s_waitcnt vmcnt(0)" ::: "memory");
                pg8::Unit uu; for (int i = 0; S.next(i, uu); ++i) if (uu.pn < 8) fox_norm_tile(P, uu.pm, uu.pn); }
            SEAM(base + 0);
        }
        if (INL(1) && kind != 2) {
            if (kind == 0) { for (int rep = 0; rep < NREP(1); ++rep) gla_g1(P, lds, j); } else if (kind == 1) { for (int rep = 0; rep < NREP(4); ++rep) rg_conv(P); }
            SEAM(base + 1);
        }
        if (INL(2) && kind != 0) {
            if (kind == 1) {
                pg8::Gemm g{}; g.A = (const bf16*)(ws + WS_Y); g.Bt = (const bf16*)(ws + WT_RG_G); g.M = T; g.N = 2560; { int kq = 256; asm volatile("" : "+s"(kq)); g.K = kq; }     g.lda = 1280; g.a_pn_stride = 256;
                pg8::EpiRgGate E{(unsigned*)(ws + WS_MIX), (const bf16*)(ws + WS_Y), kin(I_RG_BRG), kin(I_RG_BIG), kin(I_RG_LAM)};
                pg8::StaticOrder S; S.init(T, 2560, G, bx);
                for (int rep = 0; rep < NREP(4); ++rep) pg8::gemm_phase<pg8::EpiRgGate, pg8::StaticOrder, true, true>(lds, g, S, E);
            } else { const attn_body::AttnTensors AT{(const attn_body::bf16*)proj, (const attn_body::bf16*)(proj + 1024), (const attn_body::bf16*)(proj + 2048), (const attn_body::bf16*)(proj + 3072), (const float*)(ws + WS_DCUM), (attn_body::bf16*)core};
                const attn_body::StaticOrder S(G, bx);
                for (int rep = 0; rep < NREP(2); ++rep) attn_body::attn_phase<attn_body::StaticOrder>((char*)lds, AT, S); }
            SEAM(base + 2);
        }
        if (INL(3) && kind != 2) { if (kind == 0) { for (int rep = 0; rep < NREP(11); ++rep) gla_g3(P, lds, j); } else { for (int rep = 0; rep < NREP(4); ++rep) rg_scan1(P); } SEAM(base + 3); }
        if (INL(4) && kind == 1) { for (int rep = 0; rep < NREP(4); ++rep) rg_scan2(P); SEAM(base + 4); }
        if (INL(5)) {
            pg8::Gemm g{}; g.A = core; g.M = T; g.N = 1024; g.a_pn_stride = 0;
            if (kind == 0) { g.Bt = (const bf16*)(ws + WT_GLA_OUT + (size_t)j * 1024 * 1024); g.K = 512; }
            else if (kind == 1) { g.Bt = (const bf16*)(ws + WT_RG_OUT); g.K = 640; }
            else { g.Bt = (const bf16*)(ws + WT_FOX_OUT); g.K = 512; }
            g.lda = g.K;
            pg8::EpiBf16Plain E{(bf16*)Y, 1024, 0, 0.015625f}; pg8::StaticOrder S; S.init(T, 1024, G, bx);
            for (int rep = 0; rep < NREP(3); ++rep) pg8::gemm_phase<pg8::EpiBf16Plain, pg8::StaticOrder, true, true, false, true>(lds, g, S, E);
            SEAM(base + 5);
        }
        if (INL(6)) {
            TokA A{}; A.xin = (l == 0) ? kin(I_X) : X; A.xin_bf = (l != 0); A.xout_bf = 1; A.ymode = 1; A.y = Y; A.gvec = modl + 2048; A.gamma = kin(I_LN_G) + (size_t)(l * 2) * D; A.beta = kin(I_LN_B) + (size_t)(l * 2) * D; A.xout = X;
            A.scvec = modl + 4096; A.shvec = modl + 3072; A.hout = Hb; A.h_fp8 = 1; A.W = kin(I_MOE_WR) + (size_t)l * D * 32; A.ldw = 32; A.bias = kin(I_MOE_BR) + l * 32;
            A.cnt = (int*)(ctl + CW_CNT + 64 * l); A.tk_e = (int*)(ws + WS_ELIST); A.tk_p = nullptr; A.tk_w = (float*)(ws + WS_EWT);
            TOKDUP(32, A); SEAM(base + 6);
        }
        if (INL(8)) {
            moe_tables(P, lds, l); const int n = moe_units(lds, 8, vcu, (const int*)(ws + WS_ELIST), nullptr, (const float*)(ws + WS_BGUP) + (size_t)l * 32 * 2048);
            pg8::Gemm g{}; g.A = Hb; g.Bt = (const bf16*)(ws + WT_GU + (size_t)l * 32 * 2048 * 1024); g.M = NPAD_MAX; g.N = 32 * 2048; { int kq = 512; asm volatile("" : "+s"(kq)); g.K = kq; } g.lda = 512; g.a_pn_stride = 0; g.wscale = 0x7a7a7a7a;
            pg8::EpiSwiglu E{(bf16*)(ws + WS_ACT), (const LAS float*)(lds + L_VEC + 10240)};
            pg8::ListOrder S{(const LAS unsigned*)(lds + L_ULIST), n};
            for (int rep = 0; rep < NREP(3); ++rep) pg8::gemm_phase<pg8::EpiSwiglu, pg8::ListOrder, true, true, true, true>(lds, g, S, E, (const LAS unsigned*)(lds + L_VEC));
            SEAM(base + 8);
        }
        if (INL(9)) {
            moe_tables(P, lds, l); const int n = moe_units(lds, 4, vcu, (const int*)(ws + WS_ELIST), (const float*)(ws + WS_EWT), kin(I_MOE_BDN) + (size_t)l * 32 * 1024);
            pg8::Gemm g{}; g.A = (const bf16*)(ws + WS_ACT); g.Bt = (const bf16*)(ws + WT_DN + (size_t)l * 32 * 1024 * 1024); g.M = NPAD_MAX; g.N = 32 * 1024; { int kq = 512; asm volatile("" : "+s"(kq)); g.K = kq; } g.lda = 512; g.a_pn_stride = 0; g.wscale = 0x79797979;
            pg8::EpiDown E{(bf16*)(ws + WS_YB), (const LAS unsigned*)(lds + L_VEC), (const LAS float*)(lds + L_VEC + 10240)};
            pg8::ListOrder S{(const LAS unsigned*)(lds + L_ULIST), n};
            for (int rep = 0; rep < NREP(3); ++rep) pg8::gemm_phase<pg8::EpiDown, pg8::ListOrder, true, true, false, true>(lds, g, S, E);
            SEAM(base + 9);
        }
        if (INL(10)) {
            TokA A{}; A.xin = X; A.xin_bf = 1; A.xout_bf = (l != 3); A.ymode = 2; A.yb = (const bf16*)(ws + WS_YB); A.gvec = modl + 5120; A.gamma = kin(I_LN_G) + (size_t)(l * 2 + 1) * D; A.beta = kin(I_LN_B) + (size_t)(l * 2 + 1) * D;
            A.xout = (l == 3) ? P.out : X;
            if (l < 3) { const float* modn = mod + (size_t)(l + 1) * NB * 6144; A.scvec = modn + 1024; A.shvec = modn; A.hout = Hb; A.small_out = small;
                const int nk = (l + 1) % 3;
                if (nk == 0) { A.W = kin(I_GLA_WIN) + (size_t)((l + 1) / 3) * 1024 * 3088 + 3072; A.ldw = 3088; TOKDUP(16, A); }
                else if (nk == 2) { A.W = kin(I_FOX_WIN) + 3072; A.ldw = 4112; TOKDUP(16, A); }
                else TOKDUP(0, A);
            } else TOKDUP(0, A);
            SEAM(base + 10);
        }
    }

__global__ void __launch_bounds__(512, 2) mega_fwd(Params P) {
    extern __shared__ __attribute__((aligned(16))) unsigned char lds_raw[];
    LAS unsigned char* lds = (LAS unsigned char*)lds_raw;
    const int tid = my_tid(), G = gridDim.x, bx = blockIdx.x;
    for (int i = tid; i < (LDS_BYTES - CTRL_OFF) / 4; i += 512) ((LAS unsigned*)(lds + CTRL_OFF))[i] = 0u;
    __syncthreads();
    unsigned char* ws = P.ws;
    unsigned* ctl = (unsigned*)(ws + WS_CTL);
    XcdBarrier bar; bar.bar = ctl + CW_BAR; bar.x = 0; bar.st = nullptr;
    if (P.use_bar) bar = xcd_barrier_post(ctl + CW_BAR, (volatile LAS unsigned*)(lds + L_MISC));
    const int vcu = (G % 8 == 0) ? (bx % 8) * (G / 8) + bx / 8 : bx;
    const int lo = P.ph_lo, hi = P.ph_hi;
    float* X = (float*)(ws + WS_X); bf16* Hb = (bf16*)(ws + WS_H); float* Y = (float*)(ws + WS_Y); bf16* proj = (bf16*)(ws + WS_PROJ); bf16* core = (bf16*)(ws + WS_CORE);
    const float* mod = (const float*)(ws + WS_MOD); float* small = (float*)(ws + WS_SMALL);
    int* tke = (int*)(ws + WS_TKE); int* tkp = (int*)(ws + WS_TKP); float* tkw = (float*)(ws + WS_TKW);

    if (IN(0)) { p0_adaln(P, lds); SEAM(0); }
    if (IN(1)) {
        TokA A{}; A.xin = kin(I_X); A.ymode = 0; A.scvec = mod + 1024; A.shvec = mod; A.hout = Hb; A.W = kin(I_GLA_WIN) + 3072; A.ldw = 3088; A.small_out = small;
        tok_phase<16>(A, lds); __syncthreads();
        for (int rep = 0; rep < NREP(5); ++rep) { p0_convert(P, lds); __syncthreads(); }
        SEAM(1);
    }
    layer_body<0>(P, lds, bar, vcu); layer_body<1>(P, lds, bar, vcu); layer_body<2>(P, lds, bar, vcu); layer_body<3>(P, lds, bar, vcu);
#undef IN
#undef INL
#undef SEAM
}

#ifndef MK_ONE_LAUNCH
#define MK_ONE_LAUNCH 1
#endif
extern "C" void kernel_launch(void* const* d_in, const int* in_sizes, int n_in, void* d_out, int out_size, void* d_ws, size_t ws_size, hipStream_t stream) {
    static int grid = 0;
    if (grid == 0) {
        if (n_in != 31 || out_size != T * D || ws_size < WS_END) { fprintf(stderr, "kernel_launch: unexpected shapes (n_in %d out %d ws %zu need %zu)\n", n_in, out_size, ws_size, (size_t)WS_END); grid = -1; return; }
        int dev = 0, cus = 0;
        if (hipGetDevice(&dev) != hipSuccess || hipDeviceGetAttribute(&cus, hipDeviceAttributeMultiprocessorCount, dev) != hipSuccess) { grid = -1; return; }
        if (hipFuncSetAttribute((const void*)mega_fwd, hipFuncAttributeMaxDynamicSharedMemorySize, LDS_BYTES) != hipSuccess) { fprintf(stderr, "kernel_launch: hipFuncSetAttribute failed\n"); grid = -1; return; }
        int per_cu = 0; (void)hipOccupancyMaxActiveBlocksPerMultiprocessor(&per_cu, (const void*)mega_fwd, 512, LDS_BYTES); (void)hipGetLastError();
        if (per_cu < 1) fprintf(stderr, "kernel_launch: occupancy query says %d\n", per_cu);
        grid = 256;
        if (cus != 256) fprintf(stderr, "kernel_launch: built for 256 CUs, device reports %d\n", cus);
    }
    if (grid < 0) return;
    (void)hipMemsetAsync((char*)d_ws + WS_CTL, 0, CTL_ZERO_BYTES, stream);
    Params p{};
    for (int i = 0; i < 31; ++i) p.in[i] = (const float*)d_in[i];
    p.out = (float*)d_out; p.ws = (unsigned char*)d_ws; p.pad = 0;
#if MK_ONE_LAUNCH
    p.ph_lo = 0; p.ph_hi = NPH; p.use_bar = 1;
    hipLaunchKernelGGL(mega_fwd, dim3(grid), dim3(512), LDS_BYTES, stream, p);
#else
    for (int ph = 0; ph < NPH; ++ph) { if (!phase_active(ph)) continue; p.ph_lo = ph; p.ph_hi = ph + 1; p.use_bar = 0;
        hipLaunchKernelGGL(mega_fwd, dim3(grid), dim3(512), LDS_BYTES, stream, p); }
#endif
}
```

```cpp
#include <hip/hip_runtime.h>
#include <cstdio>
#include <cstdint>
__device__ __forceinline__ int my_tid() { int t = (int)threadIdx.x; asm volatile("" : "+v"(t)); return t; }
namespace pg8 {
#define PG8_LAS __attribute__((address_space(3)))
typedef unsigned short bf16_t;
typedef short bf16x8 __attribute__((ext_vector_type(8)));
typedef float f32x4 __attribute__((ext_vector_type(4)));
typedef unsigned u32x4 __attribute__((ext_vector_type(4)));
constexpr int BM = 256, BK = 64, HALF = 128, HTB = HALF * BK * 2  , STAGE_BYTES = 8 * HTB, NXCD = 8, WGM = 8;
__host__ __device__ __forceinline__ int lds_byte(int r, int c) { const int st = (r >> 4) * 2 + (c >> 5), rr = r & 15, cc = c & 31, ob = rr * 64 + cc * 2; return st * 1024 + (ob ^ (((ob >> 9) & 1) << 5)); }
__host__ __device__ __forceinline__ void stage_rc(int b, int& R, int& C) { const int st = b / 1024, sb = b % 1024, swz = sb ^ (((sb >> 9) & 1) << 5); R = (st >> 1) * 16 + swz / 64; C = (st & 1) * 32 + (swz % 64) / 2; }
__host__ __device__ __forceinline__ int perm32(int rho) { const int n = rho >> 4, i = rho & 15; return 8 * (i >> 2) + 4 * n + (i & 3); }

struct Unit { int pm, pn, ui; };
struct Gemm { const bf16_t* A; const bf16_t* Bt; int M, N, K; int lda; size_t a_pn_stride; int wscale; };

struct StaticOrder {
    int nM, nN, nwg, G, c;
    __host__ __device__ void init(int M, int N, int G_, int c_) { nM = M / BM; nN = N / BM; nwg = nM * nN; G = G_; c = c_; }
    __host__ __device__ bool next(int i, Unit& u) const {
        const long L = (long)i * G + c; if (L >= nwg) return false;
        int wgid = (int)L; { const int q = nwg / NXCD, r = nwg % NXCD, xcd = wgid % NXCD, off = wgid / NXCD; wgid = (xcd < r ? xcd * (q + 1) : r * (q + 1) + (xcd - r) * q) + off; }
        const int nig = WGM * nN, gid = wgid / nig, fm = gid * WGM, gsz = (nM - fm) < WGM ? (nM - fm) : WGM;
        u.pm = fm + ((wgid % nig) % gsz); u.pn = (wgid % nig) / gsz; return true;
    }
    __device__ __forceinline__ void a_ready(const Unit&) const {}
    __device__ __forceinline__ void done(const Unit&) const {}
};

__device__ __forceinline__ unsigned cvt_pk_bf16(float lo, float hi) { unsigned r; asm volatile("v_cvt_pk_bf16_f32 %0, %1, %2" : "=v"(r) : "v"(lo), "v"(hi)); return r; }
typedef float f32x2 __attribute__((ext_vector_type(2)));

__device__ __forceinline__ float fast_sigmoid(float x) { return __builtin_amdgcn_rcpf(1.0f + __builtin_amdgcn_exp2f(-1.4426950408889634f * x)); }
__device__ __forceinline__ float gelu_tanh(float x) { const float u = 0.7978845608028654f * (x + 0.044715f * x * x * x); return x * fast_sigmoid(2.0f * u); }
struct EpiBf16Plain {
    static constexpr bool PERM = true, AFTER_DRAIN = false, BIAS_INIT = false;
    bf16_t* O; int ldc; int gelu_pn_lt; float oscale;
    __device__ __forceinline__ void operator()(const f32x4 (&acc)[2][2][4][2], const Unit& u, int wr, int wc, int fr, int fq) const {
        const int row0 = u.pm * BM + wr * 64 + fr, col0 = u.pn * BM + wc * 32 + 8 * fq; const bool g = u.pn < gelu_pn_lt;
#pragma unroll
        for (int ai = 0; ai < 2; ++ai)
#pragma unroll
            for (int m = 0; m < 4; ++m) { bf16_t* rowp = O + (size_t)(row0 + ai * HALF + m * 16) * ldc + col0;
#pragma unroll
                for (int bj = 0; bj < 2; ++bj) { f32x4 v0 = acc[ai][bj][m][0] * oscale, v1 = acc[ai][bj][m][1] * oscale;
                    if (g) {
#pragma unroll
                        for (int q = 0; q < 4; ++q) { v0[q] = gelu_tanh(v0[q]); v1[q] = gelu_tanh(v1[q]); } }
                    u32x4 w; w.x = cvt_pk_bf16(v0[0], v0[1]); w.y = cvt_pk_bf16(v0[2], v0[3]); w.z = cvt_pk_bf16(v1[0], v1[1]); w.w = cvt_pk_bf16(v1[2], v1[3]);
                    *(u32x4*)(rowp + bj * HALF) = w; } }
    }
};
struct EpiSwiglu {
    static constexpr bool PERM = true, AFTER_DRAIN = false, BIAS_INIT = true;
    bf16_t* act; const PG8_LAS float* bl;
    __device__ __forceinline__ void bias_init(f32x4 (&b)[2][2], const Unit& u, int wc, int fq) const { const PG8_LAS float* bp = bl + u.ui * 256 + wc * 32 + 8 * fq;
#pragma unroll
        for (int bj = 0; bj < 2; ++bj)
#pragma unroll
            for (int n = 0; n < 2; ++n) b[bj][n] = *(const PG8_LAS f32x4*)(bp + bj * HALF + 4 * n); }
    __device__ __forceinline__ void operator()(const f32x4 (&acc)[2][2][4][2], const Unit& u, int wr, int wc, int fr, int fq) const {
        const int nt = u.pn & 7; const int row0 = u.pm * BM + wr * 64 + fr, cl = wc * 32 + 8 * fq, colo = nt * 128 + cl;
#pragma unroll
        for (int ai = 0; ai < 2; ++ai)
#pragma unroll
            for (int m = 0; m < 4; ++m) { unsigned char* rowp = (unsigned char*)act + (size_t)(row0 + ai * HALF + m * 16) * 1024 + colo;
                float o[8];
#pragma unroll
                for (int n = 0; n < 2; ++n) { const f32x4 G = acc[ai][0][m][n], U = acc[ai][1][m][n]; f32x4 gc, uc, ex, r;
#pragma unroll
                    for (int q = 0; q < 4; ++q) { gc[q] = __builtin_amdgcn_fmed3f(G[q], -3.0e38f, 224.0f); uc[q] = __builtin_amdgcn_fmed3f(U[q], -192.0f, 256.0f); }
                    const f32x4 ea = gc * -0.07673331611f + 10.0f;
#pragma unroll
                    for (int q = 0; q < 4; ++q) ex[q] = __builtin_amdgcn_exp2f(ea[q]);
                    const f32x4 den = ex + 1024.0f;
#pragma unroll
                    for (int q = 0; q < 4; ++q) r[q] = __builtin_amdgcn_rcpf(den[q]);
                    const f32x4 o4 = uc * gc * r;
#pragma unroll
                    for (int q = 0; q < 4; ++q) o[n * 4 + q] = o4[q]; }
                int p0 = 0, p1 = 0; p0 = __builtin_amdgcn_cvt_pk_fp8_f32(o[0], o[1], p0, false); p0 = __builtin_amdgcn_cvt_pk_fp8_f32(o[2], o[3], p0, true); p1 = __builtin_amdgcn_cvt_pk_fp8_f32(o[4], o[5], p1, false); p1 = __builtin_amdgcn_cvt_pk_fp8_f32(o[6], o[7], p1, true);
                typedef unsigned u32x2_ __attribute__((ext_vector_type(2))); *(u32x2_*)rowp = (u32x2_){(unsigned)p0, (unsigned)p1}; }
    }
};
struct EpiDown {
    static constexpr bool PERM = true, AFTER_DRAIN = false, BIAS_INIT = true;
    bf16_t* yb; const PG8_LAS unsigned* rt; const PG8_LAS float* bl;
    __device__ __forceinline__ void bias_init(f32x4 (&b)[2][2], const Unit& u, int wc, int fq) const { const PG8_LAS float* bp = bl + u.ui * 256 + wc * 32 + 8 * fq;
#pragma unroll
        for (int bj = 0; bj < 2; ++bj)
#pragma unroll
            for (int n = 0; n < 2; ++n) b[bj][n] = *(const PG8_LAS f32x4*)(bp + bj * HALF + 4 * n); }
    __device__ __forceinline__ void operator()(const f32x4 (&acc)[2][2][4][2], const Unit& u, int wr, int wc, int fr, int fq) const {
        const int nt = u.pn & 3; const int cl = wc * 32 + 8 * fq, col0 = nt * 256 + cl;
        typedef unsigned u32x2_ __attribute__((ext_vector_type(2)));
        const PG8_LAS unsigned* rp = rt + (u.ui * 256 + wr * 64 + fr) * 2;
#pragma unroll
        for (int ai = 0; ai < 2; ++ai)
#pragma unroll
            for (int m = 0; m < 4; ++m) { const u32x2_ iw = *(const PG8_LAS u32x2_*)(rp + (ai * HALF + m * 16) * 2); const int info = (int)iw.x; const float w = __uint_as_float(iw.y);
                if (info >= 0) { unsigned char* rowp = (unsigned char*)yb + (size_t)info * 1024 + col0;
#pragma unroll
                    for (int bj = 0; bj < 2; ++bj) {
                        const f32x4 v0 = acc[ai][bj][m][0] * w, v1 = acc[ai][bj][m][1] * w;
                        f32x4 c0, c1;
#pragma unroll
                        for (int q_ = 0; q_ < 4; ++q_) { c0[q_] = __builtin_amdgcn_fmed3f(v0[q_], -440.f, 440.f); c1[q_] = __builtin_amdgcn_fmed3f(v1[q_], -440.f, 440.f); }
                        int q0 = 0, q1 = 0; q0 = __builtin_amdgcn_cvt_pk_fp8_f32(c0[0], c0[1], q0, false); q0 = __builtin_amdgcn_cvt_pk_fp8_f32(c0[2], c0[3], q0, true); q1 = __builtin_amdgcn_cvt_pk_fp8_f32(c1[0], c1[1], q1, false); q1 = __builtin_amdgcn_cvt_pk_fp8_f32(c1[2], c1[3], q1, true);
                        *(u32x2_*)(rowp + bj * HALF) = (u32x2_){(unsigned)q0, (unsigned)q1}; } } }
    }
};
struct EpiRgGate {
    static constexpr bool PERM = false, AFTER_DRAIN = false, BIAS_INIT = false;
    unsigned* AU; const bf16_t* xc; const float* brg; const float* big; const float* lam;
    __device__ __forceinline__ void operator()(const f32x4 (&acc)[2][2][4][2], const Unit& u, int wr, int wc, int fr, int fq) const {
        const int row0 = u.pm * BM + wr * 64 + fr, ch0 = u.pn * 128 + wc * 32 + 4 * fq;
        unsigned long long xw[2][2][4];
#pragma unroll
        for (int n = 0; n < 2; ++n)
#pragma unroll
            for (int ai = 0; ai < 2; ++ai)
#pragma unroll
                for (int m = 0; m < 4; ++m) xw[n][ai][m] = *(const unsigned long long*)(xc + (size_t)(row0 + ai * HALF + m * 16) * 1280 + ch0 + 16 * n);
#pragma unroll
        for (int n = 0; n < 2; ++n) { const int ch = ch0 + 16 * n;
            const f32x4 br = *(const f32x4*)(brg + ch), bi = *(const f32x4*)(big + ch), lm = *(const f32x4*)(lam + ch); f32x4 sp;
#pragma unroll
            for (int q = 0; q < 4; ++q) sp[q] = lm[q] < -20.f ? -lm[q] : log1pf(__expf(-lm[q]));
#pragma unroll
            for (int ai = 0; ai < 2; ++ai)
#pragma unroll
                for (int m = 0; m < 4; ++m) { const size_t row = (size_t)(row0 + ai * HALF + m * 16);
                    const unsigned long long xq = xw[n][ai][m];
                    const float xv[4] = {__uint_as_float((unsigned)xq << 16), __uint_as_float((unsigned)xq & 0xffff0000u), __uint_as_float((unsigned)(xq >> 32) << 16), __uint_as_float((unsigned)(xq >> 32) & 0xffff0000u)};
                    u32x4 au;
#pragma unroll
                    for (int q = 0; q < 4; ++q) { const float rr = fast_sigmoid(acc[ai][0][m][n][q] + br[q]), ii = fast_sigmoid(acc[ai][1][m][n][q] + bi[q]); const float la = -8.0f * rr * sp[q];
                        const float x2 = 2.0f * la; const float om = x2 > -0.01f ? -x2 * (1.0f + x2 * (0.5f + x2 * 0.16666667f)) : 1.0f - __expf(x2);
                        au[q] = cvt_pk_bf16(la, __builtin_amdgcn_sqrtf(om) * (ii * xv[q])); }
                    *(u32x4*)(AU + row * 1280 + ch) = au; } }
    }
};
struct ListOrder {
    const PG8_LAS unsigned* list; int n;
    __device__ __forceinline__ bool next(int i, Unit& u) const { if (i >= n) return false; const unsigned v = (unsigned)__builtin_amdgcn_readfirstlane((int)list[i]); u.pm = (int)(v & 0xffffu); u.pn = (int)(v >> 16); u.ui = i; return true; }
    __device__ __forceinline__ void a_ready(const Unit&) const {}
    __device__ __forceinline__ void done(const Unit&) const {}
};
template <class Epi, class Sched, bool ALIGN_EPI = false, bool SP2 = false, bool GATHER = false, bool FP8 = false>
__device__ __forceinline__ void gemm_phase(PG8_LAS unsigned char* lds, const Gemm g, const Sched& S, const Epi& E, const PG8_LAS unsigned* gtab = nullptr) {
    const int tid = my_tid(), wid = __builtin_amdgcn_readfirstlane(tid >> 6), lane = tid & 63, wr = wid >> 2, wc = wid & 3, fr = lane & 15, fq = lane >> 4;
    const int K = g.K, nt = K / BK;
    unsigned voffA[2], voffB[2];
#pragma unroll
    for (int i = 0; i < 2; ++i) { int R, C; stage_rc(tid * 16 + i * 8192, R, C); const int Rb = Epi::PERM ? ((R & ~31) + perm32(R & 31)) : R;
        voffA[i] = (unsigned)(R * g.lda + C) * 2u; voffB[i] = (unsigned)(Rb * K + C) * 2u; }
    const size_t kstep = (size_t)(BK * 2);
    const size_t hstepA = (size_t)HALF * g.lda * 2, hstepB = (size_t)HALF * K * 2;
    const size_t tstepA = 2 * hstepA, tstepB = 2 * hstepB;
    const unsigned ldsw = (unsigned)wid * 1024u;
    const int aoff = lds_byte(wr * 64 + fr, fq * 8), boff = lds_byte(wc * 32 + fr, fq * 8);
#define PG8_SA(b, h) (((b) * 2 + (h)) * HTB)
#define PG8_SB(b, h) ((4 + (b) * 2 + (h)) * HTB)
#define PG8_STAGE(bufoff, gbase, voff) do { _Pragma("unroll") for (int _i = 0; _i < 2; ++_i) { unsigned o_ = (voff)[_i]; asm volatile("" : "+v"(o_));     \
        __builtin_amdgcn_global_load_lds((const unsigned*)((const char*)(gbase) + o_), (PG8_LAS unsigned*)(lds + (bufoff) + ldsw + _i * 8192), 16, 0, 0); } } while (0)
#define PG8_LDA(dst, b, h) do { _Pragma("unroll") for (int m = 0; m < 4; ++m) { dst[m].lo = *(const PG8_LAS bf16x8*)(lds + PG8_SA(b, h) + aoff + m * 2048); dst[m].hi = *(const PG8_LAS bf16x8*)(lds + PG8_SA(b, h) + aoff + m * 2048 + 1024); } } while (0)
#define PG8_LDB(dst, b, h) do { _Pragma("unroll") for (int n = 0; n < 2; ++n) { dst[n].lo = *(const PG8_LAS bf16x8*)(lds + PG8_SB(b, h) + boff + n * 2048); dst[n].hi = *(const PG8_LAS bf16x8*)(lds + PG8_SB(b, h) + boff + n * 2048 + 1024); } } while (0)
#define PG8_MMA(ai, bj, At, Bt) do { __builtin_amdgcn_s_setprio(1); \
        if constexpr (FP8) { typedef int v8i_ __attribute__((ext_vector_type(8))); \
            _Pragma("unroll") for (int m = 0; m < 4; ++m) _Pragma("unroll") for (int n = 0; n < 2; ++n) \
                acc[ai][bj][m][n] = __builtin_amdgcn_mfma_scale_f32_16x16x128_f8f6f4(__builtin_bit_cast(v8i_, Bt[n]), __builtin_bit_cast(v8i_, At[m]), acc[ai][bj][m][n], 0, 0, 0, 0, 0, 0);     \
        } else { _Pragma("unroll") for (int m = 0; m < 4; ++m) _Pragma("unroll") for (int n = 0; n < 2; ++n) { \
            acc[ai][bj][m][n] = __builtin_amdgcn_mfma_f32_16x16x32_bf16(Bt[n].lo, At[m].lo, acc[ai][bj][m][n], 0, 0, 0); \
            acc[ai][bj][m][n] = __builtin_amdgcn_mfma_f32_16x16x32_bf16(Bt[n].hi, At[m].hi, acc[ai][bj][m][n], 0, 0, 0); } } __builtin_amdgcn_s_setprio(0); } while (0)
#define PG8_WAIT_V(n) asm volatile("s_waitcnt vmcnt(" #n ")" ::: "memory")
#define PG8_WAIT_L(n) asm volatile("s_waitcnt lgkmcnt(" #n ")" ::: "memory")
#define PG8_BAR __builtin_amdgcn_s_barrier()
#define PG8_SCHED __builtin_amdgcn_sched_barrier(0)
    Unit cur, nxt; int ui = 0;
    if (!S.next(0, cur)) return;
    f32x4 acc[2][2][4][2];
#define PG8_ACC_INIT(unit_) do { f32x4 i_[2][2]; if constexpr (Epi::BIAS_INIT) { int t3_ = (int)threadIdx.x; asm volatile("" : "+v"(t3_)); E.bias_init(i_, unit_, wc, (t3_ & 63) >> 4); } \
        else { _Pragma("unroll") for (int b = 0; b < 2; ++b) _Pragma("unroll") for (int n = 0; n < 2; ++n) i_[b][n] = (f32x4){0.f, 0.f, 0.f, 0.f}; } \
        _Pragma("unroll") for (int a = 0; a < 2; ++a) _Pragma("unroll") for (int b = 0; b < 2; ++b) _Pragma("unroll") for (int m = 0; m < 4; ++m) _Pragma("unroll") for (int n = 0; n < 2; ++n) acc[a][b][m][n] = i_[b][n]; } while (0)
    PG8_ACC_INIT(cur);
    typedef short bf16x16 __attribute__((ext_vector_type(16)));
    bf16x16 At[4], B0[2], B1[2];
    const char* cA = GATHER ? (const char*)g.A : (const char*)g.A + (size_t)cur.pm * tstepA + (size_t)cur.pn * g.a_pn_stride;
    unsigned gvc[2][2];
#define PG8_GLOAD(dst, ui_) do { int t_ = (int)threadIdx.x; asm volatile("" : "+v"(t_));     \
        _Pragma("unroll") for (int i_ = 0; i_ < 2; ++i_) { int R_, C_; stage_rc(t_ * 16 + i_ * 8192, R_, C_); \
            _Pragma("unroll") for (int h_ = 0; h_ < 2; ++h_) dst[h_][i_] = gtab[(ui_) * 256 + h_ * HALF + R_] + (unsigned)C_ * 2u; } } while (0)
#define PG8_AH(p, h) (GATHER ? (p) : (p) + (h) * hstepA)
    if constexpr (GATHER) { PG8_GLOAD(gvc, 0); }
    else { _Pragma("unroll") for (int h_ = 0; h_ < 2; ++h_) _Pragma("unroll") for (int i_ = 0; i_ < 2; ++i_) gvc[h_][i_] = voffA[i_]; }
    const char* cB = (const char*)g.Bt + (size_t)cur.pn * tstepB;
    S.a_ready(cur);
    if constexpr (SP2) {
        PG8_STAGE(PG8_SB(0, 0), cB, voffB); PG8_STAGE(PG8_SB(0, 1), cB + hstepB, voffB); PG8_STAGE(PG8_SA(0, 0), cA, gvc[0]); PG8_STAGE(PG8_SA(0, 1), PG8_AH(cA, 1), gvc[1]);
        if (wr == 1) PG8_BAR;
        PG8_WAIT_V(2); PG8_BAR;
        PG8_STAGE(PG8_SB(1, 0), cB + kstep, voffB); PG8_STAGE(PG8_SA(1, 0), cA + kstep, gvc[0]); PG8_STAGE(PG8_SB(1, 1), cB + hstepB + kstep, voffB);
        PG8_WAIT_V(6); PG8_BAR;
    } else {
        PG8_STAGE(PG8_SB(0, 0), cB, voffB); PG8_STAGE(PG8_SA(0, 0), cA, gvc[0]); PG8_STAGE(PG8_SB(0, 1), cB + hstepB, voffB); PG8_STAGE(PG8_SA(0, 1), PG8_AH(cA, 1), gvc[1]);
        if (wr == 1) PG8_BAR;
        PG8_WAIT_V(4); PG8_BAR;
        PG8_STAGE(PG8_SB(1, 0), cB + kstep, voffB); PG8_STAGE(PG8_SA(1, 0), cA + kstep, gvc[0]); PG8_STAGE(PG8_SB(1, 1), cB + hstepB + kstep, voffB);
        PG8_WAIT_V(6); PG8_BAR;
    }
    for (;;) {
        const bool has_next = S.next(ui + 1, nxt);
        const char* nA = GATHER ? cA : (has_next ? (const char*)g.A + (size_t)nxt.pm * tstepA + (size_t)nxt.pn * g.a_pn_stride : cA);
        const char* nB = has_next ? (const char*)g.Bt + (size_t)nxt.pn * tstepB : cB;
        for (int t = 0; t < nt; t += 2) {
            const bool last = (t == nt - 2);
            const char* a1 = cA + (size_t)(t + 1) * kstep;
            const char* a2 = last ? (GATHER ? (const char*)g.A : nA) : cA + (size_t)(t + 2) * kstep; const char* b2 = last ? nB : cB + (size_t)(t + 2) * kstep;
            const char* a3 = a2 + kstep; const char* b3 = b2 + kstep;
            if (last && has_next) S.a_ready(nxt);
            if constexpr (SP2) {
            PG8_LDB(B0, 0, 0); PG8_LDB(B1, 0, 1); PG8_SCHED; PG8_LDA(At, 0, 0); PG8_STAGE(PG8_SA(1, 1), PG8_AH(a1, 1), gvc[1]); if constexpr (GATHER) { if (last && has_next) PG8_GLOAD(gvc, ui + 1); }
            PG8_WAIT_V(8); PG8_WAIT_L(0); PG8_BAR; PG8_MMA(0, 0, At, B0); PG8_MMA(0, 1, At, B1); PG8_BAR; PG8_SCHED;
            PG8_LDA(At, 0, 1); PG8_STAGE(PG8_SB(0, 0), b2, voffB); PG8_STAGE(PG8_SB(0, 1), b2 + hstepB, voffB); PG8_STAGE(PG8_SA(0, 0), a2, gvc[0]);
            PG8_WAIT_V(8); PG8_WAIT_L(0); PG8_BAR; PG8_MMA(1, 0, At, B0); PG8_MMA(1, 1, At, B1); PG8_BAR; PG8_SCHED;
            PG8_LDB(B0, 1, 0); PG8_LDB(B1, 1, 1); PG8_SCHED; PG8_LDA(At, 1, 0); PG8_STAGE(PG8_SA(0, 1), PG8_AH(a2, 1), gvc[1]);
            PG8_WAIT_V(8); PG8_WAIT_L(0); PG8_BAR; PG8_MMA(0, 0, At, B0); PG8_MMA(0, 1, At, B1); PG8_BAR; PG8_SCHED;
            PG8_LDA(At, 1, 1); PG8_STAGE(PG8_SB(1, 0), b3, voffB); PG8_STAGE(PG8_SB(1, 1), b3 + hstepB, voffB); PG8_STAGE(PG8_SA(1, 0), a3, gvc[0]);
            PG8_WAIT_V(8); PG8_WAIT_L(0); PG8_BAR; PG8_MMA(1, 0, At, B0); PG8_MMA(1, 1, At, B1); PG8_BAR; PG8_SCHED;
            } else {
            PG8_LDB(B0, 0, 0); PG8_SCHED; PG8_LDA(At, 0, 0); PG8_STAGE(PG8_SA(1, 1), PG8_AH(a1, 1), gvc[1]); if constexpr (GATHER) { if (last && has_next) PG8_GLOAD(gvc, ui + 1); }
            PG8_WAIT_L(8); PG8_BAR; PG8_WAIT_L(0); PG8_MMA(0, 0, At, B0); PG8_BAR; PG8_SCHED;
            PG8_LDB(B1, 0, 1); PG8_STAGE(PG8_SB(0, 0), b2, voffB);
            PG8_BAR; PG8_WAIT_L(0); PG8_MMA(0, 1, At, B1); PG8_BAR;
            PG8_LDA(At, 0, 1); PG8_STAGE(PG8_SA(0, 0), a2, gvc[0]);
            PG8_BAR; PG8_WAIT_L(0); PG8_MMA(1, 0, At, B0); PG8_BAR; PG8_SCHED;
            PG8_STAGE(PG8_SB(0, 1), b2 + hstepB, voffB);
            PG8_WAIT_V(6); PG8_BAR; PG8_MMA(1, 1, At, B1); PG8_BAR;
            PG8_LDB(B0, 1, 0); PG8_SCHED; PG8_LDA(At, 1, 0); PG8_STAGE(PG8_SA(0, 1), PG8_AH(a2, 1), gvc[1]);
            PG8_WAIT_L(8); PG8_BAR; PG8_WAIT_L(0); PG8_MMA(0, 0, At, B0); PG8_BAR; PG8_SCHED;
            PG8_LDB(B1, 1, 1); PG8_STAGE(PG8_SB(1, 0), b3, voffB);
            PG8_BAR; PG8_WAIT_L(0); PG8_MMA(0, 1, At, B1); PG8_BAR;
            PG8_LDA(At, 1, 1); PG8_STAGE(PG8_SA(1, 0), a3, gvc[0]);
            PG8_BAR; PG8_WAIT_L(0); PG8_MMA(1, 0, At, B0); PG8_BAR; PG8_SCHED;
            PG8_STAGE(PG8_SB(1, 1), b3 + hstepB, voffB);
            PG8_WAIT_V(6); PG8_BAR; PG8_MMA(1, 1, At, B1); PG8_BAR;
            }
        }
        if constexpr (ALIGN_EPI) { if (wr == 0) PG8_BAR; }
        if constexpr (!Epi::AFTER_DRAIN) { int t2_ = (int)threadIdx.x; asm volatile("" : "+v"(t2_));
            const int l2_ = t2_ & 63; E(acc, cur, wr, wc, l2_ & 15, l2_ >> 4); S.done(cur); }
        if (!has_next) break;
        cur = nxt; cA = nA; cB = nB; ++ui;
        PG8_ACC_INIT(cur);

        if constexpr (ALIGN_EPI) { if (wr == 1) PG8_BAR; }
    }
    PG8_WAIT_V(0);
    if constexpr (!ALIGN_EPI) { if (wr == 0) PG8_BAR; }
    PG8_BAR;
    if constexpr (Epi::AFTER_DRAIN) { E.fused(acc, cur, wr, wc, fr, fq, lds, wid, lane); S.done(cur); }
#undef PG8_GLOAD
#undef PG8_ACC_INIT
#undef PG8_AH
#undef PG8_SA
#undef PG8_SB
#undef PG8_STAGE
#undef PG8_LDA
#undef PG8_LDB
#undef PG8_MMA
#undef PG8_WAIT_V
#undef PG8_WAIT_L
#undef PG8_BAR
#undef PG8_SCHED
}
}

constexpr int NB = 4, SEQ = 4096, D = 1024, T = NB * SEQ;
constexpr float ALPHA = 1.681792830507429f;
constexpr float LN_EPS = 1e-5f;
constexpr int NE = 32;
constexpr int NPAD_MAX = T * 4 + NE * 256;
constexpr float LOG2E = 1.4426950408889634f;
constexpr float FOX_C2 = 0.125f * LOG2E;

constexpr size_t KiB = 1024, MiB = 1u << 20;
constexpr size_t WS_CTL = 0, CTL_ZERO_BYTES = 320 * KiB;
constexpr size_t WS_MOD = 1 * MiB;
constexpr size_t WS_SMALL = 2 * MiB;
constexpr size_t WS_TKE = 3 * MiB, WS_TKP = 3 * MiB + 256 * KiB, WS_TKW = 3 * MiB + 512 * KiB;
constexpr size_t WS_ROWINFO = 4 * MiB, WS_ROWW = 4 * MiB + 512 * KiB;
constexpr size_t WS_BGUP = 5 * MiB;
constexpr size_t WS_DCUM = 6 * MiB;
constexpr size_t WS_SCAN = 7 * MiB;
constexpr size_t WS_ELIST = 10 * MiB, WS_EWT = 12 * MiB;
constexpr size_t WS_X = 16 * MiB;
constexpr size_t WS_H = 80 * MiB;
constexpr size_t WS_Y = 112 * MiB;
constexpr size_t WS_PROJ = 176 * MiB;
constexpr size_t WS_CORE = 304 * MiB;
constexpr size_t WS_MIX = 352 * MiB;
constexpr size_t WS_XG = 512 * MiB;
constexpr size_t WS_ACT = 656 * MiB;
constexpr size_t WS_YB = 800 * MiB;
constexpr size_t WS_WT = 1024 * MiB;
constexpr size_t WT_GLA_IN = WS_WT, WT_GLA_OUT = WT_GLA_IN + 12 * MiB, WT_RG_IN = WT_GLA_OUT + 4 * MiB, WT_RG_OUT = WT_RG_IN + 5 * MiB,
                 WT_FOX_IN = WT_RG_OUT + 3 * MiB, WT_FOX_OUT = WT_FOX_IN + 8 * MiB, WT_RG_G = WT_FOX_OUT + 2 * MiB, WT_GU = WT_RG_G + 2 * MiB, WT_DN = WT_GU + 512 * MiB, WS_END = WT_DN + 256 * MiB;
constexpr int CW_TMO = 0, CW_BAR = 4096, CW_CNT = 16384, CW_GLA = 20480;

constexpr int RING_BYTES = 131072, CTRL_OFF = 135168, LDS_BYTES = 163840;
constexpr int L_MISC = CTRL_OFF, L_TS = CTRL_OFF + 64, L_CNT = CTRL_OFF + 256, L_ULIST = CTRL_OFF + 512, L_NU = CTRL_OFF + 1024, L_VEC = CTRL_OFF + 2048, L_RLIST = CTRL_OFF + 2048 + 20480;

#define GAS __attribute__((address_space(1)))
#define LAS __attribute__((address_space(3)))
typedef unsigned short bf16;
typedef unsigned v4u __attribute__((ext_vector_type(4)));
typedef unsigned v2u __attribute__((ext_vector_type(2)));
typedef float f32x4 __attribute__((ext_vector_type(4)));
typedef float f32x2 __attribute__((ext_vector_type(2)));
typedef __bf16 bf16x2_t __attribute__((ext_vector_type(2)));
#define LDS_WAIT() asm volatile("s_waitcnt lgkmcnt(0)" ::: "memory")
#define LDS_BARRIER() asm volatile("s_waitcnt lgkmcnt(0)\n\ts_barrier" ::: "memory")
#define VM_WAIT() asm volatile("s_waitcnt vmcnt(0)" ::: "memory")
#define RLX_AGENT __ATOMIC_RELAXED, __HIP_MEMORY_SCOPE_AGENT
__device__ __forceinline__ float bf2f(bf16 v) { return __uint_as_float((unsigned)v << 16); }
__device__ __forceinline__ float bflo(unsigned w) { return __uint_as_float(w << 16); }
__device__ __forceinline__ float bfhi(unsigned w) { return __uint_as_float(w & 0xffff0000u); }
__device__ __forceinline__ unsigned pk2(float lo, float hi) { f32x2 v = {lo, hi}; bf16x2_t b = __builtin_convertvector(v, bf16x2_t); return __builtin_bit_cast(unsigned, b); }
__device__ __forceinline__ unsigned pk4_fp8(float a, float b, float c, float d) { int p = 0; p = __builtin_amdgcn_cvt_pk_fp8_f32(a, b, p, false); p = __builtin_amdgcn_cvt_pk_fp8_f32(c, d, p, true); return (unsigned)p; }
__device__ __forceinline__ bf16 f2bf(float f) { return (bf16)(pk2(f, 0.f) & 0xffffu); }
template <int CTRL> __device__ __forceinline__ float dpp_f(float v) { return __builtin_bit_cast(float, __builtin_amdgcn_update_dpp(0, __builtin_bit_cast(int, v), CTRL, 0xf, 0xf, true)); }
__device__ __forceinline__ float wave_sum(float v) {
    v += dpp_f<0xB1>(v); v += dpp_f<0x4E>(v); v += dpp_f<0x141>(v); v += dpp_f<0x140>(v);
    const float s0 = __builtin_bit_cast(float, __builtin_amdgcn_readlane(__builtin_bit_cast(int, v), 0)), s1 = __builtin_bit_cast(float, __builtin_amdgcn_readlane(__builtin_bit_cast(int, v), 16)),
                s2 = __builtin_bit_cast(float, __builtin_amdgcn_readlane(__builtin_bit_cast(int, v), 32)), s3 = __builtin_bit_cast(float, __builtin_amdgcn_readlane(__builtin_bit_cast(int, v), 48));
    return (s0 + s1) + (s2 + s3);
}
__device__ __forceinline__ float sigmoidf_(float x) { return __builtin_amdgcn_rcpf(1.0f + __expf(-x)); }
__device__ __forceinline__ float logsigmoidf_(float x) { return fminf(x, 0.f) - log1pf(__expf(-fabsf(x))); }

#define XB_TMO      128
#define XB_XCNT(j)  (256  + 64 * (j))
#define XB_XSUB(j)  (1280 + 64 * (j))
#define XB_XGEN(j)  (2304 + 64 * (j))
#define XB_TOP      3328
#define XB_TOPGEN   3392
#define XCD_BAR_WORDS 3456
#define XB_SPIN_CAP (1u << 18)

__device__ __forceinline__ unsigned xb_ld(unsigned* p)              { return __hip_atomic_load(p, __ATOMIC_RELAXED, __HIP_MEMORY_SCOPE_AGENT); }
__device__ __forceinline__ unsigned xb_add(unsigned* p, unsigned v) { return __hip_atomic_fetch_add(p, v, __ATOMIC_RELAXED, __HIP_MEMORY_SCOPE_AGENT); }
__device__ __forceinline__ unsigned xb_xcc_id() { return (unsigned)__builtin_amdgcn_s_getreg((3 << 11) | 20) & 0xFu; }
#define XB_SPIN(cond, bar) do { unsigned _sp = 0; while (cond) { __builtin_amdgcn_s_sleep(1); \
    if ((++_sp & 255u) == 0u) { if (xb_ld(&(bar)[XB_TMO])) break; if (_sp > XB_SPIN_CAP) { atomicAdd(&(bar)[XB_TMO], 1u); break; } } } } while (0)

struct XcdBarrier {
    unsigned* bar; unsigned x;
    volatile LAS unsigned* st;
};

__device__ __forceinline__ XcdBarrier xcd_barrier_post(unsigned* bar, volatile LAS unsigned* st) {
    XcdBarrier b; b.bar = bar; b.x = xb_xcc_id(); b.st = st;
    if (threadIdx.x == 0) (void)xb_add(&bar[XB_XCNT(b.x)], 1u);
    return b;
}
__device__ __forceinline__ void xcd_barrier_complete(unsigned* bar, unsigned x, unsigned& nloc, unsigned& nx) {
    const unsigned G = gridDim.x * gridDim.y * gridDim.z;
    unsigned sum, cnt, mine, sp = 0u;
    for (;;) {
        sum = 0u; cnt = 0u; mine = 0u;
#pragma unroll
        for (unsigned j = 0; j < 16; ++j) { const unsigned c = xb_ld(&bar[XB_XCNT(j)]); sum += c; cnt += (c > 0u) ? 1u : 0u; mine = (j == x) ? c : mine; }
        if (sum == G) break;
        __builtin_amdgcn_s_sleep(1);
        if ((++sp & 255u) == 0u) { if (xb_ld(&bar[XB_TMO])) break; if (sp > XB_SPIN_CAP) { atomicAdd(&bar[XB_TMO], 1u); break; } }
    }
    nloc = mine > 0u ? mine : 1u; nx = cnt > 0u ? cnt : 1u;
}

__device__ __forceinline__ void xcd_barrier(const XcdBarrier& b) {
    asm volatile("s_waitcnt vmcnt(0)" ::: "memory");
    __syncthreads();
    if (threadIdx.x == 0) {
        unsigned* bar = b.bar;
        __builtin_amdgcn_s_waitcnt(0);
        unsigned nloc = b.st[0], nx = b.st[1];
        if (nloc == 0u) { xcd_barrier_complete(bar, b.x, nloc, nx); b.st[0] = nloc; b.st[1] = nx; }
        const unsigned old = xb_add(&bar[XB_XSUB(b.x)], 1u);
        const unsigned gen = old / nloc;
        if (old + 1u == (gen + 1u) * nloc) {
            __builtin_amdgcn_fence(__ATOMIC_RELEASE, "agent");
            asm volatile("s_waitcnt vmcnt(0)" ::: "memory");
            const unsigned og = xb_add(&bar[XB_TOP], 1u);
            const unsigned tg = og / nx;
            if (og + 1u == (tg + 1u) * nx) xb_add(&bar[XB_TOPGEN], 1u);
            else XB_SPIN(xb_ld(&bar[XB_TOPGEN]) == tg, bar);
            __builtin_amdgcn_fence(__ATOMIC_ACQUIRE, "agent");
            xb_add(&bar[XB_XGEN(b.x)], 1u);
            asm volatile("s_waitcnt vmcnt(0)" ::: "memory");
        } else {
            XB_SPIN(xb_ld(&bar[XB_XGEN(b.x)]) == gen, bar);
            __builtin_amdgcn_fence(__ATOMIC_ACQUIRE, "agent");
            asm volatile("s_waitcnt vmcnt(0)" ::: "memory");
        }
    }
    __syncthreads();
}

struct Params { const float* in[31]; float* out; unsigned char* ws; int ph_lo, ph_hi, use_bar, pad; };
enum { I_X = 0, I_C, I_ADA_W, I_ADA_B, I_LN_G, I_LN_B, I_GLA_WIN, I_GLA_WGU, I_GLA_BG, I_GLA_NG, I_GLA_WOUT, I_RG_WIN, I_RG_CW, I_RG_CB, I_RG_WRG, I_RG_BRG,
       I_RG_WIG, I_RG_BIG, I_RG_LAM, I_RG_WOUT, I_FOX_WIN, I_FOX_BF, I_FOX_QG, I_FOX_KG, I_FOX_WOUT, I_MOE_WR, I_MOE_BR, I_MOE_WGU, I_MOE_BGU, I_MOE_WDN, I_MOE_BDN };

__device__ __forceinline__ const float* kin(int i) {
    const char __attribute__((address_space(4)))* ka = (const char __attribute__((address_space(4)))*)__builtin_amdgcn_kernarg_segment_ptr();
    int off = i * 8; asm volatile("" : "+s"(off));
    return *(const float* const __attribute__((address_space(4)))*)(ka + off);
}
__device__ __forceinline__ void tr_item(const float* W, int ldw, int c0, int k0, bf16* WT, int ldt, int mode, LAS float* scr, int lane) {
#pragma unroll
    for (int i4 = 0; i4 < 16; ++i4) { const int kk = 4 * i4 + (lane >> 4);
        __builtin_amdgcn_global_load_lds((const unsigned*)(W + (size_t)(k0 + kk) * ldw + c0 + 4 * ((lane & 15) ^ ((kk >> 3) & 7))), (LAS unsigned*)(scr + i4 * 256), 16, 0, 2); }
    asm volatile("s_waitcnt vmcnt(0)" ::: "memory");
    const int c8 = lane & 7;
#pragma unroll
    for (int jj = 0; jj < 8; ++jj) { const int n = (lane >> 3) + 8 * jj, c = c0 + n;
        const int drow = mode == 0 ? c : (mode == 1 ? ((c >> 8) * 256 + (c & 1) * 128 + ((c >> 1) & 127)) : (c < 3072 ? c : c - 16));
        const LAS float* src = scr + (8 * c8) * 64 + 4 * ((n >> 2) ^ c8) + (n & 3);
        float f[8];
#pragma unroll
        for (int i = 0; i < 8; ++i) f[i] = src[i * 64];
        v4u o; o.x = pk2(f[0], f[1]); o.y = pk2(f[2], f[3]); o.z = pk2(f[4], f[5]); o.w = pk2(f[6], f[7]);
        *(v4u*)(WT + (size_t)drow * ldt + k0 + 8 * c8) = o; }
    LDS_WAIT(); asm volatile("" ::: "memory");
}
__device__ __forceinline__ void tr_item8(const float* W, int ldw, int c0, int k0, unsigned char* WT8, int ldt, int mode, float sc, LAS float* scr, int lane) {
#pragma unroll
    for (int i8 = 0; i8 < 16; ++i8) { const int kk = 8 * i8 + (lane >> 3);
        __builtin_amdgcn_global_load_lds((const unsigned*)(W + (size_t)(k0 + kk) * ldw + c0 + 4 * ((lane & 7) ^ ((kk >> 4) & 7))), (LAS unsigned*)(scr + i8 * 256), 16, 0, 2); }
    asm volatile("s_waitcnt vmcnt(0)" ::: "memory");
    const int c16 = lane & 7;
#pragma unroll
    for (int jj = 0; jj < 4; ++jj) { const int n = (lane >> 3) + 8 * jj, c = c0 + n;
        const int drow = mode == 0 ? c : ((c >> 8) * 256 + (c & 1) * 128 + ((c >> 1) & 127));
        const LAS float* src = scr + (16 * c16) * 32 + 4 * ((n >> 2) ^ c16) + (n & 3);
        float f[16];
#pragma unroll
        for (int i = 0; i < 16; ++i) f[i] = src[i * 32] * sc;
        v4u o; o.x = pk4_fp8(f[0], f[1], f[2], f[3]); o.y = pk4_fp8(f[4], f[5], f[6], f[7]); o.z = pk4_fp8(f[8], f[9], f[10], f[11]); o.w = pk4_fp8(f[12], f[13], f[14], f[15]);
        *(v4u*)(WT8 + (size_t)drow * ldt + k0 + 16 * c16) = o; }
    LDS_WAIT(); asm volatile("" ::: "memory");
}
__device__ __forceinline__ void p0_adaln(const Params& P, LAS unsigned char* lds) {
    const int tid = my_tid(), lane = tid & 63, wave = __builtin_amdgcn_readfirstlane(tid >> 6), G = gridDim.x;
    unsigned char* ws = P.ws;
    { LAS float* csil = (LAS float*)lds; LAS float* red = (LAS float*)(lds + 16384);
      for (int i = tid; i < NB * D; i += 512) { const float c = kin(I_C)[i]; csil[i] = c * sigmoidf_(c); }
      __syncthreads();
      float* mod = (float*)(ws + WS_MOD);
      for (int u = blockIdx.x; u < 4 * 48; u += G) { const int l = u / 48, cg = u % 48, col = cg * 128 + 2 * lane;
          const float* w = kin(I_ADA_W) + (size_t)l * D * 6144 + col; f32x2 a0 = {0.f, 0.f}, a1 = a0, a2 = a0, a3 = a0;
#pragma unroll 16
          for (int kk = 0; kk < 128; ++kk) { const int k = wave * 128 + kk; const f32x2 wv = *(const f32x2*)(w + (size_t)k * 6144);
              a0 += wv * csil[k]; a1 += wv * csil[D + k]; a2 += wv * csil[2 * D + k]; a3 += wv * csil[3 * D + k]; }
          LAS f32x2* red2 = (LAS f32x2*)red;
          red2[(wave * 4 + 0) * 64 + lane] = a0; red2[(wave * 4 + 1) * 64 + lane] = a1; red2[(wave * 4 + 2) * 64 + lane] = a2; red2[(wave * 4 + 3) * 64 + lane] = a3;
          __syncthreads();
          { const int b = tid >> 7, c = tid & 127; float s = kin(I_ADA_B)[l * 6144 + cg * 128 + c];
#pragma unroll
              for (int w8 = 0; w8 < 8; ++w8) s += red[((w8 * 4 + b) * 64) * 2 + c];
              mod[((size_t)l * NB + b) * 6144 + cg * 128 + c] = s; }
          __syncthreads(); }
    }
}
__device__ __forceinline__ void p0_convert(const Params& P, LAS unsigned char* lds) {
    const int tid = my_tid(), lane = tid & 63, wave = __builtin_amdgcn_readfirstlane(tid >> 6), G = gridDim.x;
    unsigned char* ws = P.ws;
    { float* bp = (float*)(ws + WS_BGUP); const float* bs = kin(I_MOE_BGU);
      for (int i = blockIdx.x * 512 + tid; i < 4 * 32 * 2048; i += G * 512) { const int le = i >> 11, r = i & 2047, nt = r >> 8, half = (r >> 7) & 1, j = r & 127;
          bp[i] = bs[(size_t)le * 2048 + 2 * (nt * 128 + j) + half]; } }
    { bf16* wg = (bf16*)(ws + WT_RG_G);
      for (int i = blockIdx.x * 512 + tid; i < 2560 * 16; i += G * 512) { const int rw = i >> 4, c = i & 15; *(v4u*)(wg + (size_t)rw * 256 + 128 + c * 8) = (v4u){0u, 0u, 0u, 0u}; } }
    LAS float* scr = (LAS float*)(lds + wave * 16384);
    const int gw = blockIdx.x * 8 + wave, NGW = G * 8;
    constexpr int N_SMALL = 4288 + 80, N_GU = 128 * 512, N_DN = 128 * 256, N_ITEMS = N_SMALL + N_GU + N_DN;
    for (int it = gw; it < N_ITEMS; it += NGW) {
        int r = it;
        if (r >= N_SMALL + N_GU) { r -= N_SMALL + N_GU; const int le = r >> 8, q = r & 255, kb = q >> 5, cb = q & 31;
            tr_item8(kin(I_MOE_WDN) + (size_t)le * 1024 * 1024, 1024, cb * 32, kb * 128, ws + WT_DN + (size_t)le * 1024 * 1024, 1024, 0, 64.0f, scr, lane); continue; }
        if (r >= N_SMALL) { r -= N_SMALL; const int le = r >> 9, q = r & 511, kb = q >> 6, cb = q & 63;
            tr_item8(kin(I_MOE_WGU) + (size_t)le * 1024 * 2048, 2048, cb * 32, kb * 128, ws + WT_GU + (size_t)le * 2048 * 1024, 1024, 1, 32.0f, scr, lane); continue; }
        if (r < 1536) { const int j = r / 768, q = r % 768, kb = q / 48, cb = q % 48;
            tr_item(kin(I_GLA_WIN) + (size_t)j * 1024 * 3088, 3088, cb * 64, kb * 64, (bf16*)(ws + WT_GLA_IN) + (size_t)j * 3072 * 1024, 1024, 0, scr, lane); continue; } r -= 1536;
        if (r < 512) { const int j = r >> 8, q = r & 255, kb = q >> 5, cb = q & 31;
            tr_item8(kin(I_GLA_WOUT) + (size_t)j * 1024 * 1024, 1024, cb * 32, kb * 128, ws + WT_GLA_OUT + (size_t)j * 1024 * 1024, 1024, 0, 64.0f, scr, lane); continue; } r -= 512;
        if (r < 640) { const int kb = r / 40, cb = r % 40;
            tr_item(kin(I_RG_WIN), 2560, cb * 64, kb * 64, (bf16*)(ws + WT_RG_IN), 1024, 0, scr, lane); continue; } r -= 640;
        if (r < 320) { const int kb = r >> 5, cb = r & 31;
            tr_item8(kin(I_RG_WOUT), 1024, cb * 32, kb * 128, ws + WT_RG_OUT, 1280, 0, 64.0f, scr, lane); continue; } r -= 320;
        if (r < 1024) { const int kb = r >> 6, cb = r & 63; const int c0 = cb < 48 ? cb * 64 : 3088 + (cb - 48) * 64;
            tr_item(kin(I_FOX_WIN), 4112, c0, kb * 64, (bf16*)(ws + WT_FOX_IN), 1024, 2, scr, lane); continue; } r -= 1024;
        if (r < 256) { const int kb = r >> 5, cb = r & 31;
            tr_item8(kin(I_FOX_WOUT), 1024, cb * 32, kb * 128, ws + WT_FOX_OUT, 1024, 0, 64.0f, scr, lane); continue; } r -= 256;
        { const int blk = r >> 3, g = (r >> 2) & 1, kb = (r >> 1) & 1, cb = r & 1;
            tr_item(kin(g ? I_RG_WIG : I_RG_WRG) + (size_t)blk * 128 * 128, 128, cb * 64, kb * 64, (bf16*)(ws + WT_RG_G) + (size_t)(blk * 256 + g * 128) * 256, 256, 0, scr, lane); }
    }
}

struct TokA {
    const float* xin; int xin_bf, xout_bf; int ymode;
    const float* y; const bf16* yb;
    const float* gvec; const float* gamma; const float* beta; float* xout;
    const float* scvec; const float* shvec; bf16* hout; int h_fp8;
    const float* W; int ldw; const float* bias; float* small_out;
    int* cnt; int* tk_e; int* tk_p; float* tk_w;
};
template <int NC>
__device__ __forceinline__ void tok_phase(const TokA& A, LAS unsigned char* lds) {
    const int tid = my_tid(), lane = tid & 63, wave = __builtin_amdgcn_readfirstlane(tid >> 6), G = gridDim.x;
    const int rows_wg = T / G, b = (blockIdx.x * rows_wg) / SEQ;
    const int rpw = rows_wg / 8;
    v4u nx[4]; v2u ny[4]; unsigned nyb[4][4];
#define TOK_LOAD(row_) do { \
        if (A.xin_bf) { _Pragma("unroll") for (int j = 0; j < 4; ++j) { const v2u w_ = ((const v2u*)((const bf16*)A.xin + (row_) * D))[64 * j + lane]; nx[j] = (v4u){w_.x, w_.y, 0u, 0u}; } } \
        else { _Pragma("unroll") for (int j = 0; j < 4; ++j) nx[j] = ((const v4u*)(A.xin + (row_) * D))[64 * j + lane]; } \
        if (A.ymode == 1) { _Pragma("unroll") for (int j = 0; j < 4; ++j) ny[j] = ((const v2u*)((const bf16*)A.y + (row_) * D))[64 * j + lane]; } \
        else if (A.ymode == 2) { _Pragma("unroll") for (int j = 0; j < 4; ++j) _Pragma("unroll") for (int k = 0; k < 4; ++k) nyb[j][k] = ((const unsigned*)((const unsigned char*)A.yb + ((row_) * 4 + k) * D))[64 * j + lane]; } } while (0)
    { const size_t r0 = (size_t)blockIdx.x * rows_wg + wave * rpw; TOK_LOAD(r0); }
    LAS float* wl = (LAS float*)lds;
    if constexpr (NC > 0) {
        constexpr int CH = NC / 4;
#pragma unroll 8
        for (int idx = tid; idx < 1024 * CH; idx += 512) { const int k = idx / CH, c = idx % CH; const f32x4 v = *(const f32x4*)(A.W + (size_t)k * A.ldw + 4 * c);
            const int s = (((k >> 8) * 4 + (k & 3)) * 64) + ((k >> 2) & 63);
            *(LAS f32x4*)(wl + (c * 1024 + s) * 4) = v; }
    }
    LAS f32x4* vec = (LAS f32x4*)(lds + L_VEC);
    if constexpr (NC == 32) { if (tid < 32) ((LAS unsigned*)(lds + L_CNT))[tid] = 0u; }
    if (tid < 256) {
        if (A.ymode) { vec[tid] = ((const f32x4*)(A.gvec + (size_t)b * 6144))[tid] + 1.0f; vec[256 + tid] = ((const f32x4*)A.gamma)[tid]; vec[512 + tid] = ((const f32x4*)A.beta)[tid]; }
        if (A.hout) { vec[768 + tid] = ((const f32x4*)(A.scvec + (size_t)b * 6144))[tid] + 1.0f; vec[1024 + tid] = ((const f32x4*)(A.shvec + (size_t)b * 6144))[tid]; } }
    __syncthreads();
    if (wave >= 4) __builtin_amdgcn_s_setprio(1);
#pragma unroll 2
    for (int ir = 0; ir < rpw; ++ir) {
        const size_t row = (size_t)blockIdx.x * rows_wg + wave * rpw + ir;
        asm volatile("" ::: "memory");
        float hv[16];
        {
            f32x4 v[4];
#pragma unroll
            for (int j = 0; j < 4; ++j) { if (A.xin_bf) v[j] = (f32x4){bflo(nx[j].x), bfhi(nx[j].x), bflo(nx[j].y), bfhi(nx[j].y)}; else v[j] = __builtin_bit_cast(f32x4, nx[j]); }
            f32x4 yv[4];
            if (A.ymode == 1) {
#pragma unroll
                for (int j = 0; j < 4; ++j) yv[j] = (f32x4){bflo(ny[j].x), bfhi(ny[j].x), bflo(ny[j].y), bfhi(ny[j].y)};
            } else if (A.ymode == 2) {
#pragma unroll
                for (int j = 0; j < 4; ++j) { f32x4 s = {0.f, 0.f, 0.f, 0.f};
#pragma unroll
                    for (int k = 0; k < 4; ++k) { const int w = (int)nyb[j][k]; const f32x2 lo = __builtin_amdgcn_cvt_pk_f32_fp8(w, false), hi = __builtin_amdgcn_cvt_pk_f32_fp8(w, true); s += (f32x4){lo.x, lo.y, hi.x, hi.y}; }
                    yv[j] = s * 0.0625f; }
            }
            if (ir + 1 < rpw) { const size_t rn = row + 1; TOK_LOAD(rn); }
            if (A.ymode) {
                float s = 0.f;
#pragma unroll
                for (int j = 0; j < 4; ++j) { v[j] = v[j] * ALPHA + vec[64 * j + lane] * yv[j]; s += (v[j].x + v[j].y) + (v[j].z + v[j].w); }
                const float mean = wave_sum(s) * (1.0f / D); float s2 = 0.f;
#pragma unroll
                for (int j = 0; j < 4; ++j) { v[j] = v[j] - mean; s2 += (v[j].x * v[j].x + v[j].y * v[j].y) + (v[j].z * v[j].z + v[j].w * v[j].w); }
                const float rstd = 1.0f / sqrtf(wave_sum(s2) * (1.0f / D) + LN_EPS);
#pragma unroll
                for (int j = 0; j < 4; ++j) { v[j] = v[j] * rstd * vec[256 + 64 * j + lane] + vec[512 + 64 * j + lane];
                    if (A.xout_bf) { v2u w; w.x = pk2(v[j].x, v[j].y); w.y = pk2(v[j].z, v[j].w); ((v2u*)((bf16*)A.xout + row * D))[64 * j + lane] = w; } else ((f32x4*)(A.xout + row * D))[64 * j + lane] = v[j]; }
            }
            if (A.hout) {
#pragma unroll
                for (int j = 0; j < 4; ++j) { const f32x4 h = v[j] * vec[768 + 64 * j + lane] + vec[1024 + 64 * j + lane]; hv[4 * j + 0] = h.x; hv[4 * j + 1] = h.y; hv[4 * j + 2] = h.z; hv[4 * j + 3] = h.w;
                    if (A.h_fp8) ((unsigned*)((unsigned char*)A.hout + row * D))[64 * j + lane] = pk4_fp8(h.x, h.y, h.z, h.w);
                    else { v2u w; w.x = pk2(h.x, h.y); w.y = pk2(h.z, h.w); ((v2u*)(A.hout + row * D))[64 * j + lane] = w; } }
            }
        }
        asm volatile("" ::: "memory");
        if constexpr (NC > 0) {
            constexpr int CH = NC / 4, LOGN = (NC == 32) ? 5 : 4;
            float acc[NC]; const LAS float* wlane = wl + lane * 4;
#pragma unroll
            for (int q = 0; q < NC; ++q) acc[q] = 0.f;
#pragma unroll
            for (int e = 0; e < 16; ++e) {
                if ((e & 1) == 0) asm volatile("" ::: "memory");
#pragma unroll
                for (int c = 0; c < CH; ++c) { const f32x4 wv = *(const LAS f32x4*)(wlane + (c * 1024 + e * 64) * 4);
#pragma unroll
                    for (int q = 0; q < 4; ++q) acc[4 * c + q] += hv[e] * wv[q]; } }
#pragma unroll
            for (int i = 0; i < NC / 2; ++i) { const auto rr = __builtin_amdgcn_permlane32_swap(__float_as_uint(acc[i]), __float_as_uint(acc[i + NC / 2]), false, false); acc[i] = __uint_as_float(rr[0]) + __uint_as_float(rr[1]); }
            { const bool up = (lane & 16) != 0;
#pragma unroll
              for (int i = 0; i < NC / 4; ++i) { const float keep = up ? acc[i + NC / 4] : acc[i], send = up ? acc[i] : acc[i + NC / 4]; acc[i] = keep + __shfl_xor(send, 16); } }
            { const bool up = (lane & 8) != 0;
#pragma unroll
              for (int i = 0; i < NC / 8; ++i) { const float keep = up ? acc[i + NC / 8] : acc[i], send = up ? acc[i] : acc[i + NC / 8]; acc[i] = keep + dpp_f<0x128>(send); } }
            { const bool up = (lane & 4) != 0;
#pragma unroll
              for (int i = 0; i < NC / 16; ++i) { const float keep = up ? acc[i + NC / 16] : acc[i], send = up ? acc[i] : acc[i + NC / 16]; acc[i] = keep + dpp_f<0x141>(send); } }
            float val;
            if constexpr (NC == 16) { val = acc[0]; val += dpp_f<0x4E>(val); val += dpp_f<0xB1>(val);
                const int col = ((lane >> 5) & 1) * 8 + ((lane >> 4) & 1) * 4 + ((lane >> 3) & 1) * 2 + ((lane >> 2) & 1);
                if ((lane & 3) == 0) A.small_out[row * 16 + col] = val;
            } else { { const bool up = (lane & 2) != 0; const float keep = up ? acc[1] : acc[0], send = up ? acc[0] : acc[1]; val = keep + dpp_f<0x4E>(send); }
                val += dpp_f<0xB1>(val);
                const int col = ((lane >> 5) & 1) * 16 + ((lane >> 4) & 1) * 8 + ((lane >> 3) & 1) * 4 + ((lane >> 2) & 1) * 2 + ((lane >> 1) & 1);
                val += A.bias[col];
                LAS float* lg = (LAS float*)(lds + L_RLIST + 2048) + wave * 48;
                if ((lane & 1) == 0) lg[col] = val;
                f32x4 o[8];
#pragma unroll
                for (int c4 = 0; c4 < 8; ++c4) o[c4] = *(const LAS f32x4*)(lg + 4 * c4);
                int gt = 0, ge = 0;
#pragma unroll
                for (int c4 = 0; c4 < 8; ++c4)
#pragma unroll
                    for (int q = 0; q < 4; ++q) { gt += (o[c4][q] > val) ? 1 : 0; ge += (o[c4][q] >= val) ? 1 : 0; }
                int rank = gt;
                if (__builtin_amdgcn_ballot_w64(ge - gt != 1) != 0ull) {
                    int colx = col; asm volatile("" : "+v"(colx));
                    rank = 0;
#pragma unroll
                    for (int c4 = 0; c4 < 8; ++c4)
#pragma unroll
                        for (int q = 0; q < 4; ++q) rank += ((o[c4][q] > val) | ((o[c4][q] == val) & ((4 * c4 + q) < colx))) ? 1 : 0; }
                if (rank < 4 && (lane & 1) == 0) { lg[32 + rank] = val; ((LAS int*)lg)[36 + rank] = col; }
                if (lane < 4) { const f32x4 tv = *(const LAS f32x4*)(lg + 32); const int ek = ((const LAS int*)lg)[36 + lane];
                    const float e1 = __expf(tv[1] - tv[0]), e2 = __expf(tv[2] - tv[0]), e3 = __expf(tv[3] - tv[0]); const float inv = 1.0f / (1.0f + e1 + e2 + e3);
                    const float wk = (lane == 0 ? 1.0f : lane == 1 ? e1 : lane == 2 ? e2 : e3) * inv;
                    const unsigned lp = __hip_atomic_fetch_add((LAS unsigned*)(lds + L_CNT) + ek, 1u, __ATOMIC_RELAXED, __HIP_MEMORY_SCOPE_WORKGROUP);
                    const int li = (wave * rpw + ir) * 4 + lane; LAS unsigned* rl = (LAS unsigned*)(lds + L_RLIST);
                    rl[li] = (unsigned)ek | (lp << 8); rl[256 + li] = __float_as_uint(wk); }
            }
        }
    }
    __builtin_amdgcn_s_setprio(0);
    if constexpr (NC == 32) {
        __syncthreads();
        LAS unsigned* hist = (LAS unsigned*)(lds + L_CNT); LAS unsigned* gb = (LAS unsigned*)(lds + L_TS); LAS unsigned* rl = (LAS unsigned*)(lds + L_RLIST);
        if (tid < 32) gb[tid] = __hip_atomic_fetch_add((unsigned*)A.cnt + tid, hist[tid], RLX_AGENT);
        __syncthreads();
        if (tid < rows_wg * 4) { const unsigned v = rl[tid]; const int ek = (int)(v & 0xffu); const size_t gi = (size_t)blockIdx.x * rows_wg * 4 + tid;
            const size_t q = (size_t)ek * T + (gb[ek] + (v >> 8)); A.tk_e[q] = (int)gi; A.tk_w[q] = __uint_as_float(rl[256 + tid]); }
        __syncthreads();
    }
}

typedef float f32x16 __attribute__((ext_vector_type(16)));
typedef short s16x8 __attribute__((ext_vector_type(8)));
typedef short s16x4 __attribute__((ext_vector_type(4)));
constexpr size_t GLA_QD = 0, GLA_KI = 16 * MiB, GLA_KE = 32 * MiB, GLA_DEC = 48 * MiB, GLA_DSEG = 49 * MiB, GLA_SLOC = 50 * MiB;
constexpr int GP = 272, GPV = 528;
__device__ __forceinline__ int crow16(int i, int h) { return (i & 3) + 8 * (i >> 2) + 4 * h; }
__device__ __forceinline__ s16x4 vtr4(const LAS unsigned char* p) { return __builtin_bit_cast(s16x4, __builtin_amdgcn_ds_read_tr16_b64_v4i16((LAS s16x4*)p)); }
__device__ __forceinline__ s16x8 tr_frag(const LAS unsigned char* img, int pitch, int row_lo, int row_hi, int col0, int lane) {
    const int i16 = lane & 15, q = i16 >> 2, p = i16 & 3, blk = (lane >> 4) & 1; const int cb = (col0 + 16 * blk + 4 * p) * 2;
    const s16x4 lo = vtr4(img + (row_lo + q) * pitch + cb), hi = vtr4(img + (row_hi + q) * pitch + cb);
    return (s16x8){lo[0], lo[1], lo[2], lo[3], hi[0], hi[1], hi[2], hi[3]};
}
__device__ __forceinline__ s16x8 tr_frag_b(const LAS unsigned char* base, int off_lo, int off_hi) {
    const s16x4 lo = vtr4(base + off_lo), hi = vtr4(base + off_hi);
    return (s16x8){lo[0], lo[1], lo[2], lo[3], hi[0], hi[1], hi[2], hi[3]};
}
__device__ __forceinline__ s16x8 pack8(const f32x16& x, int s) {
    v4u p; p.x = pk2(x[8 * s], x[8 * s + 1]); p.y = pk2(x[8 * s + 2], x[8 * s + 3]); p.z = pk2(x[8 * s + 4], x[8 * s + 5]); p.w = pk2(x[8 * s + 6], x[8 * s + 7]);
    return __builtin_bit_cast(s16x8, p);
}
#define MFMA32(a, b, c) __builtin_amdgcn_mfma_f32_32x32x16_bf16((a), (b), (c), 0, 0, 0)
__device__ __forceinline__ void gla_state_update(f32x16 (&S)[4], const LAS unsigned char* keL, const LAS unsigned char* vL, const LAS float* decL, int wave, int lane) {
    const int h = lane >> 5;
    const int i16_ = lane & 15, q_ = i16_ >> 2, p_ = i16_ & 3, blk_ = (lane >> 4) & 1;
    const LAS unsigned char* kb = keL + (q_ + 8 * h) * GP + (16 * blk_ + 4 * p_) * 2;
    const LAS unsigned char* vb = vL + (q_ + 8 * h) * GPV + (32 * wave + 16 * blk_ + 4 * p_) * 2;
#pragma unroll
    for (int dt = 0; dt < 4; ++dt)
#pragma unroll
        for (int g4 = 0; g4 < 4; ++g4) { const f32x4 dv = *(const LAS f32x4*)(decL + 32 * dt + 8 * g4 + 4 * h);
#pragma unroll
            for (int q = 0; q < 4; ++q) S[dt][4 * g4 + q] *= dv[q]; }
    s16x8 bv[2], ak[2][4];
#pragma unroll
    for (int s = 0; s < 2; ++s) { bv[s] = tr_frag_b(vb, 16 * s * GPV, (16 * s + 4) * GPV);
#pragma unroll
        for (int dt = 0; dt < 4; ++dt) ak[s][dt] = tr_frag_b(kb, 16 * s * GP + 64 * dt, (16 * s + 4) * GP + 64 * dt); }
#pragma unroll
    for (int s = 0; s < 2; ++s)
#pragma unroll
        for (int dt = 0; dt < 4; ++dt) S[dt] = MFMA32(ak[s][dt], bv[s], S[dt]);
}
__device__ __forceinline__ void gla_g1(const Params& P, LAS unsigned char* lds, int j) {
    const int tid = my_tid(), lane = tid & 63, wave = __builtin_amdgcn_readfirstlane(tid >> 6), G = gridDim.x;
    const bf16* proj = (const bf16*)(P.ws + WS_PROJ); const float* glr = (const float*)(P.ws + WS_SMALL);
    bf16* qdG = (bf16*)(P.ws + WS_MIX + GLA_QD); bf16* kiG = (bf16*)(P.ws + WS_MIX + GLA_KI); bf16* keG = (bf16*)(P.ws + WS_MIX + GLA_KE);
    float* decG = (float*)(P.ws + WS_MIX + GLA_DEC); float* dsegG = (float*)(P.ws + WS_MIX + GLA_DSEG); float* slocG = (float*)(P.ws + WS_MIX + GLA_SLOC);
    const float* wgu = kin(I_GLA_WGU) + (size_t)j * 16 * 512; const float* bg = kin(I_GLA_BG) + (size_t)j * 512;
    LAS float* glrL = (LAS float*)lds;
    LAS float* decL = (LAS float*)(lds + 16384);
    LAS float* blL = (LAS float*)(lds + 16384 + 4096);
    LAS unsigned char* keL = lds + 24576;
    LAS unsigned char* vL = lds + 24576 + 4 * 32 * GP;
    for (int u = blockIdx.x; u < 256; u += G) {
        const int bh = u >> 4, seg = u & 15, b = bh >> 2, hh = bh & 3; const size_t rowS = (size_t)b * SEQ + seg * 256;
        for (int i = tid; i < 1024; i += 512) ((LAS f32x4*)glrL)[i] = ((const f32x4*)(glr + rowS * 16))[i];
        f32x16 S[4];
#pragma unroll
        for (int dt = 0; dt < 4; ++dt)
#pragma unroll
            for (int i = 0; i < 16; ++i) S[dt][i] = 0.f;
        const int d = tid & 127, g = tid >> 7;
        float w[16];
#pragma unroll
        for (int r = 0; r < 16; ++r) w[r] = wgu[r * 512 + hh * 128 + d];
        const float bias = bg[hh * 128 + d];
        __syncthreads();
        for (int rd = 0; rd < 2; ++rd) {
            const int c = rd * 4 + g; const size_t row0 = rowS + c * 32;
            for (int i = tid; i < 4 * 32 * 32; i += 512) { const int cc = i >> 10, t = (i >> 5) & 31, c16 = i & 31;
                *(LAS v4u*)(vL + (cc * 32 + t) * GPV + c16 * 16) = *(const v4u*)(proj + (rowS + (rd * 4 + cc) * 32 + t) * 3072 + 1024 + hh * 256 + c16 * 8); }
            float la[32]; float tot = 0.f;
#pragma unroll
            for (int t = 0; t < 32; ++t) { float lg = bias;
#pragma unroll
                for (int r4 = 0; r4 < 4; ++r4) { const f32x4 gv = *(const LAS f32x4*)(glrL + (c * 32 + t) * 16 + 4 * r4); lg += gv.x * w[4 * r4] + gv.y * w[4 * r4 + 1] + gv.z * w[4 * r4 + 2] + gv.w * w[4 * r4 + 3]; }
                la[t] = (fminf(lg, 0.f) - __logf(1.0f + __expf(-fabsf(lg)))) * (1.0f / 16.0f); tot += la[t]; }
            float cum = 0.f; const float dc0 = __expf(tot);
#pragma unroll
            for (int t = 0; t < 32; ++t) { cum += la[t]; const size_t row = row0 + t;
                const float qv = bf2f(proj[row * 3072 + hh * 128 + d]) * 0.08838834764831845f, kv = bf2f(proj[row * 3072 + 512 + hh * 128 + d]);
                const float ec = __expf(cum), en = __builtin_amdgcn_rcpf(ec), ee = dc0 * en;
                const bf16 kev = f2bf(kv * ee);
                qdG[row * 512 + hh * 128 + d] = f2bf(qv * ec); kiG[row * 512 + hh * 128 + d] = f2bf(kv * en); keG[row * 512 + hh * 128 + d] = kev;
                *(LAS bf16*)(keL + (g * 32 + t) * GP + d * 2) = kev; }
            const float dc = dc0;
            decL[c * 128 + d] = dc; blL[c * 128 + d] = tot; decG[((size_t)(bh * 128 + seg * 8 + c)) * 128 + d] = dc;
            LDS_BARRIER();
#pragma unroll 1
            for (int cc = 0; cc < 4; ++cc) gla_state_update(S, keL + cc * 32 * GP, vL + cc * 32 * GPV, decL + (rd * 4 + cc) * 128, wave, lane);
            LDS_BARRIER();
        }
        if (tid < 128) { float s = 0.f;
#pragma unroll
            for (int c = 0; c < 8; ++c) s += blL[c * 128 + tid];
            __hip_atomic_store(dsegG + (size_t)u * 128 + tid, __expf(s), RLX_AGENT); }
        { const int h = lane >> 5, r = lane & 31; float* sp = slocG + (size_t)u * 128 * 256;
#pragma unroll
          for (int dt = 0; dt < 4; ++dt)
#pragma unroll
              for (int i = 0; i < 16; ++i) __hip_atomic_store(sp + (size_t)(32 * dt + crow16(i, h)) * 256 + 32 * wave + r, S[dt][i], RLX_AGENT); }
        unsigned* cntw = (unsigned*)(P.ws + WS_CTL) + CW_GLA + (j * 16 + bh) * 64;
        asm volatile("s_waitcnt vmcnt(0)" ::: "memory");
        if (lane == 0) __hip_atomic_fetch_add(cntw, 1u, RLX_AGENT);
        if (wave == 0) { unsigned sp_ = 0;
            while ((unsigned)__builtin_amdgcn_readfirstlane((int)__hip_atomic_load(cntw, RLX_AGENT)) < 128u) { __builtin_amdgcn_s_sleep(2); if (++sp_ > (1u << 22)) break; }
            __builtin_amdgcn_fence(__ATOMIC_ACQUIRE, "agent"); asm volatile("s_waitcnt vmcnt(0)" ::: "memory"); }
        __syncthreads();
        { const int dd = seg * 8 + (tid >> 6), e4 = tid & 63; f32x4 run = {0.f, 0.f, 0.f, 0.f};
#pragma unroll 4
          for (int sg = 0; sg < 16; ++sg) { f32x4* p = (f32x4*)(slocG + ((size_t)(bh * 16 + sg) * 128 + dd) * 256) + e4; const f32x4 loc = *p; *p = run;
              run = run * dsegG[(size_t)(bh * 16 + sg) * 128 + dd] + loc; } }
        __syncthreads();
    }
}
__device__ __forceinline__ void gla_g3(const Params& P, LAS unsigned char* lds, int j) {
    const int tid = my_tid(), lane = tid & 63, wave = __builtin_amdgcn_readfirstlane(tid >> 6), G = gridDim.x;
    const int h = lane >> 5, r = lane & 31;
    const bf16* proj = (const bf16*)(P.ws + WS_PROJ); bf16* core = (bf16*)(P.ws + WS_CORE);
    const bf16* qdG = (const bf16*)(P.ws + WS_MIX + GLA_QD); const bf16* kiG = (const bf16*)(P.ws + WS_MIX + GLA_KI); const bf16* keG = (const bf16*)(P.ws + WS_MIX + GLA_KE);
    const float* decG = (const float*)(P.ws + WS_MIX + GLA_DEC); const float* slocG = (const float*)(P.ws + WS_MIX + GLA_SLOC);
    const float* ng = kin(I_GLA_NG) + (size_t)j * 1024;
    LAS unsigned char* qdL = lds; LAS unsigned char* kiL = lds + 32 * GP; LAS unsigned char* keL = lds + 64 * GP; LAS unsigned char* vL = lds + 96 * GP;
    LAS float* decL = (LAS float*)(lds + 96 * GP + 32 * GPV);
    LAS float* ssqL = decL + 128;
    LAS unsigned char* oL = (LAS unsigned char*)(ssqL + 256);
    const LAS unsigned char* vkb = vL + (((lane & 15) >> 2) + 4 * h) * GPV + (32 * wave + 16 * ((lane >> 4) & 1) + 4 * (lane & 3)) * 2;
    for (int u = blockIdx.x; u < 256; u += G) {
        const int bh = u >> 4, seg = u & 15, b = bh >> 2, hh = bh & 3; const size_t rowS = (size_t)b * SEQ + seg * 256;
        f32x16 S[4];
        { const float* sp = slocG + (size_t)u * 128 * 256;
#pragma unroll
          for (int dt = 0; dt < 4; ++dt)
#pragma unroll
              for (int i = 0; i < 16; ++i) S[dt][i] = sp[(size_t)(32 * dt + crow16(i, h)) * 256 + 32 * wave + r]; }
        v4u pq, pk, pe, pv[2], prg[2]; float pd = 0.f;
#define G3_LOAD(c_) do { const size_t r0_ = rowS + (c_) * 32; const int t_ = tid >> 4, c16_ = tid & 15; const size_t go_ = (r0_ + t_) * 512 + hh * 128 + c16_ * 8; \
            pq = *(const v4u*)(qdG + go_); pk = *(const v4u*)(kiG + go_); pe = *(const v4u*)(keG + go_); \
            _Pragma("unroll") for (int k2 = 0; k2 < 2; ++k2) { const int i_ = tid + 512 * k2, tv_ = i_ >> 5, cv_ = i_ & 31; \
                pv[k2] = *(const v4u*)(proj + (r0_ + tv_) * 3072 + 1024 + hh * 256 + cv_ * 8); prg[k2] = *(const v4u*)(proj + (r0_ + tv_) * 3072 + 2048 + hh * 256 + cv_ * 8); } \
            if (tid < 128) pd = decG[((size_t)(bh * 128 + seg * 8 + (c_))) * 128 + tid]; } while (0)
        G3_LOAD(0);
        if (wave >= 4) __builtin_amdgcn_s_setprio(1);
#pragma unroll 1
        for (int c = 0; c < 8; ++c) {
            const size_t row0 = rowS + c * 32;
            { const int t = tid >> 4, c16 = tid & 15;
              *(LAS v4u*)(qdL + t * GP + c16 * 16) = pq; *(LAS v4u*)(kiL + t * GP + c16 * 16) = pk; *(LAS v4u*)(keL + t * GP + c16 * 16) = pe;
#pragma unroll
              for (int k2 = 0; k2 < 2; ++k2) { const int i = tid + 512 * k2, tv = i >> 5, cv = i & 31; *(LAS v4u*)(vL + tv * GPV + cv * 16) = pv[k2]; }
              if (tid < 128) decL[tid] = pd; }
            const v4u rg0 = prg[0], rg1 = prg[1];
            LDS_BARRIER();
            if (c + 1 < 8) G3_LOAD(c + 1);
            f32x16 pt, pt2;
#pragma unroll
            for (int i = 0; i < 16; ++i) { pt[i] = 0.f; pt2[i] = 0.f; }
#pragma unroll
            for (int hb = 0; hb < 2; ++hb) { s16x8 fa[4], fb[4];
#pragma unroll
                for (int q4 = 0; q4 < 4; ++q4) { const int s8 = 4 * hb + q4; fa[q4] = *(const LAS s16x8*)(kiL + r * GP + (16 * s8 + 8 * h) * 2); fb[q4] = *(const LAS s16x8*)(qdL + r * GP + (16 * s8 + 8 * h) * 2); }
                pt = MFMA32(fa[0], fb[0], pt); pt2 = MFMA32(fa[1], fb[1], pt2); pt = MFMA32(fa[2], fb[2], pt); pt2 = MFMA32(fa[3], fb[3], pt2);
                asm volatile("" ::: "memory"); }
            pt = pt + pt2;
#pragma unroll
            for (int i = 0; i < 16; ++i) if (crow16(i, h) > r) pt[i] = 0.f;
            f32x16 o, o2;
#pragma unroll
            for (int i = 0; i < 16; ++i) { o[i] = 0.f; o2[i] = 0.f; }
            { s16x8 av[2], bq[4][2];
#pragma unroll
              for (int s = 0; s < 2; ++s) av[s] = tr_frag_b(vkb, 16 * s * GPV, (16 * s + 8) * GPV);
#pragma unroll
              for (int dt = 0; dt < 4; ++dt)
#pragma unroll
                  for (int s = 0; s < 2; ++s) { const s16x4 lo = *(const LAS s16x4*)(qdL + r * GP + (32 * dt + 16 * s + 4 * h) * 2), hi = *(const LAS s16x4*)(qdL + r * GP + (32 * dt + 16 * s + 8 + 4 * h) * 2);
                      bq[dt][s] = (s16x8){lo[0], lo[1], lo[2], lo[3], hi[0], hi[1], hi[2], hi[3]}; }
              o = MFMA32(av[0], pack8(pt, 0), o); o2 = MFMA32(av[1], pack8(pt, 1), o2);
#pragma unroll
              for (int dt = 0; dt < 4; ++dt) { o = MFMA32(pack8(S[dt], 0), bq[dt][0], o); o2 = MFMA32(pack8(S[dt], 1), bq[dt][1], o2); }
              o = o + o2; }
            gla_state_update(S, keL, vL, decL, wave, lane);
            float ss = 0.f;
#pragma unroll
            for (int i = 0; i < 16; ++i) ss += o[i] * o[i];
            { const auto rr = __builtin_amdgcn_permlane32_swap(__float_as_uint(ss), __float_as_uint(ss), false, false); ss = __uint_as_float(rr[0]) + __uint_as_float(rr[1]); }
            if (h == 0) ssqL[wave * 32 + r] = ss;
            LDS_BARRIER();
            float tot = 0.f;
#pragma unroll
            for (int w8 = 0; w8 < 8; ++w8) tot += ssqL[w8 * 32 + r];
            const float rs = __builtin_amdgcn_rsqf(tot * (1.0f / 256.0f) + LN_EPS);
#pragma unroll
            for (int i = 0; i < 16; ++i) *(LAS bf16*)(oL + r * GPV + (32 * wave + crow16(i, h)) * 2) = f2bf(o[i] * rs);
            LDS_BARRIER();
#pragma unroll
            for (int k2 = 0; k2 < 2; ++k2) { const int i = tid + 512 * k2, t = i >> 5, c8 = i & 31; const size_t row = row0 + t;
                const v4u ov = *(const LAS v4u*)(oL + t * GPV + c8 * 16); const v4u rv = k2 ? rg1 : rg0;
                const f32x4 g0 = *(const f32x4*)(ng + hh * 256 + c8 * 8), g1 = *(const f32x4*)(ng + hh * 256 + c8 * 8 + 4);
                const unsigned ow[4] = {ov.x, ov.y, ov.z, ov.w}, rw[4] = {rv.x, rv.y, rv.z, rv.w}; const float gg[8] = {g0.x, g0.y, g0.z, g0.w, g1.x, g1.y, g1.z, g1.w};
                float rf[8];
#pragma unroll
                for (int q = 0; q < 4; ++q) { const float r0 = bflo(rw[q]), r1 = bfhi(rw[q]); rf[2 * q] = bflo(ow[q]) * gg[2 * q] * (r0 * sigmoidf_(r0)); rf[2 * q + 1] = bfhi(ow[q]) * gg[2 * q + 1] * (r1 * sigmoidf_(r1)); }
                *(v2u*)((unsigned char*)core + row * 1024 + hh * 256 + c8 * 8) = (v2u){pk4_fp8(rf[0], rf[1], rf[2], rf[3]), pk4_fp8(rf[4], rf[5], rf[6], rf[7])}; }
            LDS_BARRIER();
        }
        __builtin_amdgcn_s_setprio(0);
    }
}

__device__ __forceinline__ void rg_conv(const Params& P) {
    const int tid = my_tid(), G = gridDim.x;
    const bf16* proj = (const bf16*)(P.ws + WS_PROJ); bf16* xc = (bf16*)(P.ws + WS_Y);
    const float* cw = kin(I_RG_CW); const float* cb = kin(I_RG_CB);
    for (int i = blockIdx.x * 512 + tid; i < (T + 1) * 160; i += G * 512) { const int row = i / 160, c8 = (i % 160) * 8;
        v4u o = {0u, 0u, 0u, 0u};
        if (row < T) { const int t = row % SEQ; float acc[8];
            { const f32x4 b0 = *(const f32x4*)(cb + c8), b1 = *(const f32x4*)(cb + c8 + 4); acc[0] = b0.x; acc[1] = b0.y; acc[2] = b0.z; acc[3] = b0.w; acc[4] = b1.x; acc[5] = b1.y; acc[6] = b1.z; acc[7] = b1.w; }
#pragma unroll
            for (int jx = 0; jx < 4; ++jx) if (t - 3 + jx >= 0) { const v4u xv = *(const v4u*)(proj + (size_t)(row - 3 + jx) * 2560 + 1280 + c8);
                const f32x4 w0 = *(const f32x4*)(cw + jx * 1280 + c8), w1 = *(const f32x4*)(cw + jx * 1280 + c8 + 4);
                acc[0] += w0.x * bflo(xv.x); acc[1] += w0.y * bfhi(xv.x); acc[2] += w0.z * bflo(xv.y); acc[3] += w0.w * bfhi(xv.y);
                acc[4] += w1.x * bflo(xv.z); acc[5] += w1.y * bfhi(xv.z); acc[6] += w1.z * bflo(xv.w); acc[7] += w1.w * bfhi(xv.w); }
            o.x = pk2(acc[0], acc[1]); o.y = pk2(acc[2], acc[3]); o.z = pk2(acc[4], acc[5]); o.w = pk2(acc[6], acc[7]); }
        *(v4u*)(xc + (size_t)row * 1280 + c8) = o; }
}
constexpr int RG_SEG = 128, RG_NSEG = SEQ / RG_SEG;
__device__ __forceinline__ void rg_scan1(const Params& P) {
    const unsigned* AU = (const unsigned*)(P.ws + WS_MIX); float* cP = (float*)(P.ws + WS_SCAN); float* cH = cP + NB * RG_NSEG * 1280;
    for (int idx = blockIdx.x * 512 + threadIdx.x; idx < NB * RG_NSEG * 640; idx += gridDim.x * 512) { const int cp = idx % 640, bs = idx / 640; const size_t row0 = (size_t)bs * RG_SEG;
        float ls0 = 0.f, h0 = 0.f, ls1 = 0.f, h1 = 0.f;
#pragma unroll 16
        for (int t = 0; t < RG_SEG; ++t) { const v2u w = *(const v2u*)(AU + (row0 + t) * 1280 + 2 * cp); const float la0 = bflo(w.x), la1 = bflo(w.y);
            h0 = __expf(la0) * h0 + bfhi(w.x); ls0 += la0; h1 = __expf(la1) * h1 + bfhi(w.y); ls1 += la1; }
        *(f32x2*)(cP + (size_t)bs * 1280 + 2 * cp) = (f32x2){__expf(ls0), __expf(ls1)}; *(f32x2*)(cH + (size_t)bs * 1280 + 2 * cp) = (f32x2){h0, h1}; }
}
__device__ __forceinline__ void rg_scan2(const Params& P) {
    const unsigned* AU = (const unsigned*)(P.ws + WS_MIX); const float* cP = (const float*)(P.ws + WS_SCAN); const float* cH = cP + NB * RG_NSEG * 1280;
    const bf16* proj = (const bf16*)(P.ws + WS_PROJ); bf16* core = (bf16*)(P.ws + WS_CORE);
    for (int idx = blockIdx.x * 512 + threadIdx.x; idx < NB * RG_NSEG * 640; idx += gridDim.x * 512) { const int cp = idx % 640, bs = idx / 640, b = bs / RG_NSEG, sg = bs % RG_NSEG; const size_t row0 = (size_t)bs * RG_SEG;
        float h0 = 0.f, h1 = 0.f;
#pragma unroll 8
        for (int s2 = 0; s2 < sg; ++s2) { const size_t q = (size_t)(b * RG_NSEG + s2) * 1280 + 2 * cp; const f32x2 p2 = *(const f32x2*)(cP + q), c2 = *(const f32x2*)(cH + q); h0 = p2.x * h0 + c2.x; h1 = p2.y * h1 + c2.y; }
#pragma unroll 16
        for (int t = 0; t < RG_SEG; ++t) { const v2u w = *(const v2u*)(AU + (row0 + t) * 1280 + 2 * cp); h0 = __expf(bflo(w.x)) * h0 + bfhi(w.x); h1 = __expf(bflo(w.y)) * h1 + bfhi(w.y);
            const unsigned yb2 = *(const unsigned*)(proj + (row0 + t) * 2560 + 2 * cp);
            *(unsigned short*)((unsigned char*)core + (row0 + t) * 1280 + 2 * cp) = (unsigned short)(pk4_fp8(h0 * bflo(yb2), h1 * bfhi(yb2), 0.f, 0.f) & 0xffffu); } }
}

__device__ __forceinline__ void fox_dcum(const Params& P, LAS unsigned char* lds) {
    const int tid = my_tid(), lane = tid & 63, wave = __builtin_amdgcn_readfirstlane(tid >> 6), G = gridDim.x;
    const float* flog = (const float*)(P.ws + WS_SMALL); float* dcum = (float*)(P.ws + WS_DCUM);
    LAS float* sc = (LAS float*)lds;
    for (int u = blockIdx.x; u < 64; u += G) { const int b = u >> 4, h = u & 15; const float bf = kin(I_FOX_BF)[h];
        float loc[8]; float run = 0.f;
#pragma unroll
        for (int i = 0; i < 8; ++i) { run += logsigmoidf_(flog[((size_t)b * SEQ + tid * 8 + i) * 16 + h] + bf); loc[i] = run; }
        float inc = run;
#pragma unroll
        for (int o = 1; o < 64; o <<= 1) { const float nb = __shfl_up(inc, o); if (lane >= o) inc += nb; }
        if (lane == 63) sc[wave] = inc;
        __syncthreads();
        float wbase = 0.f;
#pragma unroll
        for (int w8 = 0; w8 < 8; ++w8) if (w8 < wave) wbase += sc[w8];
        const float base = wbase + inc - run;
#pragma unroll
        for (int i = 0; i < 8; ++i) dcum[(size_t)u * SEQ + tid * 8 + i] = (base + loc[i]) * LOG2E;
        __syncthreads(); }
}
__device__ __forceinline__ void fox_norm_tile(const Params& P, int pm, int pn) {
    const int tid = my_tid(), lane = tid & 63, wave = __builtin_amdgcn_readfirstlane(tid >> 6);
    bf16* proj = (bf16*)(P.ws + WS_PROJ); const int which = pn >> 2; const int d0 = (lane & 3) * 16; const float* gn = kin(which ? I_FOX_KG : I_FOX_QG) + d0;
#pragma unroll 2
    for (int st = 0; st < 8; ++st) { const int row = pm * 256 + st * 32 + wave * 4 + (lane >> 4); bf16* p = proj + (size_t)row * 4096 + pn * 256 + (lane & 15) * 16;
        const v4u w0 = *(const v4u*)p, w1 = *(const v4u*)(p + 8); float f[16];
        f[0] = bflo(w0.x); f[1] = bfhi(w0.x); f[2] = bflo(w0.y); f[3] = bfhi(w0.y); f[4] = bflo(w0.z); f[5] = bfhi(w0.z); f[6] = bflo(w0.w); f[7] = bfhi(w0.w);
        f[8] = bflo(w1.x); f[9] = bfhi(w1.x); f[10] = bflo(w1.y); f[11] = bfhi(w1.y); f[12] = bflo(w1.z); f[13] = bfhi(w1.z); f[14] = bflo(w1.w); f[15] = bfhi(w1.w);
        float ss = 0.f;
#pragma unroll
        for (int i = 0; i < 16; ++i) ss += f[i] * f[i];
        ss += dpp_f<0xB1>(ss); ss += dpp_f<0x4E>(ss);
        const float rs = __builtin_amdgcn_rsqf(ss * (1.0f / 64.0f) + LN_EPS) * (which ? 1.0f : FOX_C2);
        v4u o0, o1; o0.x = pk2(f[0] * rs * gn[0], f[1] * rs * gn[1]); o0.y = pk2(f[2] * rs * gn[2], f[3] * rs * gn[3]); o0.z = pk2(f[4] * rs * gn[4], f[5] * rs * gn[5]); o0.w = pk2(f[6] * rs * gn[6], f[7] * rs * gn[7]);
        o1.x = pk2(f[8] * rs * gn[8], f[9] * rs * gn[9]); o1.y = pk2(f[10] * rs * gn[10], f[11] * rs * gn[11]); o1.z = pk2(f[12] * rs * gn[12], f[13] * rs * gn[13]); o1.w = pk2(f[14] * rs * gn[14], f[15] * rs * gn[15]);
        *(v4u*)p = o0; *(v4u*)(p + 8) = o1; }
}
#include <hip/hip_bf16.h>
#include <cmath>
namespace attn_body {
using bf16=__hip_bfloat16;
using bf16x8=__attribute__((ext_vector_type(8)))short;
using s16x4=__attribute__((ext_vector_type(4)))short;
using f32x16=__attribute__((ext_vector_type(16)))float;
using u32x4=__attribute__((ext_vector_type(4)))unsigned;
constexpr int BATCH=4,NHEAD=16,SEQ=4096,D=64,PIN=4096,POUT=1024;
constexpr int NW=8,QBLK=32,QB=QBLK*NW,KVBLK=64,NQB=SEQ/QB;
constexpr int ATTN_UNIT_ROWS=QB; constexpr int LDS_DTAB=90112;
__device__ __forceinline__ int crow(int r,int hi){return (r&3)+8*(r>>2)+4*hi;}
#define SBAR() __builtin_amdgcn_sched_barrier(0)
__device__ __forceinline__ void cmask(f32x16&p0,f32x16&p1,int jb,int qrel,int hi){
  const float NEG=-INFINITY; int kb=64*jb+4*hi;
  #pragma unroll
  for(int r=0;r<16;++r){int kv=kb+(r&3)+8*(r>>2); if(kv>qrel)p0[r]=NEG; if(kv+32>qrel)p1[r]=NEG;}
}

constexpr int NSLOT=3, SLOTB=8192;
constexpr int LDS_K=0, LDS_V=NSLOT*SLOTB, LDS_WS=2*NSLOT*SLOTB, LDS_OST=LDS_WS+NW*64*4, LDS_BYTES=LDS_OST+NW*4096;
constexpr float C2=0.125f*1.4426950408889634f;
__device__ __forceinline__ void glds16(const void*gsrc,unsigned lds_dst){unsigned keep;
  asm volatile("s_mov_b32 %0, m0\n\ts_mov_b32 m0, %2\n\ts_nop 0\n\tglobal_load_lds_dwordx4 %1, off\n\ts_mov_b32 m0, %0":"=&s"(keep):"v"(gsrc),"s"(lds_dst):"memory");}
__device__ __forceinline__ float max3f(float a,float b,float c){float r;asm("v_max3_f32 %0, %1, %2, %3":"=v"(r):"v"(a),"v"(b),"v"(c));return r;}
__device__ __forceinline__ float max2f(float a,float b){float r;asm("v_max_f32_e32 %0, %1, %2":"=v"(r):"v"(a),"v"(b));return r;}
__device__ __forceinline__ float fadd_s(float a,float b){float r;asm("v_add_f32_e32 %0, %1, %2":"=v"(r):"v"(a),"v"(b));return r;}
__device__ __forceinline__ float fsub_s(float a,float b){float r;asm("v_sub_f32_e32 %0, %1, %2":"=v"(r):"v"(a),"v"(b));return r;}
typedef float f32x2_t __attribute__((ext_vector_type(2))); typedef __bf16 bf16x2_t __attribute__((ext_vector_type(2)));
__device__ __forceinline__ unsigned cvtpk_s(float lo,float hi){f32x2_t v={lo,hi};bf16x2_t b=__builtin_convertvector(v,bf16x2_t);return __builtin_bit_cast(unsigned,b);}
#define WAIT_BAR(N) asm volatile("s_waitcnt vmcnt(" #N ") lgkmcnt(0)\n\ts_barrier":::"memory")

__device__ __forceinline__ void qkt(f32x16&p0,f32x16&p1,const char*Kslot,const bf16x8*qr,int r32,int hi){
  const char*kb=Kslot+hi*1024+r32*16;
  #pragma unroll
  for(int d0=0;d0<4;++d0){
    const bf16x8 b0=*reinterpret_cast<const bf16x8*>(kb+d0*2048);
    const bf16x8 b1=*reinterpret_cast<const bf16x8*>(kb+d0*2048+512);
    p0=__builtin_amdgcn_mfma_f32_32x32x16_bf16(b0,qr[d0],p0,0,0,0);p1=__builtin_amdgcn_mfma_f32_32x32x16_bf16(b1,qr[d0],p1,0,0,0);}
}
typedef __attribute__((address_space(3))) const char* lds_cptr;
typedef __attribute__((address_space(3))) const float* lds_fptr; typedef float f32x4g __attribute__((ext_vector_type(4)));
typedef short v4i16_t __attribute__((ext_vector_type(4)));
__device__ __forceinline__ void kload8(bf16x8*kf,lds_cptr kp){
  kf[0]=*(const __attribute__((address_space(3))) bf16x8*)(kp);      kf[1]=*(const __attribute__((address_space(3))) bf16x8*)(kp+512);
  kf[2]=*(const __attribute__((address_space(3))) bf16x8*)(kp+2048); kf[3]=*(const __attribute__((address_space(3))) bf16x8*)(kp+2560);
  kf[4]=*(const __attribute__((address_space(3))) bf16x8*)(kp+4096); kf[5]=*(const __attribute__((address_space(3))) bf16x8*)(kp+4608);
  kf[6]=*(const __attribute__((address_space(3))) bf16x8*)(kp+6144); kf[7]=*(const __attribute__((address_space(3))) bf16x8*)(kp+6656);
}
__device__ __forceinline__ void kload2(bf16x8*kf,lds_cptr kp,int j){ kf[2*j]=*(const __attribute__((address_space(3))) bf16x8*)(kp+j*2048); kf[2*j+1]=*(const __attribute__((address_space(3))) bf16x8*)(kp+j*2048+512); }
__device__ __forceinline__ s16x4 vtr(lds_cptr p){ return __builtin_bit_cast(s16x4,__builtin_amdgcn_ds_read_tr16_b64_v4i16((__attribute__((address_space(3))) v4i16_t*)p)); }
__device__ __forceinline__ float rowmax(const f32x16&p0,const f32x16&p1){
  float a=max3f(p0[0],p0[1],p1[0]),b=max3f(p0[2],p0[3],p1[1]);a=max3f(a,p1[2],p1[3]);
  #pragma unroll
  for(int r=4;r<16;r+=4){a=max3f(a,p0[r],p0[r+1]);b=max3f(b,p0[r+2],p0[r+3]);a=max3f(a,p1[r],p1[r+1]);b=max3f(b,p1[r+2],p1[r+3]);}
  const float m=max2f(a,b);
  auto rr=__builtin_amdgcn_permlane32_swap(__float_as_uint(m),__float_as_uint(m),false,false);
  return max2f(__uint_as_float(rr[0]),__uint_as_float(rr[1]));
}
__device__ __forceinline__ void pv(f32x16*o,int vb,bf16x8 pa0,bf16x8 pa1,bf16x8 pa2,bf16x8 pa3){
  #pragma unroll
  for(int d0=0;d0<2;++d0){s16x4 lo[4],hi[4];
    #pragma unroll
    for(int ks=0;ks<4;++ks){
      asm volatile("ds_read_b64_tr_b16 %0,%1 offset:%c2":"=&v"(lo[ks]):"v"(vb),"i"(d0*4096+ks*1024):"memory");
      asm volatile("ds_read_b64_tr_b16 %0,%1 offset:%c2":"=&v"(hi[ks]):"v"(vb),"i"(d0*4096+ks*1024+512):"memory");}
    asm volatile("s_waitcnt lgkmcnt(0)":::"memory");SBAR();
    #define PK(k) (bf16x8){lo[k][0],lo[k][1],lo[k][2],lo[k][3],hi[k][0],hi[k][1],hi[k][2],hi[k][3]}
    o[d0]=__builtin_amdgcn_mfma_f32_32x32x16_bf16(pa0,PK(0),o[d0],0,0,0);
    o[d0]=__builtin_amdgcn_mfma_f32_32x32x16_bf16(pa1,PK(1),o[d0],0,0,0);
    o[d0]=__builtin_amdgcn_mfma_f32_32x32x16_bf16(pa2,PK(2),o[d0],0,0,0);
    o[d0]=__builtin_amdgcn_mfma_f32_32x32x16_bf16(pa3,PK(3),o[d0],0,0,0);
    #undef PK
  }
}

#ifndef ATTN_STORE16
#define ATTN_STORE16(p,v) (*(u32x4*)(p)=(v))
#endif
template<int THRL> __device__ __forceinline__ void attn_unit(int b,int h,int qb,const bf16*Q,const bf16* K,const bf16* V,const bf16*OG,const float*DC,bf16*O,char*shm,bool fill){
  const int tid=threadIdx.x,lane=tid&63,r32=lane&31,hi=lane>>5; const int wid=__builtin_amdgcn_readfirstlane(tid>>6);
  const long rowbase=(long)b*SEQ; const int q0=qb*QB;
  const bf16*Qw=Q+(rowbase+q0+wid*QBLK)*PIN+h*D;
  const bf16*Kh=K+rowbase*PIN+h*D,*Vh=V+rowbase*PIN+h*D;
  const unsigned lds0=(unsigned)(uintptr_t)shm;
  float*wsf=(float*)(shm+LDS_WS)+wid*64;
  const bf16*ksrc=Kh+(long)lane*PIN+wid*8;
  const bf16*vsrc=Vh+(long)(16*(wid&3)+(lane>>2))*PIN+(wid>>2)*32+(lane&3)*8;
  const unsigned kdst=lds0+LDS_K+wid*1024, vdst=lds0+LDS_V+wid*1024;
  #define DMA_K(t,slot) glds16(ksrc+(long)(t)*KVBLK*PIN,(unsigned)__builtin_amdgcn_readfirstlane(kdst+(slot)))
  #define DMA_V(t,slot) glds16(vsrc+(long)(t)*KVBLK*PIN,(unsigned)__builtin_amdgcn_readfirstlane(vdst+(slot)))
  const int vb0=(int)(lds0+LDS_V)+((lane>>4)&1)*32+(lane&3)*8+(4*hi+((lane&15)>>2))*64;
  const char*Kbase=shm+LDS_K; bf16x8 kf[8];
  const lds_cptr shm3=(lds_cptr)shm; const lds_cptr kp0=shm3+LDS_K+hi*1024+r32*16; const lds_cptr vp0=shm3+LDS_V+((lane>>4)&1)*32+(lane&3)*8+(4*hi+((lane&15)>>2))*64;
  const int NT=(q0+QB)/KVBLK;
  const lds_fptr dtab=(lds_fptr)(shm3+LDS_DTAB);
  if(fill){ const f32x4g*src=(const f32x4g*)(DC+(long)(b*NHEAD+h)*SEQ); for(int i=tid;i<SEQ/4;i+=NW*64) ((__attribute__((address_space(3))) f32x4g*)dtab)[i]=src[i]; }
  DMA_K(0,0);DMA_V(0,0);DMA_K(1,SLOTB);
  bf16x8 qr[4];
  #pragma unroll
  for(int d0=0;d0<4;++d0)qr[d0]=*reinterpret_cast<const bf16x8*>(&Qw[(long)r32*PIN+d0*16+hi*8]);
  float mhat=0.f,l_reg=0.f;f32x16 o[2];o[0]=f32x16{};o[1]=f32x16{}; float dq=0.f;
  #define BIAS(C0,C1,t) do{ const float base_=dq-mhat; const lds_fptr dk_=dtab+(t)*KVBLK+4*hi; \
    _Pragma("unroll") for(int g_=0;g_<4;++g_){ const f32x4g a_=*(const __attribute__((address_space(3))) f32x4g*)(dk_+8*g_), b_=*(const __attribute__((address_space(3))) f32x4g*)(dk_+32+8*g_); \
      _Pragma("unroll") for(int q_=0;q_<4;++q_){ C0[4*g_+q_]=base_-a_[q_]; C1[4*g_+q_]=base_-b_[q_]; } } }while(0)
  const int qrel=wid*QBLK+r32;
  #define CMASK(P0,P1,t) do{int jb_=(t)-(NT-4); if(jb_>=0)cmask(P0,P1,jb_,qrel,hi);}while(0)
  bool resc=false;
  #define START(P0,P1) do{ const float rm=rowmax(P0,P1); resc=false; \
    { const float dl=rm; mhat=fadd_s(mhat,dl); \
      _Pragma("unroll") for(int r=0;r<16;++r){P0[r]=fsub_s(P0[r],dl);P1[r]=fsub_s(P1[r],dl);} \
      } \
    _Pragma("unroll") for(int r=0;r<16;++r)P0[r]=__builtin_amdgcn_exp2f(P0[r]); }while(0)
  #define RESC() do{ if(resc){ asm volatile("s_waitcnt lgkmcnt(0)":::"memory"); \
      _Pragma("unroll") for(int d_=0;d_<2;++d_) _Pragma("unroll") for(int r=0;r<16;++r)o[d_][r]*=wsf[crow(r,hi)]; } }while(0)
  f32x16 pA0,pA1,pB0,pB1;
  int sl_prev=0,sl_cur=0,sl_next=SLOTB;
  #define ROT() do{sl_prev=sl_cur;sl_cur=sl_next;sl_next=(sl_next==(NSLOT-1)*SLOTB)?0:sl_next+SLOTB;}while(0)
  DMA_K(2,2*SLOTB);
  WAIT_BAR(3);
  dq=dtab[q0+wid*QBLK+r32];
  BIAS(pA0,pA1,0); qkt(pA0,pA1,Kbase,qr,r32,hi);asm volatile("s_nop 15\n\ts_nop 7":"+v"(pA0),"+v"(pA1));CMASK(pA0,pA1,0);
  START(pA0,pA1);
  _Pragma("unroll") for(int r=0;r<16;++r)pA1[r]=__builtin_amdgcn_exp2f(pA1[r]);
  WAIT_BAR(0);
  DMA_K(3,0);DMA_V(1,SLOTB);
  ROT();
  kload8(kf,kp0+sl_cur);
  WAIT_BAR(2);
  s16x4 vlo[8],vhi[8]; u32x4 pw0,pw1,pw2,pw3;
  #define PKW(P,B) cvtpk_s(P[B],P[B+1])
  #define PAF(k) __builtin_bit_cast(bf16x8,pw##k)
  #define VFR(i) (bf16x8){vlo[i][0],vlo[i][1],vlo[i][2],vlo[i][3],vhi[i][0],vhi[i][1],vhi[i][2],vhi[i][3]}
  #define PIN(x) asm volatile("":"+v"(x))
  #define MX3(a,b,c) __builtin_fmaxf(__builtin_fmaxf((a),(b)),(c))
  #define GAPA(MF,A0,A1,A2,A3,W0,W1,PW) do{ MF; sacc+=A0; sacc+=A1; sacc+=A2; sacc+=A3; PIN(sacc); W0; W1; PIN(PW); SBAR(); }while(0)
  #define EX(v) __builtin_amdgcn_exp2f(v)
  #define GAPB(MF,X,B) do{ MF; X[B]=EX(X[B]); X[B+1]=EX(X[B+1]); X[B+2]=EX(X[B+2]); X[B+3]=EX(X[B+3]); PIN(X); SBAR(); }while(0)
  #define VRD(i) do{ vlo[i]=vtr(vp_+(((i)>>2)*4096+((i)&3)*1024)); vhi[i]=vtr(vp_+(((i)>>2)*4096+((i)&3)*1024+512)); }while(0)
  #define KRD(G,j) do{ if(G){ kload2(kf,kp0+sl_next,j); SBAR(); } }while(0)
  #define STEP(C0,C1,P0,P1,t,GK,GV,GL) do{ SBAR(); BIAS(C0,C1,t); SBAR(); \
    const lds_cptr vp_=vp0+sl_prev; \
    VRD(0); SBAR(); float sacc=(P0[0]+P0[1]); \
    GAPA(C0=__builtin_amdgcn_mfma_f32_32x32x16_bf16(kf[0],qr[0],C0,0,0,0), P0[2],P0[3],P0[4],P0[5],     pw0[0]=PKW(P0,0), pw0[1]=PKW(P0,2), pw0); \
    VRD(4); SBAR(); GAPA(C1=__builtin_amdgcn_mfma_f32_32x32x16_bf16(kf[1],qr[0],C1,0,0,0), P0[6],P0[7],P0[8],P0[9],     pw0[2]=PKW(P0,4), pw0[3]=PKW(P0,6), pw0); \
    VRD(1); SBAR(); GAPA(C0=__builtin_amdgcn_mfma_f32_32x32x16_bf16(kf[2],qr[1],C0,0,0,0),   P0[10],P0[11],P0[12],P0[13], pw1[0]=PKW(P0,8), pw1[1]=PKW(P0,10), pw1); \
    VRD(5); SBAR(); GAPA(C1=__builtin_amdgcn_mfma_f32_32x32x16_bf16(kf[3],qr[1],C1,0,0,0),   P0[14],P0[15],P1[0],P1[1],   pw1[2]=PKW(P0,12),pw1[3]=PKW(P0,14), pw1); \
    VRD(2); SBAR(); GAPA(C0=__builtin_amdgcn_mfma_f32_32x32x16_bf16(kf[4],qr[2],C0,0,0,0),   P1[2],P1[3],P1[4],P1[5],     pw2[0]=PKW(P1,0), pw2[1]=PKW(P1,2), pw2); \
    VRD(6); SBAR(); GAPA(C1=__builtin_amdgcn_mfma_f32_32x32x16_bf16(kf[5],qr[2],C1,0,0,0),   P1[6],P1[7],P1[8],P1[9],     pw2[2]=PKW(P1,4), pw2[3]=PKW(P1,6), pw2); \
    VRD(3); SBAR(); GAPA(C0=__builtin_amdgcn_mfma_f32_32x32x16_bf16(kf[6],qr[3],C0,0,0,0),   P1[10],P1[11],P1[12],P1[13], pw3[0]=PKW(P1,8), pw3[1]=PKW(P1,10), pw3); \
    VRD(7); SBAR(); GAPA(C1=__builtin_amdgcn_mfma_f32_32x32x16_bf16(kf[7],qr[3],C1,0,0,0),   P1[14],P1[15],0.f,0.f,       pw3[2]=PKW(P1,12),pw3[3]=PKW(P1,14), pw3); \
    l_reg+=sacc; \
    if(GK){DMA_K((t)+3,sl_cur);} if(GV){DMA_V((t)+1,sl_next);} \
    CMASK(C0,C1,t); \
    { float a=MX3(C0[0],C0[1],C1[0]),b=MX3(C0[2],C0[3],C1[1]); a=MX3(a,C1[2],C1[3]); \
      _Pragma("unroll") for(int r=4;r<16;r+=4){a=MX3(a,C0[r],C0[r+1]);b=MX3(b,C0[r+2],C0[r+3]);a=MX3(a,C1[r],C1[r+1]);b=MX3(b,C1[r+2],C1[r+3]);} \
      float rm=__builtin_fmaxf(a,b); { auto rr=__builtin_amdgcn_permlane32_swap(__float_as_uint(rm),__float_as_uint(rm),false,false); rm=__builtin_fmaxf(__uint_as_float(rr[0]),__uint_as_float(rr[1])); } \
      resc=false; \
      if(__builtin_expect(__any(rm>(float)THRL),0)){ const float dl=__builtin_fmaxf(rm,0.f); mhat+=dl; \
        _Pragma("unroll") for(int r=0;r<16;++r){C0[r]-=dl;C1[r]-=dl;} \
        const float f=__builtin_amdgcn_exp2f(-dl); l_reg*=f; if(hi==0)wsf[r32]=f; resc=true; } } \
    SBAR(); \
    GAPB(o[0]=__builtin_amdgcn_mfma_f32_32x32x16_bf16(PAF(0),VFR(0),o[0],0,0,0), C0,0); \
    GAPB(o[1]=__builtin_amdgcn_mfma_f32_32x32x16_bf16(PAF(0),VFR(4),o[1],0,0,0), C0,4); \
    KRD(GL,0); GAPB(o[0]=__builtin_amdgcn_mfma_f32_32x32x16_bf16(PAF(1),VFR(1),o[0],0,0,0), C0,8); \
    KRD(GL,1); GAPB(o[1]=__builtin_amdgcn_mfma_f32_32x32x16_bf16(PAF(1),VFR(5),o[1],0,0,0), C0,12); \
    KRD(GL,2); GAPB(o[0]=__builtin_amdgcn_mfma_f32_32x32x16_bf16(PAF(2),VFR(2),o[0],0,0,0), C1,0); \
    KRD(GL,3); GAPB(o[1]=__builtin_amdgcn_mfma_f32_32x32x16_bf16(PAF(2),VFR(6),o[1],0,0,0), C1,4); \
    GAPB(o[0]=__builtin_amdgcn_mfma_f32_32x32x16_bf16(PAF(3),VFR(3),o[0],0,0,0), C1,8); \
    GAPB(o[1]=__builtin_amdgcn_mfma_f32_32x32x16_bf16(PAF(3),VFR(7),o[1],0,0,0), C1,12); \
    }while(0)
  int t=1;
  #undef CMASK
  #define CMASK(P0,P1,t) do{}while(0)
  for(;t+5<NT;t+=2){
    STEP(pB0,pB1,pA0,pA1,t,true,true,true);     WAIT_BAR(2); RESC(); ROT();
    STEP(pA0,pA1,pB0,pB1,t+1,true,true,true);   WAIT_BAR(2); RESC(); ROT();
  }
  #undef CMASK
  #define CMASK(P0,P1,t) do{int jb_=(t)-(NT-4); if(jb_>=0)cmask(P0,P1,jb_,qrel,hi);}while(0)
  #define ENDW(tt) do{ if((tt)+3<NT){WAIT_BAR(2);} else if((tt)+2<NT){WAIT_BAR(1);} else {WAIT_BAR(0);} }while(0)
  for(;t+1<NT;t+=2){
    STEP(pB0,pB1,pA0,pA1,t,(t+3<NT),(t+1<NT),(t+1<NT));       ENDW(t);   RESC(); ROT();
    STEP(pA0,pA1,pB0,pB1,t+1,(t+4<NT),(t+2<NT),(t+2<NT));     ENDW(t+1); RESC(); ROT();
  }
  STEP(pB0,pB1,pA0,pA1,NT-1,false,false,false); RESC();
  { float sacc=pB0[0]+pB0[1]; _Pragma("unroll") for(int r=2;r<16;++r)sacc+=pB0[r]; _Pragma("unroll") for(int r=0;r<16;++r)sacc+=pB1[r]; l_reg+=sacc;
    pw0=(u32x4){PKW(pB0,0),PKW(pB0,2),PKW(pB0,4),PKW(pB0,6)};pw1=(u32x4){PKW(pB0,8),PKW(pB0,10),PKW(pB0,12),PKW(pB0,14)};pw2=(u32x4){PKW(pB1,0),PKW(pB1,2),PKW(pB1,4),PKW(pB1,6)};pw3=(u32x4){PKW(pB1,8),PKW(pB1,10),PKW(pB1,12),PKW(pB1,14)};
    SBAR(); pv(o,vb0+sl_cur,PAF(0),PAF(1),PAF(2),PAF(3)); }
  #undef PKW
  #undef PAF
  #undef VFR
  #undef PIN
  #undef MX3
  #undef GAPA
  #undef GAPB
  #undef EX
  #undef VRD
  #undef KRD
  #undef STEP
  #undef ENDW
  {auto rr=__builtin_amdgcn_permlane32_swap(__float_as_uint(l_reg),__float_as_uint(l_reg),false,false);l_reg=__uint_as_float(rr[0])+__uint_as_float(rr[1]);}
  if(hi==0)wsf[32+r32]=l_reg;asm volatile("s_waitcnt lgkmcnt(0)":::"memory");
  float rli[16];
  #pragma unroll
  for(int r=0;r<16;++r)rli[r]=__builtin_amdgcn_rcpf(wsf[32+crow(r,hi)]);
  unsigned char*Ow=(unsigned char*)O+(rowbase+q0+wid*QBLK)*POUT+h*D; const bf16*Gw=OG+(rowbase+q0+wid*QBLK)*PIN+h*D;
  { bf16*stg=(bf16*)(shm+LDS_OST)+wid*2048;
    #pragma unroll
    for(int r=0;r<16;++r){const int orow=crow(r,hi);
      #pragma unroll
      for(int d0=0;d0<2;++d0)stg[orow*64+d0*32+r32]=__float2bfloat16(o[d0][r]*rli[r]);}
    asm volatile("s_waitcnt lgkmcnt(0)":::"memory");
    #pragma unroll
    for(int i=0;i<4;++i){const int row=i*8+(lane>>3),ch=lane&7; const u32x4 v=*(const u32x4*)(stg+row*64+ch*8); const u32x4 g=*(const u32x4*)(Gw+(long)row*PIN+ch*8); float wf[8];
      _Pragma("unroll") for(int q_=0;q_<4;++q_){ const float gl=__uint_as_float(g[q_]<<16),gh=__uint_as_float(g[q_]&0xffff0000u),vl=__uint_as_float(v[q_]<<16),vh=__uint_as_float(v[q_]&0xffff0000u);
        wf[2*q_]=vl*__builtin_amdgcn_rcpf(1.f+__builtin_amdgcn_exp2f(-1.4426950408889634f*gl)); wf[2*q_+1]=vh*__builtin_amdgcn_rcpf(1.f+__builtin_amdgcn_exp2f(-1.4426950408889634f*gh)); }
      int p0_=0,p1_=0; p0_=__builtin_amdgcn_cvt_pk_fp8_f32(wf[0],wf[1],p0_,false); p0_=__builtin_amdgcn_cvt_pk_fp8_f32(wf[2],wf[3],p0_,true); p1_=__builtin_amdgcn_cvt_pk_fp8_f32(wf[4],wf[5],p1_,false); p1_=__builtin_amdgcn_cvt_pk_fp8_f32(wf[6],wf[7],p1_,true);
      typedef unsigned u32x2_ __attribute__((ext_vector_type(2))); *(u32x2_*)(Ow+(long)row*POUT+ch*8)=(u32x2_){(unsigned)p0_,(unsigned)p1_};} }
  asm volatile("s_waitcnt lgkmcnt(0)\n\ts_barrier":::"memory");
  #undef DMA_K
  #undef DMA_V
  #undef CMASK
  #undef START
  #undef RESC
  #undef ROT
  #undef BIAS
}
constexpr int ATTN_LDS_BYTES=LDS_BYTES;
struct AttnTensors { const bf16* Q; const bf16* K; const bf16* V; const bf16* OG; const float* DC; bf16* O; };
struct AttnUnit { int bh; int qb; };
struct StaticOrder {
  int vcu;
  __device__ __forceinline__ explicit StaticOrder(int grid,int block):vcu((block%8)*(grid/8)+block/8){}
  __device__ __forceinline__ bool next(int i,AttnUnit&u)const{ if(i>=4)return false; const int s=vcu&3; u.bh=vcu>>2; u.qb=(i==0)?s:(i==1)?7-s:(i==2)?8+s:15-s; return true; }
  __device__ __forceinline__ void a_ready(const AttnUnit&)const{}
  __device__ __forceinline__ void done(const AttnUnit&)const{}
};
template<class Sched,int THRL=8> __device__ __forceinline__ void attn_phase(char*lds,const AttnTensors&T,const Sched&S){
  AttnUnit u;
  int last_bh=-1;
  for(int i=0;S.next(i,u);++i){ S.a_ready(u); attn_unit<THRL>(u.bh/NHEAD,u.bh%NHEAD,u.qb,T.Q,T.K,T.V,T.OG,T.DC,T.O,lds,u.bh!=last_bh); last_bh=u.bh; S.done(u); }
}
#undef SBAR
#undef WAIT_BAR
}

__device__ __forceinline__ void moe_tables(const Params& P, LAS unsigned char* lds, int l) {
    LAS int* ts = (LAS int*)(lds + L_TS); LAS int* lc = (LAS int*)(lds + L_CNT);
    const unsigned* cnt = (const unsigned*)(P.ws + WS_CTL) + CW_CNT + 64 * l;
    if (threadIdx.x < 64) { const int ln = (int)threadIdx.x; const int c = ln < 32 ? (int)__hip_atomic_load(cnt + (ln & 31), RLX_AGENT) : 0; const int t = (c + 255) >> 8; int inc = t;
#pragma unroll
        for (int o = 1; o < 32; o <<= 1) { const int nb = __shfl_up(inc, o); if (ln >= o) inc += nb; }
        if (ln < 32) { lc[ln] = c; ts[ln] = inc - t; if (ln == 31) ts[32] = inc; } }
    __syncthreads();
}
__device__ __forceinline__ int moe_units(LAS unsigned char* lds, int NT, int vcu, const int* elist, const float* ewt, const float* bias) {
    const LAS int* ts = (const LAS int*)(lds + L_TS); LAS unsigned* ul = (LAS unsigned*)(lds + L_ULIST); LAS int* nu = (LAS int*)(lds + L_NU);
    { const int G = gridDim.x, total = ts[32] * NT, i = (int)threadIdx.x;
      if (i < 64) { const int L = i * G + vcu;
          if (L < total) { int e = 0;
#pragma unroll 1
              for (int q = 16; q >= 1; q >>= 1) if (ts[e + q] * NT <= L) e += q;
              const int up = L - ts[e] * NT, te = ts[e + 1] - ts[e]; const int nt = up / te, rt = up % te; ul[i] = (unsigned)(ts[e] + rt) | ((unsigned)(e * NT + nt) << 16); } }
      if (i == 0) nu[0] = vcu < total ? (total - vcu + G - 1) / G : 0; }
    __syncthreads();
    const LAS int* lc = (const LAS int*)(lds + L_CNT); const int n = nu[0];
    if (NT == 8) {
        LAS unsigned* tab = (LAS unsigned*)(lds + L_VEC); LAS float* bt = (LAS float*)(lds + L_VEC + 10240);
#pragma unroll 5
        for (int i = threadIdx.x; i < n * 256; i += 512) { const unsigned uw = ul[i >> 8]; const int pm = (int)(uw & 0xffffu), pn = (int)(uw >> 16), e = pn / NT; const int p = (pm - ts[e]) * 256 + (i & 255);
            tab[i] = (p < lc[e]) ? (unsigned)(elist[(size_t)e * T + p] >> 2) * 1024u : 0u; bt[i] = 32.0f * bias[(size_t)pn * 256 + (i & 255)] + ((i & 128) ? 32.0f : 0.0f); }
    } else {
        LAS unsigned* tab = (LAS unsigned*)(lds + L_VEC); LAS float* bt = (LAS float*)(lds + L_VEC + 10240);
#pragma unroll 3
        for (int i = threadIdx.x; i < n * 256; i += 512) { const unsigned uw = ul[i >> 8]; const int pm = (int)(uw & 0xffffu), pn = (int)(uw >> 16), e = pn / NT; const int p = (pm - ts[e]) * 256 + (i & 255);
            int info = -1; float w = 0.f; if (p < lc[e]) { info = elist[(size_t)e * T + p]; w = ewt[(size_t)e * T + p] * 0.25f; }
            tab[2 * i] = (unsigned)info; tab[2 * i + 1] = __float_as_uint(w); bt[i] = 64.0f * bias[(size_t)pn * 256 + (i & 255)]; }
    }
    __syncthreads();
    return nu[0];
}

constexpr int NPH = 46;
__host__ __device__ inline bool phase_active(int ph) { if (ph < 2) return true; const int s = (ph - 2) % 11, kind = ((ph - 2) / 11) % 3; if (s == 1) return kind != 2; if (s == 2) return kind != 0; if (s == 3) return kind != 2; if (s == 4) return kind == 1; if (s == 7) return false; return true; }


#ifndef ONLY
#define ONLY -1
#endif
#ifndef DUP_SEL
#define DUP_SEL 0
#endif
#ifndef PHMASK
#define PHMASK 0xffffffffu
#endif
#define PHM(x) ((ONLY < 0 || ONLY == (x)) && ((PHMASK >> (x)) & 1))
#define IN(k) (PHM(k) && lo <= (k) && (k) < hi)
#define INL(s) (PHM(2 + (s)) && lo <= (base + (s)) && (base + (s)) < hi)
#define SEAM(k) do { if ((k) + 1 < hi && P.use_bar) { xcd_barrier(bar); if (DUP_SEL == 9) xcd_barrier(bar); } } while (0)
#define TOKDUP(NCV, A) do { if (DUP_SEL == 6) { TokA A2 = A; unsigned char* dz = ws + WS_ACT; if (A2.xout) A2.xout = (float*)dz; if (A2.hout) A2.hout = (bf16*)(dz + 64 * MiB); A2.small_out = (float*)(dz + 96 * MiB); A2.tk_e = (int*)(dz + 100 * MiB); A2.tk_p = nullptr; A2.tk_w = (float*)(dz + 104 * MiB); A2.cnt = (int*)(ctl + 65536);     tok_phase<NCV>(A2, lds); __syncthreads(); } tok_phase<NCV>(A, lds); } while (0)
#define NREP(sel) ((DUP_SEL == (sel)) ? 2 : 1)
template <int l>
__device__ __forceinline__ void layer_body(const Params& P, LAS unsigned char* lds, const XcdBarrier& bar, const int vcu) {
    constexpr int kind = l % 3, j = l / 3, base = 2 + 11 * l;
    const int lo = P.ph_lo, hi = P.ph_hi; const int G = gridDim.x, bx = blockIdx.x;
    unsigned char* ws = P.ws; unsigned* ctl = (unsigned*)(ws + WS_CTL);
    float* X = (float*)(ws + WS_X); bf16* Hb = (bf16*)(ws + WS_H); float* Y = (float*)(ws + WS_Y); bf16* proj = (bf16*)(ws + WS_PROJ); bf16* core = (bf16*)(ws + WS_CORE);
    const float* mod = (const float*)(ws + WS_MOD); float* small = (float*)(ws + WS_SMALL);
    int* tke = (int*)(ws + WS_TKE); int* tkp = (int*)(ws + WS_TKP); float* tkw = (float*)(ws + WS_TKW);

        const float* modl = mod + (size_t)l * NB * 6144;
        if (INL(0)) {
            pg8::Gemm g{}; pg8::EpiBf16Plain E{};
            g.A = Hb; g.M = T; g.K = 1024; g.lda = 1024; g.a_pn_stride = 0; E.O = proj; E.oscale = 1.0f;
            if (kind == 0) { g.Bt = (const bf16*)(ws + WT_GLA_IN) + (size_t)j * 3072 * 1024; g.N = 3072; E.ldc = 3072; E.gelu_pn_lt = 0; }
            else if (kind == 1) { g.Bt = (const bf16*)(ws + WT_RG_IN); g.N = 2560; E.ldc = 2560; E.gelu_pn_lt = 5; }
            else { g.Bt = (const bf16*)(ws + WT_FOX_IN); g.N = 4096; E.ldc = 4096; E.gelu_pn_lt = 0; }
            pg8::StaticOrder S; S.init(T, g.N, G, bx);
            if (kind == 2) fox_dcum(P, lds);
            for (int rep = 0; rep < NREP(3); ++rep) pg8::gemm_phase<pg8::EpiBf16Plain, pg8::StaticOrder, true, true>(lds, g, S, E);
            if (kind == 2) {
                __builtin_amdgcn_fence(__ATOMIC_ACQUIRE, "agent"); asm volatile("s_waitcnt vmcnt(0)" ::: "memory");
                pg8::Unit uu; for (int i = 0; S.next(i, uu); ++i) if (uu.pn < 8) fox_norm_tile(P, uu.pm, uu.pn); }
            SEAM(base + 0);
        }
        if (INL(1) && kind != 2) {
            if (kind == 0) { for (int rep = 0; rep < NREP(1); ++rep) gla_g1(P, lds, j); } else if (kind == 1) { for (int rep = 0; rep < NREP(4); ++rep) rg_conv(P); }
            SEAM(base + 1);
        }
        if (INL(2) && kind != 0) {
            if (kind == 1) {
                pg8::Gemm g{}; g.A = (const bf16*)(ws + WS_Y); g.Bt = (const bf16*)(ws + WT_RG_G); g.M = T; g.N = 2560; { int kq = 256; asm volatile("" : "+s"(kq)); g.K = kq; }     g.lda = 1280; g.a_pn_stride = 256;
                pg8::EpiRgGate E{(unsigned*)(ws + WS_MIX), (const bf16*)(ws + WS_Y), kin(I_RG_BRG), kin(I_RG_BIG), kin(I_RG_LAM)};
                pg8::StaticOrder S; S.init(T, 2560, G, bx);
                for (int rep = 0; rep < NREP(4); ++rep) pg8::gemm_phase<pg8::EpiRgGate, pg8::StaticOrder, true, true>(lds, g, S, E);
            } else { const attn_body::AttnTensors AT{(const attn_body::bf16*)proj, (const attn_body::bf16*)(proj + 1024), (const attn_body::bf16*)(proj + 2048), (const attn_body::bf16*)(proj + 3072), (const float*)(ws + WS_DCUM), (attn_body::bf16*)core};
                const attn_body::StaticOrder S(G, bx);
                for (int rep = 0; rep < NREP(2); ++rep) attn_body::attn_phase<attn_body::StaticOrder>((char*)lds, AT, S); }
            SEAM(base + 2);
        }
        if (INL(3) && kind != 2) { if (kind == 0) { for (int rep = 0; rep < NREP(11); ++rep) gla_g3(P, lds, j); } else { for (int rep = 0; rep < NREP(4); ++rep) rg_scan1(P); } SEAM(base + 3); }
        if (INL(4) && kind == 1) { for (int rep = 0; rep < NREP(4); ++rep) rg_scan2(P); SEAM(base + 4); }
        if (INL(5)) {
            pg8::Gemm g{}; g.A = core; g.M = T; g.N = 1024; g.a_pn_stride = 0;
            if (kind == 0) { g.Bt = (const bf16*)(ws + WT_GLA_OUT + (size_t)j * 1024 * 1024); g.K = 512; }
            else if (kind == 1) { g.Bt = (const bf16*)(ws + WT_RG_OUT); g.K = 640; }
            else { g.Bt = (const bf16*)(ws + WT_FOX_OUT); g.K = 512; }
            g.lda = g.K;
            pg8::EpiBf16Plain E{(bf16*)Y, 1024, 0, 0.015625f}; pg8::StaticOrder S; S.init(T, 1024, G, bx);
            for (int rep = 0; rep < NREP(3); ++rep) pg8::gemm_phase<pg8::EpiBf16Plain, pg8::StaticOrder, true, true, false, true>(lds, g, S, E);
            SEAM(base + 5);
        }
        if (INL(6)) {
            TokA A{}; A.xin = (l == 0) ? kin(I_X) : X; A.xin_bf = (l != 0); A.xout_bf = 1; A.ymode = 1; A.y = Y; A.gvec = modl + 2048; A.gamma = kin(I_LN_G) + (size_t)(l * 2) * D; A.beta = kin(I_LN_B) + (size_t)(l * 2) * D; A.xout = X;
            A.scvec = modl + 4096; A.shvec = modl + 3072; A.hout = Hb; A.h_fp8 = 1; A.W = kin(I_MOE_WR) + (size_t)l * D * 32; A.ldw = 32; A.bias = kin(I_MOE_BR) + l * 32;
            A.cnt = (int*)(ctl + CW_CNT + 64 * l); A.tk_e = (int*)(ws + WS_ELIST); A.tk_p = nullptr; A.tk_w = (float*)(ws + WS_EWT);
            TOKDUP(32, A); SEAM(base + 6);
        }
        if (INL(8)) {
            moe_tables(P, lds, l); const int n = moe_units(lds, 8, vcu, (const int*)(ws + WS_ELIST), nullptr, (const float*)(ws + WS_BGUP) + (size_t)l * 32 * 2048);
            pg8::Gemm g{}; g.A = Hb; g.Bt = (const bf16*)(ws + WT_GU + (size_t)l * 32 * 2048 * 1024); g.M = NPAD_MAX; g.N = 32 * 2048; { int kq = 512; asm volatile("" : "+s"(kq)); g.K = kq; } g.lda = 512; g.a_pn_stride = 0; g.wscale = 0x7a7a7a7a;
            pg8::EpiSwiglu E{(bf16*)(ws + WS_ACT), (const LAS float*)(lds + L_VEC + 10240)};
            pg8::ListOrder S{(const LAS unsigned*)(lds + L_ULIST), n};
            for (int rep = 0; rep < NREP(3); ++rep) pg8::gemm_phase<pg8::EpiSwiglu, pg8::ListOrder, true, true, true, true>(lds, g, S, E, (const LAS unsigned*)(lds + L_VEC));
            SEAM(base + 8);
        }
        if (INL(9)) {
            if (P.ph_lo > base + 8) moe_tables(P, lds, l);
            const int n = moe_units(lds, 4, vcu, (const int*)(ws + WS_ELIST), (const float*)(ws + WS_EWT), kin(I_MOE_BDN) + (size_t)l * 32 * 1024);
            pg8::Gemm g{}; g.A = (const bf16*)(ws + WS_ACT); g.Bt = (const bf16*)(ws + WT_DN + (size_t)l * 32 * 1024 * 1024); g.M = NPAD_MAX; g.N = 32 * 1024; { int kq = 512; asm volatile("" : "+s"(kq)); g.K = kq; } g.lda = 512; g.a_pn_stride = 0; g.wscale = 0x79797979;
            pg8::EpiDown E{(bf16*)(ws + WS_YB), (const LAS unsigned*)(lds + L_VEC), (const LAS float*)(lds + L_VEC + 10240)};
            pg8::ListOrder S{(const LAS unsigned*)(lds + L_ULIST), n};
            for (int rep = 0; rep < NREP(3); ++rep) pg8::gemm_phase<pg8::EpiDown, pg8::ListOrder, true, true, false, true>(lds, g, S, E);
            SEAM(base + 9);
        }
        if (INL(10)) {
            TokA A{}; A.xin = X; A.xin_bf = 1; A.xout_bf = (l != 3); A.ymode = 2; A.yb = (const bf16*)(ws + WS_YB); A.gvec = modl + 5120; A.gamma = kin(I_LN_G) + (size_t)(l * 2 + 1) * D; A.beta = kin(I_LN_B) + (size_t)(l * 2 + 1) * D;
            A.xout = (l == 3) ? P.out : X;
            if (l < 3) { const float* modn = mod + (size_t)(l + 1) * NB * 6144; A.scvec = modn + 1024; A.shvec = modn; A.hout = Hb; A.small_out = small;
                const int nk = (l + 1) % 3;
                if (nk == 0) { A.W = kin(I_GLA_WIN) + (size_t)((l + 1) / 3) * 1024 * 3088 + 3072; A.ldw = 3088; TOKDUP(16, A); }
                else if (nk == 2) { A.W = kin(I_FOX_WIN) + 3072; A.ldw = 4112; TOKDUP(16, A); }
                else TOKDUP(0, A);
            } else TOKDUP(0, A);
            SEAM(base + 10);
        }
    }

__global__ void __launch_bounds__(512, 2) mega_fwd(Params P) {
    extern __shared__ __attribute__((aligned(16))) unsigned char lds_raw[];
    LAS unsigned char* lds = (LAS unsigned char*)lds_raw;
    const int tid = my_tid(), G = gridDim.x, bx = blockIdx.x;
    for (int i = tid; i < (LDS_BYTES - CTRL_OFF) / 4; i += 512) ((LAS unsigned*)(lds + CTRL_OFF))[i] = 0u;
    __syncthreads();
    unsigned char* ws = P.ws;
    unsigned* ctl = (unsigned*)(ws + WS_CTL);
    XcdBarrier bar; bar.bar = ctl + CW_BAR; bar.x = 0; bar.st = nullptr;
    if (P.use_bar) bar = xcd_barrier_post(ctl + CW_BAR, (volatile LAS unsigned*)(lds + L_MISC));
    const int vcu = (G % 8 == 0) ? (bx % 8) * (G / 8) + bx / 8 : bx;
    const int lo = P.ph_lo, hi = P.ph_hi;
    float* X = (float*)(ws + WS_X); bf16* Hb = (bf16*)(ws + WS_H); float* Y = (float*)(ws + WS_Y); bf16* proj = (bf16*)(ws + WS_PROJ); bf16* core = (bf16*)(ws + WS_CORE);
    const float* mod = (const float*)(ws + WS_MOD); float* small = (float*)(ws + WS_SMALL);
    int* tke = (int*)(ws + WS_TKE); int* tkp = (int*)(ws + WS_TKP); float* tkw = (float*)(ws + WS_TKW);

    if (IN(0)) { p0_adaln(P, lds); SEAM(0); }
    if (IN(1)) {
        TokA A{}; A.xin = kin(I_X); A.ymode = 0; A.scvec = mod + 1024; A.shvec = mod; A.hout = Hb; A.W = kin(I_GLA_WIN) + 3072; A.ldw = 3088; A.small_out = small;
        tok_phase<16>(A, lds); __syncthreads();
        for (int rep = 0; rep < NREP(5); ++rep) { p0_convert(P, lds); __syncthreads(); }
        SEAM(1);
    }
    layer_body<0>(P, lds, bar, vcu); layer_body<1>(P, lds, bar, vcu); layer_body<2>(P, lds, bar, vcu); layer_body<3>(P, lds, bar, vcu);
#undef IN
#undef INL
#undef SEAM
}

#ifndef MK_ONE_LAUNCH
#define MK_ONE_LAUNCH 1
#endif
extern "C" void kernel_launch(void* const* d_in, const int* in_sizes, int n_in, void* d_out, int out_size, void* d_ws, size_t ws_size, hipStream_t stream) {
    static int grid = 0;
    if (grid == 0) {
        if (n_in != 31 || out_size != T * D || ws_size < WS_END) { fprintf(stderr, "kernel_launch: unexpected shapes (n_in %d out %d ws %zu need %zu)\n", n_in, out_size, ws_size, (size_t)WS_END); grid = -1; return; }
        int dev = 0, cus = 0;
        if (hipGetDevice(&dev) != hipSuccess || hipDeviceGetAttribute(&cus, hipDeviceAttributeMultiprocessorCount, dev) != hipSuccess) { grid = -1; return; }
        if (hipFuncSetAttribute((const void*)mega_fwd, hipFuncAttributeMaxDynamicSharedMemorySize, LDS_BYTES) != hipSuccess) { fprintf(stderr, "kernel_launch: hipFuncSetAttribute failed\n"); grid = -1; return; }
        int per_cu = 0; (void)hipOccupancyMaxActiveBlocksPerMultiprocessor(&per_cu, (const void*)mega_fwd, 512, LDS_BYTES); (void)hipGetLastError();
        if (per_cu < 1) fprintf(stderr, "kernel_launch: occupancy query says %d\n", per_cu);
        grid = 256;
        if (cus != 256) fprintf(stderr, "kernel_launch: built for 256 CUs, device reports %d\n", cus);
    }
    if (grid < 0) return;
    (void)hipMemsetAsync((char*)d_ws + WS_CTL, 0, CTL_ZERO_BYTES, stream);
    Params p{};
    for (int i = 0; i < 31; ++i) p.in[i] = (const float*)d_in[i];
    p.out = (float*)d_out; p.ws = (unsigned char*)d_ws; p.pad = 0;
#if MK_ONE_LAUNCH
    p.ph_lo = 0; p.ph_hi = NPH; p.use_bar = 1;
    hipLaunchKernelGGL(mega_fwd, dim3(grid), dim3(512), LDS_BYTES, stream, p);
#else
    for (int ph = 0; ph < NPH; ++ph) { if (!phase_active(ph)) continue; p.ph_lo = ph; p.ph_hi = ph + 1; p.use_bar = 0;
        hipLaunchKernelGGL(mega_fwd, dim3(grid), dim3(512), LDS_BYTES, stream, p); }
#endif
}
```
